# Optimizing an MI355X kernel written in HIP

```python
import math, functools
import jax, jax.numpy as jnp
from jax import lax
import numpy as np

D_MODEL = 1024
BATCH = 8
SEQ = 2048
DEPTH = 1
DEC_BATCH = 128
DEC_SEQ = 1
PAST_LEN = 2048
PAGE_SIZE = 128

PLE_DIM = 256
ATT_WIDTH = D_MODEL // 2
REC_WIDTH = D_MODEL - ATT_WIDTH
ATT_HEADS = 4
ATT_HD = ATT_WIDTH // (2 * ATT_HEADS)
REC_HEADS = 4
REC_DK = REC_WIDTH // REC_HEADS
REC_DV = REC_WIDTH // REC_HEADS
IN_WIDTH = 3 * ATT_WIDTH + 4 * REC_WIDTH
D_FF = 4 * D_MODEL
CHUNK = 64
Q_BLOCK = 128
EPS = 1e-6

kernel_name = "hymba_diffattn_hgrn2_step"


def rmsnorm(x, g):
    xf = x.astype(jnp.float32)
    y = xf * lax.rsqrt(jnp.mean(xf * xf, axis=-1, keepdims=True) + EPS)
    return (y * g.astype(jnp.float32)).astype(x.dtype)


def lambda_init_fn(li):
    return 0.8 - 0.6 * math.exp(-0.3 * li)


def diff_attend(q, k, v, q_pos, k_pos, lam):
    s = jnp.einsum('bqhmd,bkhmd->bhmqk', q, k).astype(jnp.float32) * (ATT_HD ** -0.5)
    mask = k_pos[None, :] <= q_pos[:, None]
    s = jnp.where(mask, s, -jnp.inf)
    a = jax.nn.softmax(s, axis=-1)
    w = a[:, :, 0] - lam * a[:, :, 1]
    return jnp.einsum('bhqk,bkhe->bqhe', w.astype(v.dtype), v)


def prompt_attn(q, k, v, lam):
    B, S = q.shape[:2]
    nb = S // Q_BLOCK
    qb = q.reshape(B, nb, Q_BLOCK, ATT_HEADS, 2, ATT_HD).transpose(1, 0, 2, 3, 4, 5)
    pb = jnp.arange(S).reshape(nb, Q_BLOCK)
    kk = k.reshape(B, S, ATT_HEADS, 2, ATT_HD)
    kpos = jnp.arange(S)
    ob = lax.map(lambda a: diff_attend(a[0], kk, v, a[1], kpos, lam), (qb, pb))
    return ob.transpose(1, 0, 2, 3, 4).reshape(B, S, ATT_HEADS, 2 * ATT_HD)


def sample_attn(q, k, v, lam, ck, cv, page_table):
    B, T = q.shape[:2]
    past_k = ck[page_table].reshape(B, -1, ATT_HEADS, 2 * ATT_HD)
    past_v = cv[page_table].reshape(B, -1, ATT_HEADS, 2 * ATT_HD)
    past = past_k.shape[1]
    kk = jnp.concatenate([past_k.astype(k.dtype), k], axis=1).reshape(B, past + T, ATT_HEADS, 2, ATT_HD)
    vv = jnp.concatenate([past_v.astype(v.dtype), v], axis=1)
    q_pos = past + jnp.arange(T)
    k_pos = jnp.arange(past + T)
    q = q.reshape(B, T, ATT_HEADS, 2, ATT_HD)
    return diff_attend(q, kk, vv, q_pos, k_pos, lam)


def hgrn_scan(q, k, v, logf, s0):
    B, T, H, _ = q.shape
    c = min(CHUNK, T)
    n = -(-T // c)
    pad = n * c - T
    if pad:
        padw = ((0, 0), (0, pad), (0, 0), (0, 0))
        q = jnp.pad(q, padw); k = jnp.pad(k, padw); v = jnp.pad(v, padw); logf = jnp.pad(logf, padw)

    def to_chunks(a):
        return a.reshape(B, n, c, H, a.shape[-1]).transpose(1, 0, 3, 2, 4)

    causal = jnp.tril(jnp.ones((c, c), dtype=bool))[:, :, None]

    def step(S, inp):
        qc, kc, vc, lc = inp
        b = jnp.cumsum(lc, axis=2)
        o_inter = jnp.einsum('bhtd,bhde->bhte', qc * jnp.exp(b), S)
        diff = b[:, :, :, None, :] - b[:, :, None, :, :]
        decay = jnp.exp(jnp.where(causal, diff, -jnp.inf))
        att = jnp.einsum('bhtd,bhsd,bhtsd->bhts', qc, kc, decay)
        o = o_inter + jnp.einsum('bhts,bhse->bhte', att, vc)
        b_last = b[:, :, -1:, :]
        S_new = jnp.exp(b_last[:, :, 0, :])[..., None] * S + jnp.einsum(
            'bhsd,bhse->bhde', kc * jnp.exp(b_last - b), vc)
        return S_new, o

    s_fin, o = lax.scan(step, s0, (to_chunks(q), to_chunks(k), to_chunks(v), to_chunks(logf)))
    o = o.transpose(1, 0, 3, 2, 4).reshape(B, n * c, H, v.shape[-1])[:, :T]
    return o, s_fin


def hgrn_mixer(rq, rf, ri, rg, lb, g_rec, s0):
    B, T, _ = rq.shape
    f32 = jnp.float32
    shp = (B, T, REC_HEADS, REC_DK)
    q = jax.nn.silu(rq.astype(f32)).reshape(shp)
    f = lb + (1.0 - lb) * jax.nn.sigmoid(rf.astype(f32))
    logf = jnp.log(f).reshape(shp)
    k = (1.0 - f).reshape(shp)
    v = ri.astype(f32).reshape(B, T, REC_HEADS, REC_DV)
    o, s_fin = hgrn_scan(q, k, v, logf, s0.astype(f32))
    o = rmsnorm(o.reshape(B, T, REC_WIDTH), g_rec) * jax.nn.silu(rg.astype(f32))
    return o.astype(rq.dtype), s_fin


def block(x, p_i, li, attend, s0, w_in, lambda_q1, lambda_k1, lambda_q2, lambda_k2,
          g_subln, hgrn_lb, g_rec, w_out, g_mix, g_ffn, w_up, w_down, w_ple_gate, w_ple_proj):
    B, T, _ = x.shape
    h = rmsnorm(x, g_mix[li])
    z = h @ w_in[li]
    cuts = [ATT_WIDTH, 2 * ATT_WIDTH, 3 * ATT_WIDTH, 3 * ATT_WIDTH + REC_WIDTH,
            3 * ATT_WIDTH + 2 * REC_WIDTH, 3 * ATT_WIDTH + 3 * REC_WIDTH]
    aq, ak, av, rq, rf, ri, rg = jnp.split(z, cuts, axis=-1)
    lam_init = lambda_init_fn(li)
    f32 = jnp.float32
    lam = (jnp.exp(jnp.sum(lambda_q1[li].astype(f32) * lambda_k1[li].astype(f32)))
           - jnp.exp(jnp.sum(lambda_q2[li].astype(f32) * lambda_k2[li].astype(f32))) + lam_init)
    q = aq.reshape(B, T, ATT_HEADS, 2, ATT_HD)
    k = ak.reshape(B, T, ATT_HEADS, 2 * ATT_HD)
    v = av.reshape(B, T, ATT_HEADS, 2 * ATT_HD)
    att = attend(q, k, v, lam)
    att = (rmsnorm(att, g_subln[li]) * (1.0 - lam_init)).reshape(B, T, ATT_WIDTH)
    lb = jnp.cumsum(jax.nn.softmax(hgrn_lb.astype(f32), axis=0), axis=0)[li]
    rec, s_new = hgrn_mixer(rq, rf, ri, rg, lb, g_rec[li], s0)
    mix = jnp.concatenate([att.astype(x.dtype), rec.astype(x.dtype)], axis=-1) @ w_out[li]
    x = x + mix
    hf = rmsnorm(x, g_ffn[li]) @ w_up[li]
    x = x + jnp.square(jax.nn.relu(hf)) @ w_down[li]
    x = x + jax.nn.sigmoid(x @ w_ple_gate[li]) * (p_i @ w_ple_proj[li])
    return x, k, v, s_new


def setup_inputs(seed: int = 0) -> dict:
    key = jax.random.key(seed)
    ks = jax.random.split(key, 26)
    f32 = jnp.float32
    n_pages = PAST_LEN // PAGE_SIZE
    n_pool = (DEC_BATCH * n_pages * 5) // 4

    def nrm(k, shape, scale):
        return jax.random.normal(k, shape, f32) * scale

    page_table = jax.random.permutation(ks[5], n_pool)[:DEC_BATCH * n_pages]
    page_table = page_table.reshape(DEC_BATCH, n_pages).astype(jnp.int32)
    return {
        'x_prompt': nrm(ks[0], (BATCH, SEQ, D_MODEL), 1.0),
        'x_sample': nrm(ks[1], (DEC_BATCH, DEC_SEQ, D_MODEL), 1.0),
        'cache_k': nrm(ks[2], (DEPTH, n_pool, PAGE_SIZE, ATT_HEADS, 2 * ATT_HD), 1.0),
        'cache_v': nrm(ks[3], (DEPTH, n_pool, PAGE_SIZE, ATT_HEADS, 2 * ATT_HD), 1.0),
        'state_hgrn': nrm(ks[4], (DEPTH, DEC_BATCH, REC_HEADS, REC_DK, REC_DV), 0.2),
        'page_table': page_table,
        'p_prompt': nrm(ks[6], (DEPTH, BATCH, SEQ, PLE_DIM), 1.0),
        'p_sample': nrm(ks[7], (DEPTH, DEC_BATCH, DEC_SEQ, PLE_DIM), 1.0),
        'w_in': nrm(ks[8], (DEPTH, D_MODEL, IN_WIDTH), D_MODEL ** -0.5),
        'lambda_q1': nrm(ks[9], (DEPTH, ATT_HD), 0.1),
        'lambda_k1': nrm(ks[10], (DEPTH, ATT_HD), 0.1),
        'lambda_q2': nrm(ks[11], (DEPTH, ATT_HD), 0.1),
        'lambda_k2': nrm(ks[12], (DEPTH, ATT_HD), 0.1),
        'g_subln': 1.0 + nrm(ks[13], (DEPTH, 2 * ATT_HD), 0.02),
        'hgrn_lb': nrm(ks[14], (DEPTH + 1, REC_WIDTH), 0.1),
        'g_rec': 1.0 + nrm(ks[15], (DEPTH, REC_WIDTH), 0.02),
        'w_out': nrm(ks[16], (DEPTH, D_MODEL, D_MODEL), D_MODEL ** -0.5),
        'g_mix': 1.0 + nrm(ks[17], (DEPTH, D_MODEL), 0.02),
        'g_ffn': 1.0 + nrm(ks[18], (DEPTH, D_MODEL), 0.02),
        'w_up': nrm(ks[19], (DEPTH, D_MODEL, D_FF), D_MODEL ** -0.5),
        'w_down': nrm(ks[20], (DEPTH, D_FF, D_MODEL), D_FF ** -0.5),
        'w_ple_gate': nrm(ks[21], (DEPTH, D_MODEL, D_MODEL), D_MODEL ** -0.5),
        'w_ple_proj': nrm(ks[22], (DEPTH, PLE_DIM, D_MODEL), PLE_DIM ** -0.5),
        'g_final': 1.0 + nrm(ks[23], (D_MODEL,), 0.02),
    }


def reference(x_prompt, x_sample, cache_k, cache_v, state_hgrn, page_table, p_prompt, p_sample,
              w_in, lambda_q1, lambda_k1, lambda_q2, lambda_k2, g_subln, hgrn_lb, g_rec, w_out,
              g_mix, g_ffn, w_up, w_down, w_ple_gate, w_ple_proj, g_final):
    weights = (w_in, lambda_q1, lambda_k1, lambda_q2, lambda_k2, g_subln, hgrn_lb, g_rec, w_out,
               g_mix, g_ffn, w_up, w_down, w_ple_gate, w_ple_proj)
    hp, hs = x_prompt, x_sample
    kp_l, vp_l, sp_l, ks_l, vs_l, ss_l = [], [], [], [], [], []
    for li in range(DEPTH):
        s0_p = jnp.zeros((hp.shape[0], REC_HEADS, REC_DK, REC_DV), jnp.float32)
        hp, kp, vp, sp = block(hp, p_prompt[li], li, prompt_attn, s0_p, *weights)
        attend_s = functools.partial(sample_attn, ck=cache_k[li], cv=cache_v[li], page_table=page_table)
        hs, ksm, vsm, ssm = block(hs, p_sample[li], li, attend_s, state_hgrn[li], *weights)
        kp_l.append(kp); vp_l.append(vp); sp_l.append(sp)
        ks_l.append(ksm); vs_l.append(vsm); ss_l.append(ssm)
    y_prompt = rmsnorm(hp, g_final)
    y_sample = rmsnorm(hs, g_final)
    k_prompt = jnp.stack(kp_l, 0)
    v_prompt = jnp.stack(vp_l, 0)
    s_prompt = jnp.stack(sp_l, 0)
    k_sample = jnp.stack(ks_l, 0)
    v_sample = jnp.stack(vs_l, 0)
    s_sample = jnp.stack(ss_l, 0)
    return (y_prompt, y_sample, k_prompt, v_prompt, s_prompt, k_sample, v_sample, s_sample)
```

```cpp
#include <hip/hip_runtime.h>
#include <hip/hip_bf16.h>
#include <cstdio>
#include <cstdint>
#include <cmath>

#ifndef MK_N_LAUNCHES
#define MK_N_LAUNCHES 1
#endif

constexpr int D = 1024, NB = 8, SEQ = 2048, MP = NB * SEQ, MS = 128, MT = 16640  ;
constexpr int NIN = 3584, FF = 4096, PLE = 256, AW = 512, RW = 512, NPAGES = 16, PAGE = 128;
constexpr float EPS = 1e-6f;
constexpr float LOG2E = 1.4426950408889634f;
constexpr float QSCALE = 0.125f * LOG2E;
constexpr float LAM_INIT = 0.2f;
constexpr size_t OUT_YP = 0, OUT_YS = OUT_YP + (size_t)MP * D, OUT_KP = OUT_YS + (size_t)MS * D, OUT_VP = OUT_KP + (size_t)MP * AW, OUT_SP = OUT_VP + (size_t)MP * AW,
                 OUT_KS = OUT_SP + (size_t)NB * 4 * 128 * 128, OUT_VS = OUT_KS + (size_t)MS * AW, OUT_SS = OUT_VS + (size_t)MS * AW, OUT_END = OUT_SS + (size_t)MS * 4 * 128 * 128;

namespace pg8 {
#define PG8_LAS __attribute__((address_space(3)))
typedef unsigned short bf16_t;
typedef short bf16x8 __attribute__((ext_vector_type(8)));
typedef float f32x4 __attribute__((ext_vector_type(4)));
typedef unsigned u32x4 __attribute__((ext_vector_type(4)));
typedef unsigned u32x2 __attribute__((ext_vector_type(2)));
constexpr int BM = 256, BK = 64, HALF = 128, HTB = HALF * BK * 2  , STAGE_BYTES = 8 * HTB, NXCD = 8, WGM = 8;

__host__ __device__ __forceinline__ int lds_byte(int r, int c) { const int st = (r >> 4) * 2 + (c >> 5), rr = r & 15, cc = c & 31, ob = rr * 64 + cc * 2; return st * 1024 + (ob ^ (((ob >> 9) & 1) << 5)); }
__host__ __device__ __forceinline__ void stage_rc(int b, int& R, int& C) { const int st = b / 1024, sb = b % 1024, swz = sb ^ (((sb >> 9) & 1) << 5); R = (st >> 1) * 16 + swz / 64; C = (st & 1) * 32 + (swz % 64) / 2; }
__host__ __device__ __forceinline__ int perm32(int rho) { const int n = rho >> 4, i = rho & 15; return 8 * (i >> 2) + 4 * n + (i & 3); }

struct Unit { int pm, pn; };
struct Gemm { const bf16_t* A; const bf16_t* Bt; int M, N, K; };

struct StaticOrder {
    int nM, nN, nwg, G, c;
    __host__ __device__ void init(int M, int N, int G_, int c_) { nM = M / BM; nN = N / BM; nwg = nM * nN; G = G_; c = c_; }
    __host__ __device__ bool next(int i, Unit& u) const {
        const long L = (long)i * G + c; if (L >= nwg) return false;
        int wgid = (int)L; { const int q = nwg / NXCD, r = nwg % NXCD, xcd = wgid % NXCD, off = wgid / NXCD; wgid = (xcd < r ? xcd * (q + 1) : r * (q + 1) + (xcd - r) * q) + off; }
        const int nig = WGM * nN, gid = wgid / nig, fm = gid * WGM, gsz = (nM - fm) < WGM ? (nM - fm) : WGM;
        u.pm = fm + ((wgid % nig) % gsz); u.pn = (wgid % nig) / gsz; return true;
    }
    __device__ __forceinline__ void a_ready(const Unit&) const {}
    __device__ __forceinline__ void done(const Unit&) const {}
};

__device__ __forceinline__ unsigned cvt_pk_bf16(float lo, float hi) { unsigned r; asm volatile("v_cvt_pk_bf16_f32 %0, %1, %2" : "=v"(r) : "v"(lo), "v"(hi)); return r; }
__device__ __forceinline__ u32x4 pack8(const f32x4 v0, const f32x4 v1) { u32x4 w; w.x = cvt_pk_bf16(v0[0], v0[1]); w.y = cvt_pk_bf16(v0[2], v0[3]); w.z = cvt_pk_bf16(v1[0], v1[1]); w.w = cvt_pk_bf16(v1[2], v1[3]); return w; }
__device__ __forceinline__ float fexp(float x) { return __builtin_amdgcn_exp2f(x * 1.4426950408889634f); }
__device__ __forceinline__ float frcp(float x) { return __builtin_amdgcn_rcpf(x); }
__device__ __forceinline__ float sigmoidf_(float x) { return frcp(1.0f + fexp(-x)); }
__device__ __forceinline__ float siluf_(float x) { return x * sigmoidf_(x); }
__device__ __forceinline__ f32x4 map4_silu(f32x4 v) { return (f32x4){siluf_(v[0]), siluf_(v[1]), siluf_(v[2]), siluf_(v[3])}; }

struct EpiIn {
    static constexpr bool PERM = true, AFTER_DRAIN = false;
    bf16_t* Q0; float* LOGF; float* out; const float* hlb;
    static constexpr size_t BUFSTRIDE = (size_t)17 * 1024 * 1024 / 2;
    __device__ __forceinline__ void operator()(const f32x4 (&acc)[2][2][4][2], const Unit& u, int wr, int wc, int fr, int fq) const {
        const int type = u.pn >> 1;
        const int cb = (u.pn & 1) * 256 + wc * 32 + 8 * fq;
        const int row0 = u.pm * BM + wr * 64 + fr;
        const bool prow = u.pm < 64;
        if (type == 0 || type == 3 || type == 5 || type == 6) {
            bf16_t* base = Q0 + (size_t)type * BUFSTRIDE;
#pragma unroll
            for (int ai = 0; ai < 2; ++ai)
#pragma unroll
                for (int m = 0; m < 4; ++m) { bf16_t* rowp = base + (size_t)(row0 + ai * HALF + m * 16) * 512 + cb;
#pragma unroll
                    for (int bj = 0; bj < 2; ++bj) { f32x4 v0 = acc[ai][bj][m][0], v1 = acc[ai][bj][m][1];
                        if (type == 0) { v0 = v0 * QSCALE; v1 = v1 * QSCALE; }
                        else if (type != 5) { v0 = map4_silu(v0); v1 = map4_silu(v1); }
                        *(u32x4*)(rowp + bj * HALF) = pack8(v0, v1); } }
        } else if (type == 1 || type == 2) {
            bf16_t* base = Q0 + (size_t)type * BUFSTRIDE;
            float* ob = out + (type == 1 ? (prow ? OUT_KP : OUT_KS) : (prow ? OUT_VP : OUT_VS));
#pragma unroll
            for (int ai = 0; ai < 2; ++ai)
#pragma unroll
                for (int m = 0; m < 4; ++m) { const int row = row0 + ai * HALF + m * 16; bf16_t* rowp = base + (size_t)row * 512 + cb;
                    const bool ok = prow || ai == 0; float* orow = ob + (size_t)(prow ? row : row - MP) * 512 + cb;
#pragma unroll
                    for (int bj = 0; bj < 2; ++bj) { const f32x4 v0 = acc[ai][bj][m][0], v1 = acc[ai][bj][m][1];
                        *(u32x4*)(rowp + bj * HALF) = pack8(v0, v1);
                        if (ok) { *(f32x4*)(orow + bj * HALF) = v0; *(f32x4*)(orow + bj * HALF + 4) = v1; } } }
        } else {
#pragma unroll
            for (int bj = 0; bj < 2; ++bj) {
                f32x4 lb[2];
#pragma unroll
                for (int n = 0; n < 2; ++n) { const f32x4 l0 = *(const f32x4*)(hlb + cb + bj * HALF + 4 * n), l1 = *(const f32x4*)(hlb + 512 + cb + bj * HALF + 4 * n);
#pragma unroll
                    for (int j = 0; j < 4; ++j) lb[n][j] = frcp(1.0f + fexp(l1[j] - l0[j])); }
#pragma unroll
                for (int ai = 0; ai < 2; ++ai)
#pragma unroll
                    for (int m = 0; m < 4; ++m) { const size_t ro = (size_t)(row0 + ai * HALF + m * 16) * 512 + cb + bj * HALF; f32x4 lf[2], kk[2];
#pragma unroll
                        for (int n = 0; n < 2; ++n)
#pragma unroll
                            for (int j = 0; j < 4; ++j) { const float x = acc[ai][bj][m][n][j], e = fexp(-x), sg = frcp(1.0f + e), l = lb[n][j];
                                const float f = l + (1.0f - l) * sg; lf[n][j] = __builtin_amdgcn_logf(f) * 0.6931471805599453f; kk[n][j] = (1.0f - l) * (e * sg); }
                        *(f32x4*)(LOGF + ro) = lf[0]; *(f32x4*)(LOGF + ro + 4) = lf[1];
                        *(u32x4*)(Q0 + 4 * BUFSTRIDE + ro) = pack8(kk[0], kk[1]); }
            }
        }
    }
};

struct EpiBf {
    static constexpr bool PERM = true, AFTER_DRAIN = false;
    bf16_t* O; int ldc;
    __device__ __forceinline__ void operator()(const f32x4 (&acc)[2][2][4][2], const Unit& u, int wr, int wc, int fr, int fq) const {
        const int row0 = u.pm * BM + wr * 64 + fr, col0 = u.pn * BM + wc * 32 + 8 * fq;
#pragma unroll
        for (int ai = 0; ai < 2; ++ai)
#pragma unroll
            for (int m = 0; m < 4; ++m) { bf16_t* rowp = O + (size_t)(row0 + ai * HALF + m * 16) * ldc + col0;
#pragma unroll
                for (int bj = 0; bj < 2; ++bj) *(u32x4*)(rowp + bj * HALF) = pack8(acc[ai][bj][m][0], acc[ai][bj][m][1]); }
    }
};
struct EpiUp {
    static constexpr bool PERM = true, AFTER_DRAIN = false;
    bf16_t* O; int ldc;
    __device__ __forceinline__ void operator()(const f32x4 (&acc)[2][2][4][2], const Unit& u, int wr, int wc, int fr, int fq) const {
        const int row0 = u.pm * BM + wr * 64 + fr, col0 = u.pn * BM + wc * 32 + 8 * fq;
#pragma unroll
        for (int ai = 0; ai < 2; ++ai)
#pragma unroll
            for (int m = 0; m < 4; ++m) { bf16_t* rowp = O + (size_t)(row0 + ai * HALF + m * 16) * ldc + col0;
#pragma unroll
                for (int bj = 0; bj < 2; ++bj) { f32x4 v0 = acc[ai][bj][m][0], v1 = acc[ai][bj][m][1];
#pragma unroll
                    for (int j = 0; j < 4; ++j) { const float a = fmaxf(v0[j], 0.f), b = fmaxf(v1[j], 0.f); v0[j] = a * a; v1[j] = b * b; }
                    *(u32x4*)(rowp + bj * HALF) = pack8(v0, v1); } }
    }
};
struct EpiOut {
    static constexpr bool PERM = true, AFTER_DRAIN = false;
    const float* xp; const float* xs; float* X1; bf16_t* A2; float* SSP;
    __device__ __forceinline__ void operator()(const f32x4 (&acc)[2][2][4][2], const Unit& u, int wr, int wc, int fr, int fq) const {
        const int row0 = u.pm * BM + wr * 64 + fr, col0 = u.pn * BM + wc * 32 + 8 * fq; const bool prow = u.pm < 64;
#pragma unroll
        for (int ai = 0; ai < 2; ++ai) { if (!prow && ai == 1) break;
#pragma unroll
            for (int m = 0; m < 4; ++m) { const int row = row0 + ai * HALF + m * 16; const float* xr = (prow ? xp + (size_t)row * D : xs + (size_t)(row - MP) * D) + col0;
                float s = 0.f;
#pragma unroll
                for (int bj = 0; bj < 2; ++bj) { const f32x4 a0 = *(const f32x4*)(xr + bj * HALF), a1 = *(const f32x4*)(xr + bj * HALF + 4);
                    const f32x4 v0 = a0 + acc[ai][bj][m][0], v1 = a1 + acc[ai][bj][m][1];
                    s += (v0[0] * v0[0] + v0[1] * v0[1]) + (v0[2] * v0[2] + v0[3] * v0[3]) + (v1[0] * v1[0] + v1[1] * v1[1]) + (v1[2] * v1[2] + v1[3] * v1[3]);
                    float* o = X1 + (size_t)row * D + col0 + bj * HALF; *(f32x4*)o = v0; *(f32x4*)(o + 4) = v1;
                    *(u32x4*)(A2 + (size_t)row * D + col0 + bj * HALF) = pack8(v0, v1); }
                s += __shfl_xor(s, 16); s += __shfl_xor(s, 32);
                if (fq == 0) SSP[(size_t)row * 16 + u.pn * 4 + wc] = s; } }
    }
};
struct EpiDown {
    static constexpr bool PERM = true, AFTER_DRAIN = false;
    float* X1; bf16_t* A3; const float* SSP;
    __device__ __forceinline__ void operator()(const f32x4 (&acc)[2][2][4][2], const Unit& u, int wr, int wc, int fr, int fq) const {
        const int row0 = u.pm * BM + wr * 64 + fr, col0 = u.pn * BM + wc * 32 + 8 * fq; const bool prow = u.pm < 64;
#pragma unroll
        for (int ai = 0; ai < 2; ++ai) { if (!prow && ai == 1) break;
#pragma unroll
            for (int m = 0; m < 4; ++m) { const int row = row0 + ai * HALF + m * 16;
                const f32x4 p0 = *(const f32x4*)(SSP + (size_t)row * 16), p1 = *(const f32x4*)(SSP + (size_t)row * 16 + 4), p2 = *(const f32x4*)(SSP + (size_t)row * 16 + 8), p3 = *(const f32x4*)(SSP + (size_t)row * 16 + 12);
                const f32x4 ps = (p0 + p1) + (p2 + p3); const float ss = (ps[0] + ps[1]) + (ps[2] + ps[3]);
                const float r2 = frcp(ss * (1.0f / D) + EPS);
#pragma unroll
                for (int bj = 0; bj < 2; ++bj) { float* o = X1 + (size_t)row * D + col0 + bj * HALF;
                    const f32x4 v0 = *(const f32x4*)o + acc[ai][bj][m][0] * r2, v1 = *(const f32x4*)(o + 4) + acc[ai][bj][m][1] * r2;
                    *(f32x4*)o = v0; *(f32x4*)(o + 4) = v1;
                    *(u32x4*)(A3 + (size_t)row * D + col0 + bj * HALF) = pack8(v0, v1); } } }
    }
};
struct EpiGate {
    static constexpr bool PERM = true, AFTER_DRAIN = false;
    const float* X1; const bf16_t* PJ; float* out; float* SSP;
    __device__ __forceinline__ void operator()(const f32x4 (&acc)[2][2][4][2], const Unit& u, int wr, int wc, int fr, int fq) const {
        const int row0 = u.pm * BM + wr * 64 + fr, col0 = u.pn * BM + wc * 32 + 8 * fq; const bool prow = u.pm < 64;
#pragma unroll
        for (int ai = 0; ai < 2; ++ai) { if (!prow && ai == 1) break;
#pragma unroll
            for (int m = 0; m < 4; ++m) { const int row = row0 + ai * HALF + m * 16; float* orow = out + (prow ? OUT_YP + (size_t)row * D : OUT_YS + (size_t)(row - MP) * D) + col0;
                float s = 0.f;
#pragma unroll
                for (int bj = 0; bj < 2; ++bj) { const float* xr = X1 + (size_t)row * D + col0 + bj * HALF; const f32x4 a0 = *(const f32x4*)xr, a1 = *(const f32x4*)(xr + 4);
                    const u32x4 pj = *(const u32x4*)(PJ + (size_t)row * D + col0 + bj * HALF);
                    f32x4 v0, v1;
#pragma unroll
                    for (int j = 0; j < 4; ++j) { const unsigned w0 = pj[j >> 1], w1 = pj[2 + (j >> 1)];
                        const float pa = __uint_as_float((j & 1) ? (w0 & 0xffff0000u) : (w0 << 16)), pb = __uint_as_float((j & 1) ? (w1 & 0xffff0000u) : (w1 << 16));
                        v0[j] = a0[j] + sigmoidf_(acc[ai][bj][m][0][j]) * pa; v1[j] = a1[j] + sigmoidf_(acc[ai][bj][m][1][j]) * pb; }
                    s += (v0[0] * v0[0] + v0[1] * v0[1]) + (v0[2] * v0[2] + v0[3] * v0[3]) + (v1[0] * v1[0] + v1[1] * v1[1]) + (v1[2] * v1[2] + v1[3] * v1[3]);
                    *(f32x4*)(orow + bj * HALF) = v0; *(f32x4*)(orow + bj * HALF + 4) = v1; }
                s += __shfl_xor(s, 16); s += __shfl_xor(s, 32);
                if (fq == 0) SSP[(size_t)row * 16 + u.pn * 4 + wc] = s; } }
    }
};

template <class Epi, class Sched, bool ALIGN_EPI = false, bool SP2 = false>
__device__ __forceinline__ void gemm_phase(PG8_LAS unsigned char* lds, const Gemm g, const Sched& S, const Epi& E) {
    const int tid = threadIdx.x, wid = __builtin_amdgcn_readfirstlane(tid >> 6), lane = tid & 63, wr = wid >> 2, wc = wid & 3, fr = lane & 15, fq = lane >> 4;
    const int K = g.K, nt = K / BK;
    unsigned voffA[2], voffB[2];
#pragma unroll
    for (int i = 0; i < 2; ++i) { int R, C; stage_rc(tid * 16 + i * 8192, R, C); const int Rb = Epi::PERM ? ((R & ~31) + perm32(R & 31)) : R;
        voffA[i] = (unsigned)(R * K + C) * 2u; voffB[i] = (unsigned)(Rb * K + C) * 2u; }
    const size_t kstep = (size_t)(BK * 2);
    const size_t hstep = (size_t)HALF * K * 2;
    const size_t tstep = 2 * hstep;
    const unsigned ldsw = (unsigned)wid * 1024u;
    const int aoff = lds_byte(wr * 64 + fr, fq * 8), boff = lds_byte(wc * 32 + fr, fq * 8);
#define PG8_SA(b, h) (((b) * 2 + (h)) * HTB)
#define PG8_SB(b, h) ((4 + (b) * 2 + (h)) * HTB)
#define PG8_STAGE(bufoff, gbase, voff) do { _Pragma("unroll") for (int _i = 0; _i < 2; ++_i) \
        __builtin_amdgcn_global_load_lds((const unsigned*)((const char*)(gbase) + (voff)[_i]), (PG8_LAS unsigned*)(lds + (bufoff) + ldsw + _i * 8192), 16, 0, 0); } while (0)
#define PG8_LDA(dst, b, h) do { _Pragma("unroll") for (int m = 0; m < 4; ++m) _Pragma("unroll") for (int k = 0; k < 2; ++k) dst[m][k] = *(const PG8_LAS bf16x8*)(lds + PG8_SA(b, h) + aoff + m * 2048 + k * 1024); } while (0)
#define PG8_LDB(dst, b, h) do { _Pragma("unroll") for (int n = 0; n < 2; ++n) _Pragma("unroll") for (int k = 0; k < 2; ++k) dst[n][k] = *(const PG8_LAS bf16x8*)(lds + PG8_SB(b, h) + boff + n * 2048 + k * 1024); } while (0)
#define PG8_MMA(ai, bj, At, Bt) do { __builtin_amdgcn_s_setprio(1); _Pragma("unroll") for (int m = 0; m < 4; ++m) _Pragma("unroll") for (int n = 0; n < 2; ++n) _Pragma("unroll") for (int k = 0; k < 2; ++k) \
        acc[ai][bj][m][n] = __builtin_amdgcn_mfma_f32_16x16x32_bf16(Bt[n][k], At[m][k], acc[ai][bj][m][n], 0, 0, 0); __builtin_amdgcn_s_setprio(0); } while (0)
#define PG8_WAIT_V(n) asm volatile("s_waitcnt vmcnt(" #n ")" ::: "memory")
#define PG8_WAIT_L(n) asm volatile("s_waitcnt lgkmcnt(" #n ")" ::: "memory")
#define PG8_BAR __builtin_amdgcn_s_barrier()
#define PG8_SCHED __builtin_amdgcn_sched_barrier(0)
    Unit cur, nxt; int ui = 0;
    if (!S.next(0, cur)) return;
    f32x4 acc[2][2][4][2];
#pragma unroll
    for (int a = 0; a < 2; ++a)
#pragma unroll
        for (int b = 0; b < 2; ++b)
#pragma unroll
            for (int m = 0; m < 4; ++m)
#pragma unroll
                for (int n = 0; n < 2; ++n) acc[a][b][m][n] = (f32x4){0.f, 0.f, 0.f, 0.f};
    bf16x8 At[4][2], B0[2][2], B1[2][2];
    const char* cA = (const char*)g.A + (size_t)cur.pm * tstep; const char* cB = (const char*)g.Bt + (size_t)cur.pn * tstep;
    S.a_ready(cur);
    if constexpr (SP2) {
        PG8_STAGE(PG8_SB(0, 0), cB, voffB); PG8_STAGE(PG8_SB(0, 1), cB + hstep, voffB); PG8_STAGE(PG8_SA(0, 0), cA, voffA); PG8_STAGE(PG8_SA(0, 1), cA + hstep, voffA);
        if (wr == 1) PG8_BAR;
        PG8_WAIT_V(2); PG8_BAR;
        PG8_STAGE(PG8_SB(1, 0), cB + kstep, voffB); PG8_STAGE(PG8_SA(1, 0), cA + kstep, voffA); PG8_STAGE(PG8_SB(1, 1), cB + hstep + kstep, voffB);
        PG8_WAIT_V(6); PG8_BAR;
    } else {
        PG8_STAGE(PG8_SB(0, 0), cB, voffB); PG8_STAGE(PG8_SA(0, 0), cA, voffA); PG8_STAGE(PG8_SB(0, 1), cB + hstep, voffB); PG8_STAGE(PG8_SA(0, 1), cA + hstep, voffA);
        if (wr == 1) PG8_BAR;
        PG8_WAIT_V(4); PG8_BAR;
        PG8_STAGE(PG8_SB(1, 0), cB + kstep, voffB); PG8_STAGE(PG8_SA(1, 0), cA + kstep, voffA); PG8_STAGE(PG8_SB(1, 1), cB + hstep + kstep, voffB);
        PG8_WAIT_V(6); PG8_BAR;
    }
    for (;;) {
        const bool has_next = S.next(ui + 1, nxt);
        const char* nA = has_next ? (const char*)g.A + (size_t)nxt.pm * tstep : cA; const char* nB = has_next ? (const char*)g.Bt + (size_t)nxt.pn * tstep : cB;
        for (int t = 0; t < nt; t += 2) {
            const bool last = (t == nt - 2);
            const char* a1 = cA + (size_t)(t + 1) * kstep;
            const char* a2 = last ? nA : cA + (size_t)(t + 2) * kstep; const char* b2 = last ? nB : cB + (size_t)(t + 2) * kstep;
            const char* a3 = a2 + kstep; const char* b3 = b2 + kstep;
            if (last && has_next) S.a_ready(nxt);
            if constexpr (SP2) {
            PG8_LDB(B0, 0, 0); PG8_LDB(B1, 0, 1); PG8_SCHED; PG8_LDA(At, 0, 0); PG8_STAGE(PG8_SA(1, 1), a1 + hstep, voffA);
            PG8_WAIT_V(8); PG8_WAIT_L(0); PG8_BAR; PG8_MMA(0, 0, At, B0); PG8_MMA(0, 1, At, B1); PG8_BAR; PG8_SCHED;
            PG8_LDA(At, 0, 1); PG8_STAGE(PG8_SB(0, 0), b2, voffB); PG8_STAGE(PG8_SB(0, 1), b2 + hstep, voffB); PG8_STAGE(PG8_SA(0, 0), a2, voffA);
            PG8_WAIT_V(8); PG8_WAIT_L(0); PG8_BAR; PG8_MMA(1, 0, At, B0); PG8_MMA(1, 1, At, B1); PG8_BAR; PG8_SCHED;
            PG8_LDB(B0, 1, 0); PG8_LDB(B1, 1, 1); PG8_SCHED; PG8_LDA(At, 1, 0); PG8_STAGE(PG8_SA(0, 1), a2 + hstep, voffA);
            PG8_WAIT_V(8); PG8_WAIT_L(0); PG8_BAR; PG8_MMA(0, 0, At, B0); PG8_MMA(0, 1, At, B1); PG8_BAR; PG8_SCHED;
            PG8_LDA(At, 1, 1); PG8_STAGE(PG8_SB(1, 0), b3, voffB); PG8_STAGE(PG8_SB(1, 1), b3 + hstep, voffB); PG8_STAGE(PG8_SA(1, 0), a3, voffA);
            PG8_WAIT_V(8); PG8_WAIT_L(0); PG8_BAR; PG8_MMA(1, 0, At, B0); PG8_MMA(1, 1, At, B1); PG8_BAR; PG8_SCHED;
            } else {
            PG8_LDB(B0, 0, 0); PG8_SCHED; PG8_LDA(At, 0, 0); PG8_STAGE(PG8_SA(1, 1), a1 + hstep, voffA);
            PG8_WAIT_L(8); PG8_BAR; PG8_WAIT_L(0); PG8_MMA(0, 0, At, B0); PG8_BAR; PG8_SCHED;
            PG8_LDB(B1, 0, 1); PG8_STAGE(PG8_SB(0, 0), b2, voffB);
            PG8_BAR; PG8_WAIT_L(0); PG8_MMA(0, 1, At, B1); PG8_BAR;
            PG8_LDA(At, 0, 1); PG8_STAGE(PG8_SA(0, 0), a2, voffA);
            PG8_BAR; PG8_WAIT_L(0); PG8_MMA(1, 0, At, B0); PG8_BAR; PG8_SCHED;
            PG8_STAGE(PG8_SB(0, 1), b2 + hstep, voffB);
            PG8_WAIT_V(6); PG8_BAR; PG8_MMA(1, 1, At, B1); PG8_BAR;
            PG8_LDB(B0, 1, 0); PG8_SCHED; PG8_LDA(At, 1, 0); PG8_STAGE(PG8_SA(0, 1), a2 + hstep, voffA);
            PG8_WAIT_L(8); PG8_BAR; PG8_WAIT_L(0); PG8_MMA(0, 0, At, B0); PG8_BAR; PG8_SCHED;
            PG8_LDB(B1, 1, 1); PG8_STAGE(PG8_SB(1, 0), b3, voffB);
            PG8_BAR; PG8_WAIT_L(0); PG8_MMA(0, 1, At, B1); PG8_BAR;
            PG8_LDA(At, 1, 1); PG8_STAGE(PG8_SA(1, 0), a3, voffA);
            PG8_BAR; PG8_WAIT_L(0); PG8_MMA(1, 0, At, B0); PG8_BAR; PG8_SCHED;
            PG8_STAGE(PG8_SB(1, 1), b3 + hstep, voffB);
            PG8_WAIT_V(6); PG8_BAR; PG8_MMA(1, 1, At, B1); PG8_BAR;
            }
        }
        if constexpr (ALIGN_EPI) { if (wr == 0) PG8_BAR; }
        if constexpr (!Epi::AFTER_DRAIN) { E(acc, cur, wr, wc, fr, fq); S.done(cur); }
        if (!has_next) break;
#pragma unroll
        for (int a = 0; a < 2; ++a)
#pragma unroll
            for (int b = 0; b < 2; ++b)
#pragma unroll
                for (int m = 0; m < 4; ++m)
#pragma unroll
                    for (int n = 0; n < 2; ++n) acc[a][b][m][n] = (f32x4){0.f, 0.f, 0.f, 0.f};
        cur = nxt; cA = nA; cB = nB; ++ui;
        if constexpr (ALIGN_EPI) { if (wr == 1) PG8_BAR; }
    }
    PG8_WAIT_V(0);
    if constexpr (!ALIGN_EPI) { if (wr == 0) PG8_BAR; }
    PG8_BAR;
    if constexpr (Epi::AFTER_DRAIN) { E.fused(acc, cur, wr, wc, fr, fq, lds, wid, lane); S.done(cur); }
#undef PG8_SA
#undef PG8_SB
#undef PG8_STAGE
#undef PG8_LDA
#undef PG8_LDB
#undef PG8_MMA
#undef PG8_WAIT_V
#undef PG8_WAIT_L
#undef PG8_BAR
#undef PG8_SCHED
}
}
#define GAS __attribute__((address_space(1)))
#define LAS __attribute__((address_space(3)))
typedef unsigned short bf16;
typedef unsigned v4u __attribute__((ext_vector_type(4)));
typedef float f32x4 __attribute__((ext_vector_type(4)));
typedef short bf16x8 __attribute__((ext_vector_type(8)));
typedef GAS unsigned gu32;
typedef GAS unsigned long long gu64;
#define RLX_AGENT __ATOMIC_RELAXED, __HIP_MEMORY_SCOPE_AGENT
#define LDS_WAIT() asm volatile("s_waitcnt lgkmcnt(0)" ::: "memory")
#define VM_WAIT() asm volatile("s_waitcnt vmcnt(0)" ::: "memory")
__device__ __forceinline__ unsigned long long rt() { return __builtin_amdgcn_s_memrealtime(); }
__device__ __forceinline__ unsigned f2bf(float f) { unsigned u = __builtin_bit_cast(unsigned, f); return (u + 0x7fffu + ((u >> 16) & 1u)) >> 16; }
__device__ __forceinline__ unsigned pk2(float lo, float hi) { return f2bf(lo) | (f2bf(hi) << 16); }

#define XB_TMO      128
#define XB_XCNT(j)  (256  + 64 * (j))
#define XB_XSUB(j)  (1280 + 64 * (j))
#define XB_XGEN(j)  (2304 + 64 * (j))
#define XB_TOP      3328
#define XB_TOPGEN   3392
#define XCD_BAR_WORDS 3456
#define XB_SPIN_CAP (1u << 18)

__device__ __forceinline__ unsigned xb_ld(unsigned* p)              { return __hip_atomic_load(p, __ATOMIC_RELAXED, __HIP_MEMORY_SCOPE_AGENT); }
__device__ __forceinline__ unsigned xb_add(unsigned* p, unsigned v) { return __hip_atomic_fetch_add(p, v, __ATOMIC_RELAXED, __HIP_MEMORY_SCOPE_AGENT); }
__device__ __forceinline__ unsigned xb_xcc_id() { return (unsigned)__builtin_amdgcn_s_getreg((3 << 11) | 20) & 0xFu; }
#define XB_SPIN(cond, bar) do { unsigned _sp = 0; while (cond) { __builtin_amdgcn_s_sleep(1); \
    if ((++_sp & 255u) == 0u) { if (xb_ld(&(bar)[XB_TMO])) break; if (_sp > XB_SPIN_CAP) { atomicAdd(&(bar)[XB_TMO], 1u); break; } } } } while (0)

struct XcdBarrier {
    unsigned* bar; unsigned x;
    volatile LAS unsigned* st;
};

__device__ __forceinline__ XcdBarrier xcd_barrier_post(unsigned* bar, volatile LAS unsigned* st) {
    XcdBarrier b; b.bar = bar; b.x = xb_xcc_id(); b.st = st;
    if (threadIdx.x == 0) (void)xb_add(&bar[XB_XCNT(b.x)], 1u);
    return b;
}
__device__ __forceinline__ void xcd_barrier_complete(unsigned* bar, unsigned x, unsigned& nloc, unsigned& nx) {
    const unsigned G = gridDim.x * gridDim.y * gridDim.z;
    unsigned sum, cnt, mine, sp = 0u;
    for (;;) {
        sum = 0u; cnt = 0u; mine = 0u;
#pragma unroll
        for (unsigned j = 0; j < 16; ++j) { const unsigned c = xb_ld(&bar[XB_XCNT(j)]); sum += c; cnt += (c > 0u) ? 1u : 0u; mine = (j == x) ? c : mine; }
        if (sum == G) break;
        __builtin_amdgcn_s_sleep(1);
        if ((++sp & 255u) == 0u) { if (xb_ld(&bar[XB_TMO])) break; if (sp > XB_SPIN_CAP) { atomicAdd(&bar[XB_TMO], 1u); break; } }
    }
    nloc = mine > 0u ? mine : 1u; nx = cnt > 0u ? cnt : 1u;
}

__device__ __forceinline__ void xcd_barrier(const XcdBarrier& b) {
    asm volatile("s_waitcnt vmcnt(0)" ::: "memory");
    __syncthreads();
    if (threadIdx.x == 0) {
        unsigned* bar = b.bar;
        __builtin_amdgcn_s_waitcnt(0);
        unsigned nloc = b.st[0], nx = b.st[1];
        if (nloc == 0u) { xcd_barrier_complete(bar, b.x, nloc, nx); b.st[0] = nloc; b.st[1] = nx; }
        const unsigned old = xb_add(&bar[XB_XSUB(b.x)], 1u);
        const unsigned gen = old / nloc;
        if (old + 1u == (gen + 1u) * nloc) {
            __builtin_amdgcn_fence(__ATOMIC_RELEASE, "agent");
            asm volatile("s_waitcnt vmcnt(0)" ::: "memory");
            const unsigned og = xb_add(&bar[XB_TOP], 1u);
            const unsigned tg = og / nx;
            if (og + 1u == (tg + 1u) * nx) xb_add(&bar[XB_TOPGEN], 1u);
            else XB_SPIN(xb_ld(&bar[XB_TOPGEN]) == tg, bar);
            __builtin_amdgcn_fence(__ATOMIC_ACQUIRE, "agent");
            xb_add(&bar[XB_XGEN(b.x)], 1u);
            asm volatile("s_waitcnt vmcnt(0)" ::: "memory");
        } else {
            XB_SPIN(xb_ld(&bar[XB_XGEN(b.x)]) == gen, bar);
            __builtin_amdgcn_fence(__ATOMIC_ACQUIRE, "agent");
            asm volatile("s_waitcnt vmcnt(0)" ::: "memory");
        }
    }
    __syncthreads();
}

typedef float f32x16 __attribute__((ext_vector_type(16)));
typedef short s16x4 __attribute__((ext_vector_type(4)));
typedef unsigned u32x2v __attribute__((ext_vector_type(2)));
typedef LAS unsigned char* ldsp_t;
#define WAITV0_BAR() asm volatile("s_waitcnt vmcnt(0) lgkmcnt(0)\n\ts_barrier" ::: "memory")
#define LGKM_BAR() asm volatile("s_waitcnt lgkmcnt(0)\n\ts_barrier" ::: "memory")
__device__ __forceinline__ int crow(int r, int hi) { return (r & 3) + 8 * (r >> 2) + 4 * hi; }
__device__ __forceinline__ unsigned cvtpk(float lo, float hi) { unsigned r; asm volatile("v_cvt_pk_bf16_f32 %0, %1, %2" : "=v"(r) : "v"(lo), "v"(hi)); return r; }
__device__ __forceinline__ float bf2f(unsigned short b) { return __uint_as_float((unsigned)b << 16); }
__device__ __forceinline__ float bflo(unsigned w) { return __uint_as_float(w << 16); }
__device__ __forceinline__ float bfhi(unsigned w) { return __uint_as_float(w & 0xffff0000u); }
__device__ __forceinline__ float ex2(float x) { return __builtin_amdgcn_exp2f(x); }
__device__ __forceinline__ float fexpn(float x) { return __builtin_amdgcn_exp2f(x * LOG2E); }
__device__ __forceinline__ float swap_max(float v) { auto rr = __builtin_amdgcn_permlane32_swap(__float_as_uint(v), __float_as_uint(v), false, false); return fmaxf(__uint_as_float(rr[0]), __uint_as_float(rr[1])); }
__device__ __forceinline__ float swap_sum(float v) { auto rr = __builtin_amdgcn_permlane32_swap(__float_as_uint(v), __float_as_uint(v), false, false); return __uint_as_float(rr[0]) + __uint_as_float(rr[1]); }
__device__ __forceinline__ s16x4 vtr(LAS const unsigned char* p) { return __builtin_bit_cast(s16x4, __builtin_amdgcn_ds_read_tr16_b64_v4i16((LAS s16x4*)p)); }
__device__ __forceinline__ bf16x8 cat8(s16x4 a, s16x4 b) { return (bf16x8){a[0], a[1], a[2], a[3], b[0], b[1], b[2], b[3]}; }
__device__ __forceinline__ bf16x8 accfrag(const f32x16& x, int s) {
    v4u w; w.x = cvtpk(x[8 * s + 0], x[8 * s + 1]); w.y = cvtpk(x[8 * s + 2], x[8 * s + 3]); w.z = cvtpk(x[8 * s + 4], x[8 * s + 5]); w.w = cvtpk(x[8 * s + 6], x[8 * s + 7]);
    return __builtin_bit_cast(bf16x8, w);
}
#define DMA16(gsrc, ldsdst) __builtin_amdgcn_global_load_lds((const unsigned*)(gsrc), (LAS unsigned*)(ldsdst), 16, 0, 0)
__device__ __forceinline__ void dma_vimg(const bf16* src, int pitch, ldsp_t img, int wid, int lane) {
    const int sub = lane >> 5, row = (lane & 31) >> 2, ch = lane & 3;
#pragma unroll
    for (int j = 0; j < 2; ++j) DMA16(src + (size_t)(8 * wid + row) * pitch + 32 * (2 * j + sub) + 8 * ch, img + (wid * 4 + 2 * j) * 512);
}
__device__ __forceinline__ int vtr_lane_off(int lane) { return ((lane >> 4) & 1) * 32 + (lane & 3) * 8 + ((lane & 15) >> 2) * 64; }

namespace att {
constexpr int BUFB = 32768, KIMG = 16384, XOFF = 65536;
__device__ __forceinline__ void unit(int b, int h, int qblk, const bf16* Q, const bf16* K, const bf16* V, bf16* MIX, float lam, const float* gsub, ldsp_t lds) {
    int tid = threadIdx.x; asm volatile("" : "+v"(tid));
    const int lane = tid & 63, wid = __builtin_amdgcn_readfirstlane(tid >> 6), r32 = lane & 31, hi = lane >> 5, mp = wid >> 2, qb = wid & 3;
    const int q0 = qblk * 128, NT = 2 * (qblk + 1);
    const size_t rowbase = (size_t)b * SEQ;
    const int qg = q0 + 32 * qb + r32;
    bf16x8 qr[4];
    { const bf16* qp = Q + (rowbase + qg) * AW + h * 128 + mp * 64 + hi * 8;
#pragma unroll
      for (int d0 = 0; d0 < 4; ++d0) qr[d0] = *(const bf16x8*)(qp + 16 * d0); }
    const bf16* ksrc = K + (rowbase + lane) * AW + h * 128 + mp * 64 + 2 * (wid & 3) * 8;
    const bf16* vsrc = V + rowbase * AW + h * 128;
    const int kdst = mp * 8192 + 2 * (wid & 3) * 1024;
#define ATT_DMA(t, buf) do { const bf16* ks_ = ksrc + (size_t)(t) * 64 * AW; DMA16(ks_, lds + (buf) * BUFB + kdst); DMA16(ks_ + 8, lds + (buf) * BUFB + kdst + 1024); \
        dma_vimg(vsrc + (size_t)(t) * 64 * AW, AW, lds + (buf) * BUFB + KIMG, wid, lane); } while (0)
    f32x16 o[4];
#pragma unroll
    for (int i = 0; i < 4; ++i) o[i] = (f32x16){};
    float mrun = -1e30f, lsum = 0.f;
    const int vlo = vtr_lane_off(lane) + 4 * hi * 64;
    ATT_DMA(0, 0);
    WAITV0_BAR();
    for (int t = 0; t < NT; ++t) {
        const int buf = t & 1;
        if (t + 1 < NT) ATT_DMA(t + 1, buf ^ 1);
        if (64 * t <= q0 + 32 * qb + 31) {
            const LAS unsigned char* kb = lds + buf * BUFB + mp * 8192 + hi * 1024 + r32 * 16;
            f32x16 p0 = (f32x16){}, p1 = (f32x16){};
#pragma unroll
            for (int d0 = 0; d0 < 4; ++d0) {
                const bf16x8 k0 = *(const LAS bf16x8*)(kb + d0 * 2048), k1 = *(const LAS bf16x8*)(kb + d0 * 2048 + 512);
                p0 = __builtin_amdgcn_mfma_f32_32x32x16_bf16(k0, qr[d0], p0, 0, 0, 0);
                p1 = __builtin_amdgcn_mfma_f32_32x32x16_bf16(k1, qr[d0], p1, 0, 0, 0);
            }
            if (64 * t + 63 > q0 + 32 * qb) {
#pragma unroll
                for (int r = 0; r < 16; ++r) { const int kv = 64 * t + crow(r, hi); if (kv > qg) p0[r] = -1e30f; if (kv + 32 > qg) p1[r] = -1e30f; }
            }
            float mt = fmaxf(p0[0], p1[0]);
#pragma unroll
            for (int r = 1; r < 16; ++r) mt = fmaxf(mt, fmaxf(p0[r], p1[r]));
            mt = swap_max(mt);
            const float mnew = fmaxf(mrun, mt);
            if (__any(mnew > mrun)) {
                const float al = ex2(mrun - mnew); lsum *= al;
#pragma unroll
                for (int i = 0; i < 4; ++i)
#pragma unroll
                    for (int r = 0; r < 16; ++r) o[i][r] *= al;
            }
            mrun = mnew;
            float ps = 0.f;
#pragma unroll
            for (int r = 0; r < 16; ++r) { p0[r] = ex2(p0[r] - mnew); p1[r] = ex2(p1[r] - mnew); ps += p0[r] + p1[r]; }
            lsum += ps;
            bf16x8 pw[4]; pw[0] = accfrag(p0, 0); pw[1] = accfrag(p0, 1); pw[2] = accfrag(p1, 0); pw[3] = accfrag(p1, 1);
            const LAS unsigned char* vb = lds + buf * BUFB + KIMG + vlo;
#pragma unroll
            for (int s = 0; s < 4; ++s)
#pragma unroll
                for (int db = 0; db < 4; ++db) {
                    const bf16x8 vf = cat8(vtr(vb + ((2 * s) * 4 + db) * 512), vtr(vb + ((2 * s + 1) * 4 + db) * 512));
                    o[db] = __builtin_amdgcn_mfma_f32_32x32x16_bf16(vf, pw[s], o[db], 0, 0, 0);
                }
        }
        WAITV0_BAR();
    }
#undef ATT_DMA
    const float inv = 1.0f / swap_sum(lsum);
    LAS float* X = (LAS float*)(lds + XOFF);
    if (mp == 1) { const float sc = lam * inv;
#pragma unroll
        for (int db = 0; db < 4; ++db)
#pragma unroll
            for (int r = 0; r < 16; ++r) X[(qb * 64 + db * 16 + r) * 64 + lane] = o[db][r] * sc; }
    LGKM_BAR();
    if (mp == 0) {
        float ss = 0.f;
#pragma unroll
        for (int db = 0; db < 4; ++db)
#pragma unroll
            for (int r = 0; r < 16; ++r) { const float a = o[db][r] * inv - X[(qb * 64 + db * 16 + r) * 64 + lane]; o[db][r] = a; ss += a * a; }
        ss = swap_sum(ss);
        const float rs = (1.0f - LAM_INIT) / sqrtf(ss * (1.0f / 128.0f) + EPS);
        bf16* orow = MIX + (rowbase + qg) * D + h * 128;
#pragma unroll
        for (int db = 0; db < 4; ++db)
#pragma unroll
            for (int g = 0; g < 4; ++g) { const int d = 32 * db + 8 * g + 4 * hi; const f32x4 gg = *(const f32x4*)(gsub + d);
                u32x2v w; w.x = cvtpk(o[db][4 * g] * rs * gg[0], o[db][4 * g + 1] * rs * gg[1]); w.y = cvtpk(o[db][4 * g + 2] * rs * gg[2], o[db][4 * g + 3] * rs * gg[3]);
                *(u32x2v*)(orow + d) = w; }
    }
}
}

namespace hg {
constexpr int QE_OFF = 0, QE_P = 136  , KE_OFF = 17408, KLT_OFF = 34816, KLT_P = 72, V_OFF = 53248, G_OFF = 86016, QT_OFF = 86528, LDS_END = 88576;
__device__ __forceinline__ void unit(int bh, const bf16* RQ, const bf16* RK, const bf16* RV, const float* LOGF, bf16* OREC, float* sout, ldsp_t lds) {
    int tid = threadIdx.x; asm volatile("" : "+v"(tid));
    const int lane = tid & 63, wid = __builtin_amdgcn_readfirstlane(tid >> 6), r32 = lane & 31, hi = lane >> 5, th = wid >> 2, eb = wid & 3;
    const int b = bh >> 2, h = bh & 3;
    const size_t rowbase = (size_t)b * SEQ; const int col0 = h * 128;
    const int d = tid & 127, tq = tid >> 7;
    LAS bf16* QE = (LAS bf16*)(lds + QE_OFF); LAS bf16* KE = (LAS bf16*)(lds + KE_OFF); LAS bf16* KLT = (LAS bf16*)(lds + KLT_OFF);
    LAS float* G = (LAS float*)(lds + G_OFF); LAS float* QT = (LAS float*)(lds + QT_OFF);
    float lf[16]; unsigned short rq[16], rk[16];
    f32x16 S[4];
#pragma unroll
    for (int i = 0; i < 4; ++i) S[i] = (f32x16){};
    const int vlo = vtr_lane_off(lane);
#define HG_LOAD(n) do { const size_t g0_ = (rowbase + 64 * (n) + 16 * tq) * RW + col0 + d; _Pragma("unroll") for (int i = 0; i < 16; ++i) { lf[i] = LOGF[g0_ + (size_t)i * RW]; rq[i] = RQ[g0_ + (size_t)i * RW]; rk[i] = RK[g0_ + (size_t)i * RW]; } \
        dma_vimg(RV + (rowbase + 64 * (n)) * RW + col0, RW, lds + V_OFF + ((n) & 1) * 16384, wid, lane); } while (0)
#define HG_PREP() do { float cs_[16]; float c_ = 0.f; _Pragma("unroll") for (int i = 0; i < 16; ++i) { c_ += lf[i]; cs_[i] = c_; } \
        QT[tq * 128 + d] = c_; LGKM_BAR(); \
        float off_ = 0.f, tot_ = 0.f; _Pragma("unroll") for (int q = 0; q < 4; ++q) { const float v_ = QT[q * 128 + d]; tot_ += v_; if (q < tq) off_ += v_; } \
        if (tq == 0) G[d] = fexpn(tot_); \
        unsigned klw_[8]; \
        _Pragma("unroll") for (int i = 0; i < 16; i += 2) { \
            const float b0_ = cs_[i] + off_, b1_ = cs_[i + 1] + off_; const float q0_ = bf2f(rq[i]), q1_ = bf2f(rq[i + 1]), k0_ = bf2f(rk[i]), k1_ = bf2f(rk[i + 1]); \
            const unsigned qe_ = cvtpk(q0_ * fexpn(b0_), q1_ * fexpn(b1_)), ke_ = cvtpk(k0_ * fexpn(-b0_), k1_ * fexpn(-b1_)); \
            klw_[i >> 1] = cvtpk(k0_ * fexpn(tot_ - b0_), k1_ * fexpn(tot_ - b1_)); \
            QE[(16 * tq + i) * QE_P + d] = (bf16)(qe_ & 0xffffu); QE[(16 * tq + i + 1) * QE_P + d] = (bf16)(qe_ >> 16); \
            KE[(16 * tq + i) * QE_P + d] = (bf16)(ke_ & 0xffffu); KE[(16 * tq + i + 1) * QE_P + d] = (bf16)(ke_ >> 16); } \
        *(LAS v4u*)(KLT + d * KLT_P + 16 * tq) = (v4u){klw_[0], klw_[1], klw_[2], klw_[3]}; *(LAS v4u*)(KLT + d * KLT_P + 16 * tq + 8) = (v4u){klw_[4], klw_[5], klw_[6], klw_[7]}; } while (0)
    HG_LOAD(0);
    HG_PREP();
    WAITV0_BAR();
    for (int n = 0; n < 32; ++n) {
        if (n + 1 < 32) HG_LOAD(n + 1);
        const LAS unsigned char* vimg = lds + V_OFF + (n & 1) * 16384;
        f32x16 o = (f32x16){};
        bf16x8 xw[2][2];
#pragma unroll
        for (int sb = 0; sb < 2; ++sb) if (sb <= th) {
            f32x16 x = (f32x16){};
#pragma unroll
            for (int sg = 0; sg < 8; ++sg) {
                const bf16x8 ka = *(const LAS bf16x8*)(KE + (32 * sb + r32) * QE_P + 16 * sg + 8 * hi), qbv = *(const LAS bf16x8*)(QE + (32 * th + r32) * QE_P + 16 * sg + 8 * hi);
                x = __builtin_amdgcn_mfma_f32_32x32x16_bf16(ka, qbv, x, 0, 0, 0);
            }
            if (sb == th) {
#pragma unroll
                for (int r = 0; r < 16; ++r) if (crow(r, hi) > r32) x[r] = 0.f;
            }
            xw[sb][0] = accfrag(x, 0); xw[sb][1] = accfrag(x, 1);
        }
#pragma unroll
        for (int db = 0; db < 4; ++db)
#pragma unroll
            for (int sg = 0; sg < 2; ++sg) {
                const LAS bf16* qp = QE + (32 * th + r32) * QE_P + 32 * db + 16 * sg + 4 * hi;
                const u32x2v a0 = *(const LAS u32x2v*)qp, a1 = *(const LAS u32x2v*)(qp + 8);
                const v4u aw = (v4u){a0.x, a0.y, a1.x, a1.y};
                o = __builtin_amdgcn_mfma_f32_32x32x16_bf16(__builtin_bit_cast(bf16x8, aw), accfrag(S[db], sg), o, 0, 0, 0);
            }
#pragma unroll
        for (int sb = 0; sb < 2; ++sb) if (sb <= th) {
#pragma unroll
            for (int sg = 0; sg < 2; ++sg) {
                const LAS unsigned char* vb = vimg + vlo + 4 * hi * 64 + ((4 * sb + 2 * sg) * 4 + eb) * 512;
                const bf16x8 vf = cat8(vtr(vb), vtr(vb + 4 * 512));
                o = __builtin_amdgcn_mfma_f32_32x32x16_bf16(xw[sb][sg], vf, o, 0, 0, 0);
            }
        }
        { bf16* op = OREC + (rowbase + 64 * n + 32 * th) * RW + col0 + 32 * eb + r32;
#pragma unroll
          for (int r = 0; r < 16; r += 2) { const unsigned w = cvtpk(o[r], o[r + 1]); op[(size_t)crow(r, hi) * RW] = (bf16)(w & 0xffffu); op[(size_t)crow(r + 1, hi) * RW] = (bf16)(w >> 16); } }
#pragma unroll
        for (int db = 0; db < 4; ++db) {
#pragma unroll
            for (int g = 0; g < 4; ++g) { const f32x4 gg = *(const LAS f32x4*)(G + 32 * db + 8 * g + 4 * hi);
                S[db][4 * g] *= gg[0]; S[db][4 * g + 1] *= gg[1]; S[db][4 * g + 2] *= gg[2]; S[db][4 * g + 3] *= gg[3]; }
        }
#pragma unroll
        for (int sg = 0; sg < 4; ++sg) {
            const LAS unsigned char* vb = vimg + vlo + ((2 * sg + hi) * 4 + eb) * 512;
            const bf16x8 vf = cat8(vtr(vb), vtr(vb + 4 * 64));
#pragma unroll
            for (int db = 0; db < 4; ++db) {
                const bf16x8 ka = *(const LAS bf16x8*)(KLT + (32 * db + r32) * KLT_P + 16 * sg + 8 * hi);
                S[db] = __builtin_amdgcn_mfma_f32_32x32x16_bf16(ka, vf, S[db], 0, 0, 0);
            }
        }
        LGKM_BAR();
        if (n + 1 < 32) HG_PREP();
        WAITV0_BAR();
    }
#undef HG_LOAD
#undef HG_PREP
    if (th == 0) { float* sp = sout + (size_t)bh * 16384 + 32 * eb + r32;
#pragma unroll
        for (int db = 0; db < 4; ++db)
#pragma unroll
            for (int r = 0; r < 16; ++r) sp[(size_t)(32 * db + crow(r, hi)) * 128] = S[db][r]; }
}
}

namespace dec {
constexpr int PART = 264;
__device__ __forceinline__ void unit(int bs, int h, const bf16* Q, const bf16* K, const bf16* V, const float* ck, const float* cv, const int* ptab, bf16* MIX, float lam, const float* gsub, ldsp_t lds) {
    int tid = threadIdx.x; asm volatile("" : "+v"(tid));
    const int lane = tid & 63, wid = __builtin_amdgcn_readfirstlane(tid >> 6);
    const size_t row = (size_t)MP + bs;
    LAS float* P = (LAS float*)lds;
    const int c4 = 4 * (lane & 31), half = lane >> 5, mymap = (lane >> 4) & 1;
    f32x4 q4; { const u32x2v qw = *(const u32x2v*)(Q + row * AW + h * 128 + c4); q4 = (f32x4){bflo(qw.x), bfhi(qw.x), bflo(qw.y), bfhi(qw.y)}; }
    float mrun = -1e30f, lrun = 0.f; f32x4 o0 = (f32x4){0.f, 0.f, 0.f, 0.f}, o1 = o0;
    for (int pg = 0; pg < 2; ++pg) {
        const int pid = ptab[bs * NPAGES + 2 * wid + pg];
        const float* kp = ck + ((size_t)pid * PAGE + half) * 512 + h * 128 + c4;
        const float* vp = cv + ((size_t)pid * PAGE + half) * 512 + h * 128 + c4;
        for (int t = 0; t < 8; ++t) {
            f32x4 kk[8], vv[8];
#pragma unroll
            for (int i = 0; i < 8; ++i) kk[i] = __builtin_nontemporal_load((const f32x4*)(kp + (size_t)(16 * t + 2 * i) * 512));
#pragma unroll
            for (int i = 0; i < 8; ++i) vv[i] = __builtin_nontemporal_load((const f32x4*)(vp + (size_t)(16 * t + 2 * i) * 512));
            float pr[8];
#pragma unroll
            for (int i = 0; i < 8; ++i) pr[i] = (kk[i][0] * q4[0] + kk[i][1] * q4[1]) + (kk[i][2] * q4[2] + kk[i][3] * q4[3]);
            float a4[4], a2[2], s;
            { const bool up = (lane & 8) != 0;
#pragma unroll
              for (int i = 0; i < 4; ++i) { const float keep = up ? pr[i + 4] : pr[i], send = up ? pr[i] : pr[i + 4]; a4[i] = keep + __shfl_xor(send, 8); } }
            { const bool up = (lane & 4) != 0;
#pragma unroll
              for (int i = 0; i < 2; ++i) { const float keep = up ? a4[i + 2] : a4[i], send = up ? a4[i] : a4[i + 2]; a2[i] = keep + __shfl_xor(send, 4); } }
            { const bool up = (lane & 2) != 0; const float keep = up ? a2[1] : a2[0], send = up ? a2[0] : a2[1]; s = keep + __shfl_xor(send, 2); }
            s += __shfl_xor(s, 1);
            float mt = s; mt = fmaxf(mt, __shfl_xor(mt, 2)); mt = fmaxf(mt, __shfl_xor(mt, 4)); mt = fmaxf(mt, __shfl_xor(mt, 8)); mt = fmaxf(mt, __shfl_xor(mt, 32));
            const float mnew = fmaxf(mrun, mt), al = ex2(mrun - mnew), p = ex2(s - mnew);
            float psum = p; psum += __shfl_xor(psum, 2); psum += __shfl_xor(psum, 4); psum += __shfl_xor(psum, 8); psum += __shfl_xor(psum, 32);
            lrun = lrun * al + psum; mrun = mnew;
            const float al0 = __shfl(al, 0), al1 = __shfl(al, 16);
            o0 = o0 * al0; o1 = o1 * al1;
#pragma unroll
            for (int i = 0; i < 8; ++i) { const float p0 = __shfl(p, (lane & 32) + 2 * i), p1 = __shfl(p, (lane & 32) + 16 + 2 * i); o0 = o0 + vv[i] * p0; o1 = o1 + vv[i] * p1; }
        }
    }
#pragma unroll
    for (int j = 0; j < 4; ++j) { o0[j] += __shfl_xor(o0[j], 32); o1[j] += __shfl_xor(o1[j], 32); }
    { const float m0 = __shfl(mrun, 0), l0 = __shfl(lrun, 0), m1 = __shfl(mrun, 16), l1 = __shfl(lrun, 16);
      LAS float* pw = P + wid * PART;
      if (lane < 32) { *(LAS f32x4*)(pw + c4) = o0; *(LAS f32x4*)(pw + 128 + c4) = o1; }
      if (lane == 0) { pw[256] = m0; pw[257] = l0; pw[258] = m1; pw[259] = l1; } }
    if (wid == 0) {
        const u32x2v kw = *(const u32x2v*)(K + row * AW + h * 128 + c4);
        float s = (bflo(kw.x) * q4[0] + bfhi(kw.x) * q4[1]) + (bflo(kw.y) * q4[2] + bfhi(kw.y) * q4[3]);
        s += __shfl_xor(s, 1); s += __shfl_xor(s, 2); s += __shfl_xor(s, 4); s += __shfl_xor(s, 8);
        if (lane == 0) P[8 * PART] = s; if (lane == 16) P[8 * PART + 1] = s;
    }
    LGKM_BAR();
    if (wid == 0) {
        float M0 = P[8 * PART], M1 = P[8 * PART + 1]; const float sn0 = M0, sn1 = M1;
#pragma unroll
        for (int w = 0; w < 8; ++w) { M0 = fmaxf(M0, P[w * PART + 256]); M1 = fmaxf(M1, P[w * PART + 258]); }
        const float wn0 = ex2(sn0 - M0), wn1 = ex2(sn1 - M1);
        float L0 = wn0, L1 = wn1; float a[2], bq[2];
        { const bf16* vr = V + row * AW + h * 128; a[0] = wn0 * bf2f(vr[lane]); a[1] = wn0 * bf2f(vr[lane + 64]); bq[0] = wn1 * bf2f(vr[lane]); bq[1] = wn1 * bf2f(vr[lane + 64]); }
#pragma unroll
        for (int w = 0; w < 8; ++w) { const float f0 = ex2(P[w * PART + 256] - M0), f1 = ex2(P[w * PART + 258] - M1);
            L0 += f0 * P[w * PART + 257]; L1 += f1 * P[w * PART + 259];
            a[0] += f0 * P[w * PART + lane]; a[1] += f0 * P[w * PART + lane + 64]; bq[0] += f1 * P[w * PART + 128 + lane]; bq[1] += f1 * P[w * PART + 128 + lane + 64]; }
        const float i0 = 1.0f / L0, i1 = lam / L1;
        const float y0 = a[0] * i0 - bq[0] * i1, y1 = a[1] * i0 - bq[1] * i1;
        float ss = y0 * y0 + y1 * y1;
#pragma unroll
        for (int o = 1; o < 64; o <<= 1) ss += __shfl_xor(ss, o);
        const float rs = (1.0f - LAM_INIT) / sqrtf(ss * (1.0f / 128.0f) + EPS);
        bf16* orow = MIX + row * D + h * 128;
        orow[lane] = (bf16)f2bf(y0 * rs * gsub[lane]); orow[lane + 64] = (bf16)f2bf(y1 * rs * gsub[lane + 64]);
    }
    LGKM_BAR();
}
}

__device__ __forceinline__ void hgrn_step(int bs, int h, const bf16* RQ, const bf16* RK, const bf16* RV, const float* LOGF, const float* S0, float* Sout, bf16* OREC, ldsp_t lds) {
    int tid = threadIdx.x; asm volatile("" : "+v"(tid)); const size_t row = (size_t)MP + bs; const size_t g0 = row * RW + h * 128;
    LAS float* qs = (LAS float*)lds; LAS float* ks = qs + 128; LAS float* fs = qs + 256; LAS float* po = qs + 384;
    if (tid < 128) { qs[tid] = bf2f(RQ[g0 + tid]); ks[tid] = bf2f(RK[g0 + tid]); fs[tid] = fexpn(LOGF[g0 + tid]); }
    const int e = tid & 127, dq = tid >> 7;
    const float v = bf2f(RV[g0 + e]);
    LGKM_BAR();
    const size_t sb = ((size_t)(bs * 4 + h) * 128 + 32 * dq) * 128 + e;
    float acc = 0.f;
#pragma unroll 8
    for (int i = 0; i < 32; ++i) { const int dd = 32 * dq + i; const float sn = fs[dd] * S0[sb + (size_t)i * 128] + ks[dd] * v; Sout[sb + (size_t)i * 128] = sn; acc += qs[dd] * sn; }
    po[dq * 128 + e] = acc;
    LGKM_BAR();
    if (tid < 128) OREC[g0 + tid] = (bf16)f2bf((po[tid] + po[128 + tid]) + (po[256 + tid] + po[384 + tid]));
    LGKM_BAR();
}


constexpr size_t MiB = 1u << 20;
constexpr size_t WS_CTL = 0, CTL_ZERO_BYTES = 1 * MiB;
constexpr size_t WS_WIN = 2 * MiB, WS_WOUT = 9 * MiB, WS_WUP = 11 * MiB, WS_WDN = 19 * MiB, WS_WG = 27 * MiB, WS_WP = 29 * MiB;
constexpr size_t WS_XN = 32 * MiB, WS_PB = 66 * MiB, WS_Q = 76 * MiB, WS_K = 93 * MiB, WS_V = 110 * MiB, WS_RQ = 127 * MiB, WS_RK = 144 * MiB, WS_RV = 161 * MiB, WS_RG = 178 * MiB;
constexpr size_t WS_LOGF = 195 * MiB, WS_OREC = 228 * MiB, WS_MIX = 245 * MiB, WS_X1 = 278 * MiB, WS_A2 = 343 * MiB, WS_A3 = 376 * MiB, WS_PJ = 409 * MiB, WS_H = 442 * MiB;
constexpr size_t WS_SSP1 = 572 * MiB, WS_SSP3 = 574 * MiB, WS_END = 576 * MiB;
static_assert(WS_K - WS_Q == 17 * MiB && WS_V - WS_K == 17 * MiB && WS_RQ - WS_V == 17 * MiB && WS_RK - WS_RQ == 17 * MiB && WS_RV - WS_RK == 17 * MiB && WS_RG - WS_RV == 17 * MiB, "EpiIn buffer stride");
static_assert(WS_XN + (size_t)MT * D * 2 <= WS_PB && WS_PB + (size_t)MT * PLE * 2 <= WS_Q && WS_Q + (size_t)MT * AW * 2 <= WS_K && WS_LOGF + (size_t)MT * RW * 4 <= WS_OREC &&
              WS_MIX + (size_t)MT * D * 2 <= WS_X1 && WS_X1 + (size_t)MT * D * 4 <= WS_A2 && WS_PJ + (size_t)MT * D * 2 <= WS_H && WS_H + (size_t)MT * FF * 2 <= WS_SSP1 && WS_SSP1 + (size_t)MT * 64 <= WS_SSP3, "d_ws map");
constexpr int CW_QA = 64, CW_QD = 128;
constexpr int CW_BAR = 4096;
static_assert((CW_BAR + XCD_BAR_WORDS) * 4 <= (int)CTL_ZERO_BYTES, "CTL words inside the memset region");

constexpr int RING_OFF = 0, RING_BYTES = 131072;
constexpr int LDSCTL_OFF = RING_BYTES, MISC_OFF = LDSCTL_OFF + 320;
constexpr int LDS_BYTES = 147456;
constexpr int NWAVES = 8;
constexpr int N_PHASES = 9;

struct Frame {
    LAS unsigned char* lds; volatile LAS unsigned* MISC; gu32* ctl;
    int tid, lane, wave, vcu, G;
};

__device__ __forceinline__ float wave_sum(float v) {
#pragma unroll
    for (int o = 1; o < 64; o <<= 1) v += __shfl_xor(v, o);
    return v;
}
__device__ __forceinline__ void p0_transpose_item(const float* W, int K, int N, bf16* WT, const float* kscale, LAS float* scr, int item, int lane) {
    const int nblk = N / 32, kb = item / nblk, nb = item % nblk, k0 = 64 * kb, n0 = 32 * nb;
#pragma unroll 8
    for (int i = 0; i < 32; ++i) { const int kk = 2 * i + (lane >> 5); float w = W[(size_t)(k0 + kk) * N + n0 + (lane & 31)]; if (kscale) w *= kscale[k0 + kk]; scr[kk * 33 + (lane & 31)] = w; }
    LDS_WAIT(); asm volatile("" ::: "memory");
    const int c = lane & 7;
#pragma unroll
    for (int j = 0; j < 4; ++j) { const int n = (lane >> 3) + 8 * j; const LAS float* s = scr + (8 * c) * 33 + n;
        v4u o; o.x = pk2(s[0 * 33], s[1 * 33]); o.y = pk2(s[2 * 33], s[3 * 33]); o.z = pk2(s[4 * 33], s[5 * 33]); o.w = pk2(s[6 * 33], s[7 * 33]);
        *(GAS v4u*)(WT + (size_t)(n0 + n) * K + k0 + 8 * c) = o; }
    LDS_WAIT(); asm volatile("" ::: "memory");
}
__device__ __forceinline__ void rms_row_to_bf16(const float* xrow, const float* g, bf16* orow, int lane) {
    const f32x4* xr = (const f32x4*)xrow + lane; const f32x4* gr = (const f32x4*)g + lane;
    f32x4 v[4]; float s = 0.f;
#pragma unroll
    for (int j = 0; j < 4; ++j) { v[j] = xr[64 * j]; s += (v[j].x * v[j].x + v[j].y * v[j].y) + (v[j].z * v[j].z + v[j].w * v[j].w); }
    const float r = 1.0f / sqrtf(wave_sum(s) * (1.f / D) + EPS);
    unsigned long long* o8 = (unsigned long long*)orow + lane;
#pragma unroll
    for (int j = 0; j < 4; ++j) { const f32x4 gg = gr[64 * j]; o8[64 * j] = (unsigned long long)pk2(v[j].x * r * gg.x, v[j].y * r * gg.y) | ((unsigned long long)pk2(v[j].z * r * gg.z, v[j].w * r * gg.w) << 32); }
}


struct Args { const float* in[24]; float* out; unsigned char* ws; int ph_lo, ph_hi, li, pad; };

#define x_prompt (args.in[0])
#define x_sample (args.in[1])
#define cache_k (args.in[2])
#define cache_v (args.in[3])
#define state0 (args.in[4])
#define ptab ((const int*)args.in[5])
#define p_prompt (args.in[6])
#define p_sample (args.in[7])
#define w_in (args.in[8])
#define g_subln (args.in[13])
#define hgrn_lb (args.in[14])
#define g_rec (args.in[15])
#define w_out (args.in[16])
#define g_mix (args.in[17])
#define g_ffn (args.in[18])
#define w_up (args.in[19])
#define w_down (args.in[20])
#define w_gate (args.in[21])
#define w_proj (args.in[22])
#define g_final (args.in[23])
#define OUTP (args.out)
#define WSP(T, off) ((T*)(args.ws + (off)))
#define WinT WSP(bf16, WS_WIN)
#define WoutT WSP(bf16, WS_WOUT)
#define WupT WSP(bf16, WS_WUP)
#define WdnT WSP(bf16, WS_WDN)
#define WgT WSP(bf16, WS_WG)
#define WpT WSP(bf16, WS_WP)
#define XN WSP(bf16, WS_XN)
#define PB WSP(bf16, WS_PB)
#define Qb WSP(bf16, WS_Q)
#define Kb WSP(bf16, WS_K)
#define Vb WSP(bf16, WS_V)
#define RQ WSP(bf16, WS_RQ)
#define RK WSP(bf16, WS_RK)
#define RV WSP(bf16, WS_RV)
#define RG WSP(bf16, WS_RG)
#define LOGF WSP(float, WS_LOGF)
#define OREC WSP(bf16, WS_OREC)
#define MIX WSP(bf16, WS_MIX)
#define X1 WSP(float, WS_X1)
#define A2 WSP(bf16, WS_A2)
#define A3 WSP(bf16, WS_A3)
#define PJ WSP(bf16, WS_PJ)
#define HB WSP(bf16, WS_H)
#define SSP1 WSP(float, WS_SSP1)
#define SSP3 WSP(float, WS_SSP3)

__global__ void __launch_bounds__(NWAVES * 64, 2) mk_fwd(Args args) {
    extern __shared__ __attribute__((aligned(16))) unsigned char lds_raw[];
    Frame F;
    F.lds = (LAS unsigned char*)lds_raw;
    F.MISC = (volatile LAS unsigned*)(F.lds + MISC_OFF);
    F.tid = threadIdx.x; F.lane = F.tid & 63; F.wave = __builtin_amdgcn_readfirstlane(F.tid >> 6);
    F.G = gridDim.x; { const int bx = blockIdx.x; F.vcu = (F.G % 8 == 0) ? (bx % 8) * (F.G / 8) + bx / 8 : bx; }
    F.ctl = (gu32*)(args.ws + WS_CTL);
    for (int u = F.tid; u < (LDS_BYTES - LDSCTL_OFF) / 4; u += NWAVES * 64) ((LAS unsigned*)(F.lds + LDSCTL_OFF))[u] = 0u;
    __syncthreads();
    if (F.wave == 0) {
        const float a = args.in[9][F.lane] * args.in[10][F.lane], b = args.in[11][F.lane] * args.in[12][F.lane];
        const float lam = fexpn(wave_sum(a)) - fexpn(wave_sum(b)) + LAM_INIT;
        if (F.lane == 0) F.MISC[4] = __float_as_uint(lam);
    }
    XcdBarrier bar; bar.bar = (unsigned*)(F.ctl + CW_BAR); bar.x = 0; bar.st = nullptr;
    if (MK_N_LAUNCHES == 1) bar = xcd_barrier_post((unsigned*)(F.ctl + CW_BAR), F.MISC + 8);
    __syncthreads();
#define GRID_BAR() do { if (MK_N_LAUNCHES == 1) xcd_barrier(bar); } while (0)
    const int lo = args.ph_lo, hi = args.ph_hi;
#ifndef PH_MASK
#define PH_MASK 0x1ff
#endif
#define IN(k) ((((PH_MASK) >> (k)) & 1) && lo <= (k) && (k) < hi)
#define BOTH(k) (IN(k) && IN((k) + 1))
    const int gw = F.vcu * NWAVES + F.wave, NGW = F.G * NWAVES;

    if (IN(0)) {
        int tl_ = threadIdx.x; asm volatile("" : "+v"(tl_)); const int lane = tl_ & 63;
        LAS float* scr = (LAS float*)(F.lds + RING_OFF + F.wave * 16384);
        constexpr int I_IN = (D / 64) * (NIN / 32), I_O = (D / 64) * (D / 32), I_UP = (D / 64) * (FF / 32), I_DN = (FF / 64) * (D / 32), I_G = I_O, I_P = (PLE / 64) * (D / 32);
        constexpr int NITEMS = I_IN + I_O + I_UP + I_DN + I_G + I_P;
        for (int it = gw; it < NITEMS; it += NGW) {
            int r = it;
            if (r < I_IN) { p0_transpose_item(w_in, D, NIN, WinT, nullptr, scr, r, lane); continue; } r -= I_IN;
            if (r < I_O) { p0_transpose_item(w_out, D, D, WoutT, nullptr, scr, r, lane); continue; } r -= I_O;
            if (r < I_UP) { p0_transpose_item(w_up, D, FF, WupT, g_ffn, scr, r, lane); continue; } r -= I_UP;
            if (r < I_DN) { p0_transpose_item(w_down, FF, D, WdnT, nullptr, scr, r, lane); continue; } r -= I_DN;
            if (r < I_G) { p0_transpose_item(w_gate, D, D, WgT, nullptr, scr, r, lane); continue; } r -= I_G;
            p0_transpose_item(w_proj, PLE, D, WpT, nullptr, scr, r, lane);
        }
        for (int m = gw; m < MT; m += NGW) {
            if (m < MP + MS) {
                const float* xr = m < MP ? x_prompt + (size_t)m * D : x_sample + (size_t)(m - MP) * D;
                rms_row_to_bf16(xr, g_mix, XN + (size_t)m * D, lane);
                const float* pr = m < MP ? p_prompt + (size_t)m * PLE : p_sample + (size_t)(m - MP) * PLE;
                const f32x4 pv = ((const f32x4*)pr)[lane];
                ((unsigned long long*)(PB + (size_t)m * PLE))[lane] = (unsigned long long)pk2(pv.x, pv.y) | ((unsigned long long)pk2(pv.z, pv.w) << 32);
            } else {
                unsigned long long* o8 = (unsigned long long*)(XN + (size_t)m * D) + lane;
#pragma unroll
                for (int j = 0; j < 4; ++j) o8[64 * j] = 0ull;
                ((unsigned long long*)(PB + (size_t)m * PLE))[lane] = 0ull;
            }
        }
        if (BOTH(0)) GRID_BAR();
    }

    if (IN(1)) {
        { pg8::Gemm g{XN, WinT, MT, NIN, D}; pg8::StaticOrder S; S.init(MT, NIN, F.G, (int)blockIdx.x);
          pg8::EpiIn E{Qb, LOGF, OUTP, hgrn_lb};
          pg8::gemm_phase<pg8::EpiIn, pg8::StaticOrder, true, true>(F.lds + RING_OFF, g, S, E); }
        { pg8::Gemm g{PB, WpT, MT, D, PLE}; pg8::StaticOrder S; S.init(MT, D, F.G, (int)(F.G - 1 - blockIdx.x));
          pg8::EpiBf E{PJ, D};
          pg8::gemm_phase<pg8::EpiBf, pg8::StaticOrder, true, true>(F.lds + RING_OFF, g, S, E); }
        if (BOTH(1)) GRID_BAR();
    }

    if (IN(2)) {
        const float lam = __uint_as_float(F.MISC[4]);
#ifndef SKIP_HG
        if (blockIdx.x < 32) hg::unit((int)blockIdx.x, RQ, RK, RV, LOGF, OREC, OUTP + OUT_SP, F.lds + RING_OFF);
#endif
#ifndef SKIP_ATT
        for (;;) {
            if (F.tid == 0) F.MISC[0] = __hip_atomic_fetch_add(F.ctl + CW_QA, 1u, RLX_AGENT);
            LGKM_BAR();
            const int idx = (int)F.MISC[0];
            if (idx >= 512) break;
            const int qblk = 15 - (idx >> 5), bh = idx & 31;
            att::unit(bh >> 2, bh & 3, qblk, Qb, Kb, Vb, MIX, lam, g_subln, F.lds + RING_OFF);
        }
#endif
#ifndef SKIP_DEC
        for (;;) {
            if (F.tid == 0) F.MISC[1] = __hip_atomic_fetch_add(F.ctl + CW_QD, 1u, RLX_AGENT);
            LGKM_BAR();
            const int idx = (int)F.MISC[1];
            if (idx >= 512) break;
            dec::unit(idx >> 2, idx & 3, Qb, Kb, Vb, cache_k, cache_v, ptab, MIX, lam, g_subln, F.lds + RING_OFF);
        }
#endif
        for (int it = F.vcu; it < 512; it += F.G) hgrn_step(it >> 2, it & 3, RQ, RK, RV, LOGF, state0, OUTP + OUT_SS, OREC, F.lds + RING_OFF);
        if (BOTH(2)) GRID_BAR();
    }

    if (IN(3)) {
        int tl_ = threadIdx.x; asm volatile("" : "+v"(tl_)); const int lane = tl_ & 63;
        for (int m = gw; m < MP + MS; m += NGW) {
            const v4u ow = ((const v4u*)(OREC + (size_t)m * RW))[lane]; const v4u gw4 = ((const v4u*)(RG + (size_t)m * RW))[lane];
            float o[8] = {bflo(ow.x), bfhi(ow.x), bflo(ow.y), bfhi(ow.y), bflo(ow.z), bfhi(ow.z), bflo(ow.w), bfhi(ow.w)};
            const float gt[8] = {bflo(gw4.x), bfhi(gw4.x), bflo(gw4.y), bfhi(gw4.y), bflo(gw4.z), bfhi(gw4.z), bflo(gw4.w), bfhi(gw4.w)};
            float s = 0.f;
#pragma unroll
            for (int j = 0; j < 8; ++j) s += o[j] * o[j];
            const float r = 1.0f / sqrtf(wave_sum(s) * (1.f / RW) + EPS);
            const f32x4 g0 = ((const f32x4*)g_rec)[2 * lane], g1 = ((const f32x4*)g_rec)[2 * lane + 1];
            v4u w; w.x = pk2(o[0] * r * g0.x * gt[0], o[1] * r * g0.y * gt[1]); w.y = pk2(o[2] * r * g0.z * gt[2], o[3] * r * g0.w * gt[3]);
            w.z = pk2(o[4] * r * g1.x * gt[4], o[5] * r * g1.y * gt[5]); w.w = pk2(o[6] * r * g1.z * gt[6], o[7] * r * g1.w * gt[7]);
            ((v4u*)(MIX + (size_t)m * D + AW))[lane] = w;
        }
        if (BOTH(3)) GRID_BAR();
    }

    if (IN(4)) {
        pg8::Gemm g{MIX, WoutT, MT, D, D}; pg8::StaticOrder S; S.init(MT, D, F.G, (int)blockIdx.x);
        pg8::EpiOut E{x_prompt, x_sample, X1, A2, SSP1};
        pg8::gemm_phase<pg8::EpiOut, pg8::StaticOrder, true, true>(F.lds + RING_OFF, g, S, E);
        if (BOTH(4)) GRID_BAR();
    }
    if (IN(5)) {
        pg8::Gemm g{A2, WupT, MT, FF, D}; pg8::StaticOrder S; S.init(MT, FF, F.G, (int)blockIdx.x);
        pg8::EpiUp E{HB, FF};
        pg8::gemm_phase<pg8::EpiUp, pg8::StaticOrder, true, true>(F.lds + RING_OFF, g, S, E);
        if (BOTH(5)) GRID_BAR();
    }
    if (IN(6)) {
        pg8::Gemm g{HB, WdnT, MT, D, FF}; pg8::StaticOrder S; S.init(MT, D, F.G, (int)blockIdx.x);
        pg8::EpiDown E{X1, A3, SSP1};
        pg8::gemm_phase<pg8::EpiDown, pg8::StaticOrder, true, true>(F.lds + RING_OFF, g, S, E);
        if (BOTH(6)) GRID_BAR();
    }
    if (IN(7)) {
        pg8::Gemm g{A3, WgT, MT, D, D}; pg8::StaticOrder S; S.init(MT, D, F.G, (int)blockIdx.x);
        pg8::EpiGate E{X1, PJ, OUTP, SSP3};
        pg8::gemm_phase<pg8::EpiGate, pg8::StaticOrder, true, true>(F.lds + RING_OFF, g, S, E);
        if (BOTH(7)) GRID_BAR();
    }
    if (IN(8)) {
        int tl_ = threadIdx.x; asm volatile("" : "+v"(tl_)); const int lane = tl_ & 63;
        for (int m = gw; m < MP + MS; m += NGW) {
            float* yr = OUTP + (m < MP ? OUT_YP + (size_t)m * D : OUT_YS + (size_t)(m - MP) * D);
            const f32x4* sp = (const f32x4*)(SSP3 + (size_t)m * 16);
            const f32x4 ps = (sp[0] + sp[1]) + (sp[2] + sp[3]);
            const float r = 1.0f / sqrtf(((ps.x + ps.y) + (ps.z + ps.w)) * (1.f / D) + EPS);
            f32x4* y4 = (f32x4*)yr + lane; const f32x4* g4 = (const f32x4*)g_final + lane;
#pragma unroll
            for (int j = 0; j < 4; ++j) { const f32x4 v = y4[64 * j], gg = g4[64 * j]; y4[64 * j] = v * r * gg; }
        }
    }
#undef IN
#undef BOTH
#undef GRID_BAR
}

#undef x_prompt
#undef x_sample
#undef cache_k
#undef cache_v
#undef state0
#undef ptab
#undef p_prompt
#undef p_sample
#undef w_in
#undef g_subln
#undef hgrn_lb
#undef g_rec
#undef w_out
#undef g_mix
#undef g_ffn
#undef w_up
#undef w_down
#undef w_gate
#undef w_proj
#undef g_final
#undef OUTP
#undef WSP
#undef WinT
#undef WoutT
#undef WupT
#undef WdnT
#undef WgT
#undef WpT
#undef XN
#undef PB
#undef Qb
#undef Kb
#undef Vb
#undef RQ
#undef RK
#undef RV
#undef RG
#undef LOGF
#undef OREC
#undef MIX
#undef X1
#undef A2
#undef A3
#undef PJ
#undef HB
#undef SSP1
#undef SSP3
extern "C" void kernel_launch(void* const* d_in, const int* in_sizes, int n_in, void* d_out, int out_size, void* d_ws, size_t ws_size, hipStream_t stream) {
    static int grid = 0;
    if (grid == 0) {
        if (n_in != 24 || in_sizes[0] != MP * D || (size_t)out_size != OUT_END || ws_size < WS_END) {
            fprintf(stderr, "kernel_launch: unexpected shapes: n_in %d, in0 %d, out %d, ws %zu; nothing launched\n", n_in, n_in > 0 ? in_sizes[0] : -1, out_size, ws_size); grid = -1; return; }
        int dev = 0, cus = 0, per_cu = 0;
        if (hipGetDevice(&dev) != hipSuccess || hipDeviceGetAttribute(&cus, hipDeviceAttributeMultiprocessorCount, dev) != hipSuccess) { grid = -1; return; }
        if (hipFuncSetAttribute((const void*)mk_fwd, hipFuncAttributeMaxDynamicSharedMemorySize, LDS_BYTES) != hipSuccess) { fprintf(stderr, "kernel_launch: hipFuncSetAttribute failed\n"); grid = -1; return; }
        if (hipOccupancyMaxActiveBlocksPerMultiprocessor(&per_cu, (const void*)mk_fwd, NWAVES * 64, LDS_BYTES) != hipSuccess || per_cu < 1) {
            fprintf(stderr, "kernel_launch: occupancy query reports %d workgroups per CU; nothing launched\n", per_cu); (void)hipGetLastError(); grid = -1; return; }
        (void)hipGetLastError();
        grid = cus;
    }
    if (grid < 0) return;
    if (hipMemsetAsync((char*)d_ws + WS_CTL, 0, CTL_ZERO_BYTES, stream) != hipSuccess) return;
    Args a{};
    for (int i = 0; i < 24; ++i) a.in[i] = (const float*)d_in[i];
    a.out = (float*)d_out; a.ws = (unsigned char*)d_ws;
    if (MK_N_LAUNCHES == 1) {
        a.ph_lo = 0; a.ph_hi = N_PHASES; a.li = 0;
        hipLaunchKernelGGL(mk_fwd, dim3(grid), dim3(NWAVES * 64), LDS_BYTES, stream, a);
    } else {
        for (int li = 0; li < N_PHASES; ++li) { a.ph_lo = li; a.ph_hi = li + 1; a.li = li; hipLaunchKernelGGL(mk_fwd, dim3(grid), dim3(NWAVES * 64), LDS_BYTES, stream, a); }
    }
}
```

```cpp
#include <hip/hip_runtime.h>
#include <hip/hip_bf16.h>
#include <cstdio>
#include <cstdint>
#include <cmath>

#ifndef MK_N_LAUNCHES
#define MK_N_LAUNCHES 1
#endif

constexpr int D = 1024, NB = 8, SEQ = 2048, MP = NB * SEQ, MS = 128, MT = 16640  ;
constexpr int NIN = 3584, FF = 4096, PLE = 256, AW = 512, RW = 512, NPAGES = 16, PAGE = 128;
constexpr float EPS = 1e-6f;
constexpr float LOG2E = 1.4426950408889634f;
constexpr float QSCALE = 0.125f * LOG2E;
constexpr float LAM_INIT = 0.2f;
constexpr size_t OUT_YP = 0, OUT_YS = OUT_YP + (size_t)MP * D, OUT_KP = OUT_YS + (size_t)MS * D, OUT_VP = OUT_KP + (size_t)MP * AW, OUT_SP = OUT_VP + (size_t)MP * AW,
                 OUT_KS = OUT_SP + (size_t)NB * 4 * 128 * 128, OUT_VS = OUT_KS + (size_t)MS * AW, OUT_SS = OUT_VS + (size_t)MS * AW, OUT_END = OUT_SS + (size_t)MS * 4 * 128 * 128;

namespace pg8 {
#define PG8_LAS __attribute__((address_space(3)))
typedef unsigned short bf16_t;
typedef short bf16x8 __attribute__((ext_vector_type(8)));
typedef float f32x4 __attribute__((ext_vector_type(4)));
typedef unsigned u32x4 __attribute__((ext_vector_type(4)));
typedef unsigned u32x2 __attribute__((ext_vector_type(2)));
constexpr int BM = 256, BK = 64, HALF = 128, HTB = HALF * BK * 2  , STAGE_BYTES = 8 * HTB, NXCD = 8, WGM = 8;

__host__ __device__ __forceinline__ int lds_byte(int r, int c) { const int st = (r >> 4) * 2 + (c >> 5), rr = r & 15, cc = c & 31, ob = rr * 64 + cc * 2; return st * 1024 + (ob ^ (((ob >> 9) & 1) << 5)); }
__host__ __device__ __forceinline__ void stage_rc(int b, int& R, int& C) { const int st = b / 1024, sb = b % 1024, swz = sb ^ (((sb >> 9) & 1) << 5); R = (st >> 1) * 16 + swz / 64; C = (st & 1) * 32 + (swz % 64) / 2; }
__host__ __device__ __forceinline__ int perm32(int rho) { const int n = rho >> 4, i = rho & 15; return 8 * (i >> 2) + 4 * n + (i & 3); }

struct Unit { int pm, pn; };
struct Gemm { const bf16_t* A; const bf16_t* Bt; int M, N, K; };

struct StaticOrder {
    int nM, nN, nwg, G, c;
    __host__ __device__ void init(int M, int N, int G_, int c_) { nM = M / BM; nN = N / BM; nwg = nM * nN; G = G_; c = c_; }
    __host__ __device__ bool next(int i, Unit& u) const {
        const long L = (long)i * G + c; if (L >= nwg) return false;
        int wgid = (int)L; { const int q = nwg / NXCD, r = nwg % NXCD, xcd = wgid % NXCD, off = wgid / NXCD; wgid = (xcd < r ? xcd * (q + 1) : r * (q + 1) + (xcd - r) * q) + off; }
        const int nig = WGM * nN, gid = wgid / nig, fm = gid * WGM, gsz = (nM - fm) < WGM ? (nM - fm) : WGM;
        u.pm = fm + ((wgid % nig) % gsz); u.pn = (wgid % nig) / gsz; return true;
    }
    __device__ __forceinline__ void a_ready(const Unit&) const {}
    __device__ __forceinline__ void done(const Unit&) const {}
};

__device__ __forceinline__ unsigned cvt_pk_bf16(float lo, float hi) { unsigned r; asm volatile("v_cvt_pk_bf16_f32 %0, %1, %2" : "=v"(r) : "v"(lo), "v"(hi)); return r; }
__device__ __forceinline__ u32x4 pack8(const f32x4 v0, const f32x4 v1) { u32x4 w; w.x = cvt_pk_bf16(v0[0], v0[1]); w.y = cvt_pk_bf16(v0[2], v0[3]); w.z = cvt_pk_bf16(v1[0], v1[1]); w.w = cvt_pk_bf16(v1[2], v1[3]); return w; }
__device__ __forceinline__ float fexp(float x) { return __builtin_amdgcn_exp2f(x * 1.4426950408889634f); }
__device__ __forceinline__ float frcp(float x) { return __builtin_amdgcn_rcpf(x); }
__device__ __forceinline__ float sigmoidf_(float x) { return frcp(1.0f + fexp(-x)); }
__device__ __forceinline__ float siluf_(float x) { return x * sigmoidf_(x); }
__device__ __forceinline__ f32x4 map4_silu(f32x4 v) { return (f32x4){siluf_(v[0]), siluf_(v[1]), siluf_(v[2]), siluf_(v[3])}; }

struct EpiIn {
    static constexpr bool PERM = true, AFTER_DRAIN = false;
    bf16_t* Q0; float* LOGF; float* out; const float* hlb;
    static constexpr size_t BUFSTRIDE = (size_t)17 * 1024 * 1024 / 2;
    __device__ __forceinline__ void operator()(const f32x4 (&acc)[2][2][4][2], const Unit& u, int wr, int wc, int fr, int fq) const {
        const int type = u.pn >> 1;
        const int cb = (u.pn & 1) * 256 + wc * 32 + 8 * fq;
        const int row0 = u.pm * BM + wr * 64 + fr;
        const bool prow = u.pm < 64;
        if (type == 0 || type == 3 || type == 5 || type == 6) {
            bf16_t* base = Q0 + (size_t)type * BUFSTRIDE;
#pragma unroll
            for (int ai = 0; ai < 2; ++ai)
#pragma unroll
                for (int m = 0; m < 4; ++m) { bf16_t* rowp = base + (size_t)(row0 + ai * HALF + m * 16) * 512 + cb;
#pragma unroll
                    for (int bj = 0; bj < 2; ++bj) { f32x4 v0 = acc[ai][bj][m][0], v1 = acc[ai][bj][m][1];
                        if (type == 0) { v0 = v0 * QSCALE; v1 = v1 * QSCALE; }
                        else if (type != 5) { v0 = map4_silu(v0); v1 = map4_silu(v1); }
                        *(u32x4*)(rowp + bj * HALF) = pack8(v0, v1); } }
        } else if (type == 1 || type == 2) {
            bf16_t* base = Q0 + (size_t)type * BUFSTRIDE;
            float* ob = out + (type == 1 ? (prow ? OUT_KP : OUT_KS) : (prow ? OUT_VP : OUT_VS));
#pragma unroll
            for (int ai = 0; ai < 2; ++ai)
#pragma unroll
                for (int m = 0; m < 4; ++m) { const int row = row0 + ai * HALF + m * 16; bf16_t* rowp = base + (size_t)row * 512 + cb;
                    const bool ok = prow || ai == 0; float* orow = ob + (size_t)(prow ? row : row - MP) * 512 + cb;
#pragma unroll
                    for (int bj = 0; bj < 2; ++bj) { const f32x4 v0 = acc[ai][bj][m][0], v1 = acc[ai][bj][m][1];
                        *(u32x4*)(rowp + bj * HALF) = pack8(v0, v1);
                        if (ok) { *(f32x4*)(orow + bj * HALF) = v0; *(f32x4*)(orow + bj * HALF + 4) = v1; } } }
        } else {
#pragma unroll
            for (int bj = 0; bj < 2; ++bj) {
                f32x4 lb[2];
#pragma unroll
                for (int n = 0; n < 2; ++n) { const f32x4 l0 = *(const f32x4*)(hlb + cb + bj * HALF + 4 * n), l1 = *(const f32x4*)(hlb + 512 + cb + bj * HALF + 4 * n);
#pragma unroll
                    for (int j = 0; j < 4; ++j) lb[n][j] = frcp(1.0f + fexp(l1[j] - l0[j])); }
#pragma unroll
                for (int ai = 0; ai < 2; ++ai)
#pragma unroll
                    for (int m = 0; m < 4; ++m) { const size_t ro = (size_t)(row0 + ai * HALF + m * 16) * 512 + cb + bj * HALF; f32x4 lf[2], kk[2];
#pragma unroll
                        for (int n = 0; n < 2; ++n)
#pragma unroll
                            for (int j = 0; j < 4; ++j) { const float x = acc[ai][bj][m][n][j], e = fexp(-x), sg = frcp(1.0f + e), l = lb[n][j];
                                const float f = l + (1.0f - l) * sg; lf[n][j] = __builtin_amdgcn_logf(f) * 0.6931471805599453f; kk[n][j] = (1.0f - l) * (e * sg); }
                        *(f32x4*)(LOGF + ro) = lf[0]; *(f32x4*)(LOGF + ro + 4) = lf[1];
                        *(u32x4*)(Q0 + 4 * BUFSTRIDE + ro) = pack8(kk[0], kk[1]); }
            }
        }
    }
};

struct EpiBf {
    static constexpr bool PERM = true, AFTER_DRAIN = false;
    bf16_t* O; int ldc;
    __device__ __forceinline__ void operator()(const f32x4 (&acc)[2][2][4][2], const Unit& u, int wr, int wc, int fr, int fq) const {
        const int row0 = u.pm * BM + wr * 64 + fr, col0 = u.pn * BM + wc * 32 + 8 * fq;
#pragma unroll
        for (int ai = 0; ai < 2; ++ai)
#pragma unroll
            for (int m = 0; m < 4; ++m) { bf16_t* rowp = O + (size_t)(row0 + ai * HALF + m * 16) * ldc + col0;
#pragma unroll
                for (int bj = 0; bj < 2; ++bj) *(u32x4*)(rowp + bj * HALF) = pack8(acc[ai][bj][m][0], acc[ai][bj][m][1]); }
    }
};
struct EpiUp {
    static constexpr bool PERM = true, AFTER_DRAIN = false;
    bf16_t* O; int ldc;
    __device__ __forceinline__ void operator()(const f32x4 (&acc)[2][2][4][2], const Unit& u, int wr, int wc, int fr, int fq) const {
        const int row0 = u.pm * BM + wr * 64 + fr, col0 = u.pn * BM + wc * 32 + 8 * fq;
#pragma unroll
        for (int ai = 0; ai < 2; ++ai)
#pragma unroll
            for (int m = 0; m < 4; ++m) { bf16_t* rowp = O + (size_t)(row0 + ai * HALF + m * 16) * ldc + col0;
#pragma unroll
                for (int bj = 0; bj < 2; ++bj) { f32x4 v0 = acc[ai][bj][m][0], v1 = acc[ai][bj][m][1];
#pragma unroll
                    for (int j = 0; j < 4; ++j) { const float a = fmaxf(v0[j], 0.f), b = fmaxf(v1[j], 0.f); v0[j] = a * a; v1[j] = b * b; }
                    *(u32x4*)(rowp + bj * HALF) = pack8(v0, v1); } }
    }
};
struct EpiOut {
    static constexpr bool PERM = true, AFTER_DRAIN = false;
    const float* xp; const float* xs; float* X1; bf16_t* A2; float* SSP;
    __device__ __forceinline__ void operator()(const f32x4 (&acc)[2][2][4][2], const Unit& u, int wr, int wc, int fr, int fq) const {
        const int row0 = u.pm * BM + wr * 64 + fr, col0 = u.pn * BM + wc * 32 + 8 * fq; const bool prow = u.pm < 64;
#pragma unroll
        for (int ai = 0; ai < 2; ++ai) { if (!prow && ai == 1) break;
#pragma unroll
            for (int m = 0; m < 4; ++m) { const int row = row0 + ai * HALF + m * 16; const float* xr = (prow ? xp + (size_t)row * D : xs + (size_t)(row - MP) * D) + col0;
                float s = 0.f;
#pragma unroll
                for (int bj = 0; bj < 2; ++bj) { const f32x4 a0 = *(const f32x4*)(xr + bj * HALF), a1 = *(const f32x4*)(xr + bj * HALF + 4);
                    const f32x4 v0 = a0 + acc[ai][bj][m][0], v1 = a1 + acc[ai][bj][m][1];
                    s += (v0[0] * v0[0] + v0[1] * v0[1]) + (v0[2] * v0[2] + v0[3] * v0[3]) + (v1[0] * v1[0] + v1[1] * v1[1]) + (v1[2] * v1[2] + v1[3] * v1[3]);
                    float* o = X1 + (size_t)row * D + col0 + bj * HALF; *(f32x4*)o = v0; *(f32x4*)(o + 4) = v1;
                    *(u32x4*)(A2 + (size_t)row * D + col0 + bj * HALF) = pack8(v0, v1); }
                s += __shfl_xor(s, 16); s += __shfl_xor(s, 32);
                if (fq == 0) SSP[(size_t)row * 16 + u.pn * 4 + wc] = s; } }
    }
};
struct EpiDown {
    static constexpr bool PERM = true, AFTER_DRAIN = false;
    float* X1; bf16_t* A3; const float* SSP;
    __device__ __forceinline__ void operator()(const f32x4 (&acc)[2][2][4][2], const Unit& u, int wr, int wc, int fr, int fq) const {
        const int row0 = u.pm * BM + wr * 64 + fr, col0 = u.pn * BM + wc * 32 + 8 * fq; const bool prow = u.pm < 64;
#pragma unroll
        for (int ai = 0; ai < 2; ++ai) { if (!prow && ai == 1) break;
#pragma unroll
            for (int m = 0; m < 4; ++m) { const int row = row0 + ai * HALF + m * 16;
                const f32x4 p0 = *(const f32x4*)(SSP + (size_t)row * 16), p1 = *(const f32x4*)(SSP + (size_t)row * 16 + 4), p2 = *(const f32x4*)(SSP + (size_t)row * 16 + 8), p3 = *(const f32x4*)(SSP + (size_t)row * 16 + 12);
                const f32x4 ps = (p0 + p1) + (p2 + p3); const float ss = (ps[0] + ps[1]) + (ps[2] + ps[3]);
                const float r2 = frcp(ss * (1.0f / D) + EPS);
#pragma unroll
                for (int bj = 0; bj < 2; ++bj) { float* o = X1 + (size_t)row * D + col0 + bj * HALF;
                    const f32x4 v0 = *(const f32x4*)o + acc[ai][bj][m][0] * r2, v1 = *(const f32x4*)(o + 4) + acc[ai][bj][m][1] * r2;
                    *(f32x4*)o = v0; *(f32x4*)(o + 4) = v1;
                    *(u32x4*)(A3 + (size_t)row * D + col0 + bj * HALF) = pack8(v0, v1); } } }
    }
};
struct EpiGate {
    static constexpr bool PERM = true, AFTER_DRAIN = false;
    const float* X1; const bf16_t* PJ; float* out; float* SSP;
    __device__ __forceinline__ void operator()(const f32x4 (&acc)[2][2][4][2], const Unit& u, int wr, int wc, int fr, int fq) const {
        const int row0 = u.pm * BM + wr * 64 + fr, col0 = u.pn * BM + wc * 32 + 8 * fq; const bool prow = u.pm < 64;
#pragma unroll
        for (int ai = 0; ai < 2; ++ai) { if (!prow && ai == 1) break;
#pragma unroll
            for (int m = 0; m < 4; ++m) { const int row = row0 + ai * HALF + m * 16; float* orow = out + (prow ? OUT_YP + (size_t)row * D : OUT_YS + (size_t)(row - MP) * D) + col0;
                float s = 0.f;
#pragma unroll
                for (int bj = 0; bj < 2; ++bj) { const float* xr = X1 + (size_t)row * D + col0 + bj * HALF; const f32x4 a0 = *(const f32x4*)xr, a1 = *(const f32x4*)(xr + 4);
                    const u32x4 pj = *(const u32x4*)(PJ + (size_t)row * D + col0 + bj * HALF);
                    f32x4 v0, v1;
#pragma unroll
                    for (int j = 0; j < 4; ++j) { const unsigned w0 = pj[j >> 1], w1 = pj[2 + (j >> 1)];
                        const float pa = __uint_as_float((j & 1) ? (w0 & 0xffff0000u) : (w0 << 16)), pb = __uint_as_float((j & 1) ? (w1 & 0xffff0000u) : (w1 << 16));
                        v0[j] = a0[j] + sigmoidf_(acc[ai][bj][m][0][j]) * pa; v1[j] = a1[j] + sigmoidf_(acc[ai][bj][m][1][j]) * pb; }
                    s += (v0[0] * v0[0] + v0[1] * v0[1]) + (v0[2] * v0[2] + v0[3] * v0[3]) + (v1[0] * v1[0] + v1[1] * v1[1]) + (v1[2] * v1[2] + v1[3] * v1[3]);
                    *(f32x4*)(orow + bj * HALF) = v0; *(f32x4*)(orow + bj * HALF + 4) = v1; }
                s += __shfl_xor(s, 16); s += __shfl_xor(s, 32);
                if (fq == 0) SSP[(size_t)row * 16 + u.pn * 4 + wc] = s; } }
    }
};

template <class Epi, class Sched, bool ALIGN_EPI = false, bool SP2 = false>
__device__ __forceinline__ void gemm_phase(PG8_LAS unsigned char* lds, const Gemm g, const Sched& S, const Epi& E) {
    const int tid = threadIdx.x, wid = __builtin_amdgcn_readfirstlane(tid >> 6), lane = tid & 63, wr = wid >> 2, wc = wid & 3, fr = lane & 15, fq = lane >> 4;
    const int K = g.K, nt = K / BK;
    unsigned voffA[2], voffB[2];
#pragma unroll
    for (int i = 0; i < 2; ++i) { int R, C; stage_rc(tid * 16 + i * 8192, R, C); const int Rb = Epi::PERM ? ((R & ~31) + perm32(R & 31)) : R;
        voffA[i] = (unsigned)(R * K + C) * 2u; voffB[i] = (unsigned)(Rb * K + C) * 2u; }
    const size_t kstep = (size_t)(BK * 2);
    const size_t hstep = (size_t)HALF * K * 2;
    const size_t tstep = 2 * hstep;
    const unsigned ldsw = (unsigned)wid * 1024u;
    const int aoff = lds_byte(wr * 64 + fr, fq * 8), boff = lds_byte(wc * 32 + fr, fq * 8);
#define PG8_SA(b, h) (((b) * 2 + (h)) * HTB)
#define PG8_SB(b, h) ((4 + (b) * 2 + (h)) * HTB)
#define PG8_STAGE(bufoff, gbase, voff) do { _Pragma("unroll") for (int _i = 0; _i < 2; ++_i) \
        __builtin_amdgcn_global_load_lds((const unsigned*)((const char*)(gbase) + (voff)[_i]), (PG8_LAS unsigned*)(lds + (bufoff) + ldsw + _i * 8192), 16, 0, 0); } while (0)
#define PG8_LDA(dst, b, h) do { _Pragma("unroll") for (int m = 0; m < 4; ++m) _Pragma("unroll") for (int k = 0; k < 2; ++k) dst[m][k] = *(const PG8_LAS bf16x8*)(lds + PG8_SA(b, h) + aoff + m * 2048 + k * 1024); } while (0)
#define PG8_LDB(dst, b, h) do { _Pragma("unroll") for (int n = 0; n < 2; ++n) _Pragma("unroll") for (int k = 0; k < 2; ++k) dst[n][k] = *(const PG8_LAS bf16x8*)(lds + PG8_SB(b, h) + boff + n * 2048 + k * 1024); } while (0)
#define PG8_MMA(ai, bj, At, Bt) do { __builtin_amdgcn_s_setprio(1); _Pragma("unroll") for (int m = 0; m < 4; ++m) _Pragma("unroll") for (int n = 0; n < 2; ++n) _Pragma("unroll") for (int k = 0; k < 2; ++k) \
        acc[ai][bj][m][n] = __builtin_amdgcn_mfma_f32_16x16x32_bf16(Bt[n][k], At[m][k], acc[ai][bj][m][n], 0, 0, 0); __builtin_amdgcn_s_setprio(0); } while (0)
#define PG8_WAIT_V(n) asm volatile("s_waitcnt vmcnt(" #n ")" ::: "memory")
#define PG8_WAIT_L(n) asm volatile("s_waitcnt lgkmcnt(" #n ")" ::: "memory")
#define PG8_BAR __builtin_amdgcn_s_barrier()
#define PG8_SCHED __builtin_amdgcn_sched_barrier(0)
    Unit cur, nxt; int ui = 0;
    if (!S.next(0, cur)) return;
    f32x4 acc[2][2][4][2];
#pragma unroll
    for (int a = 0; a < 2; ++a)
#pragma unroll
        for (int b = 0; b < 2; ++b)
#pragma unroll
            for (int m = 0; m < 4; ++m)
#pragma unroll
                for (int n = 0; n < 2; ++n) acc[a][b][m][n] = (f32x4){0.f, 0.f, 0.f, 0.f};
    bf16x8 At[4][2], B0[2][2], B1[2][2];
    const char* cA = (const char*)g.A + (size_t)cur.pm * tstep; const char* cB = (const char*)g.Bt + (size_t)cur.pn * tstep;
    S.a_ready(cur);
    if constexpr (SP2) {
        PG8_STAGE(PG8_SB(0, 0), cB, voffB); PG8_STAGE(PG8_SB(0, 1), cB + hstep, voffB); PG8_STAGE(PG8_SA(0, 0), cA, voffA); PG8_STAGE(PG8_SA(0, 1), cA + hstep, voffA);
        if (wr == 1) PG8_BAR;
        PG8_WAIT_V(2); PG8_BAR;
        PG8_STAGE(PG8_SB(1, 0), cB + kstep, voffB); PG8_STAGE(PG8_SA(1, 0), cA + kstep, voffA); PG8_STAGE(PG8_SB(1, 1), cB + hstep + kstep, voffB);
        PG8_WAIT_V(6); PG8_BAR;
    } else {
        PG8_STAGE(PG8_SB(0, 0), cB, voffB); PG8_STAGE(PG8_SA(0, 0), cA, voffA); PG8_STAGE(PG8_SB(0, 1), cB + hstep, voffB); PG8_STAGE(PG8_SA(0, 1), cA + hstep, voffA);
        if (wr == 1) PG8_BAR;
        PG8_WAIT_V(4); PG8_BAR;
        PG8_STAGE(PG8_SB(1, 0), cB + kstep, voffB); PG8_STAGE(PG8_SA(1, 0), cA + kstep, voffA); PG8_STAGE(PG8_SB(1, 1), cB + hstep + kstep, voffB);
        PG8_WAIT_V(6); PG8_BAR;
    }
    for (;;) {
        const bool has_next = S.next(ui + 1, nxt);
        const char* nA = has_next ? (const char*)g.A + (size_t)nxt.pm * tstep : cA; const char* nB = has_next ? (const char*)g.Bt + (size_t)nxt.pn * tstep : cB;
        for (int t = 0; t < nt; t += 2) {
            const bool last = (t == nt - 2);
            const char* a1 = cA + (size_t)(t + 1) * kstep;
            const char* a2 = last ? nA : cA + (size_t)(t + 2) * kstep; const char* b2 = last ? nB : cB + (size_t)(t + 2) * kstep;
            const char* a3 = a2 + kstep; const char* b3 = b2 + kstep;
            if (last && has_next) S.a_ready(nxt);
            if constexpr (SP2) {
            PG8_LDB(B0, 0, 0); PG8_LDB(B1, 0, 1); PG8_SCHED; PG8_LDA(At, 0, 0); PG8_STAGE(PG8_SA(1, 1), a1 + hstep, voffA);
            PG8_WAIT_V(8); PG8_WAIT_L(0); PG8_BAR; PG8_MMA(0, 0, At, B0); PG8_MMA(0, 1, At, B1); PG8_BAR; PG8_SCHED;
            PG8_LDA(At, 0, 1); PG8_STAGE(PG8_SB(0, 0), b2, voffB); PG8_STAGE(PG8_SB(0, 1), b2 + hstep, voffB); PG8_STAGE(PG8_SA(0, 0), a2, voffA);
            PG8_WAIT_V(8); PG8_WAIT_L(0); PG8_BAR; PG8_MMA(1, 0, At, B0); PG8_MMA(1, 1, At, B1); PG8_BAR; PG8_SCHED;
            PG8_LDB(B0, 1, 0); PG8_LDB(B1, 1, 1); PG8_SCHED; PG8_LDA(At, 1, 0); PG8_STAGE(PG8_SA(0, 1), a2 + hstep, voffA);
            PG8_WAIT_V(8); PG8_WAIT_L(0); PG8_BAR; PG8_MMA(0, 0, At, B0); PG8_MMA(0, 1, At, B1); PG8_BAR; PG8_SCHED;
            PG8_LDA(At, 1, 1); PG8_STAGE(PG8_SB(1, 0), b3, voffB); PG8_STAGE(PG8_SB(1, 1), b3 + hstep, voffB); PG8_STAGE(PG8_SA(1, 0), a3, voffA);
            PG8_WAIT_V(8); PG8_WAIT_L(0); PG8_BAR; PG8_MMA(1, 0, At, B0); PG8_MMA(1, 1, At, B1); PG8_BAR; PG8_SCHED;
            } else {
            PG8_LDB(B0, 0, 0); PG8_SCHED; PG8_LDA(At, 0, 0); PG8_STAGE(PG8_SA(1, 1), a1 + hstep, voffA);
            PG8_WAIT_L(8); PG8_BAR; PG8_WAIT_L(0); PG8_MMA(0, 0, At, B0); PG8_BAR; PG8_SCHED;
            PG8_LDB(B1, 0, 1); PG8_STAGE(PG8_SB(0, 0), b2, voffB);
            PG8_BAR; PG8_WAIT_L(0); PG8_MMA(0, 1, At, B1); PG8_BAR;
            PG8_LDA(At, 0, 1); PG8_STAGE(PG8_SA(0, 0), a2, voffA);
            PG8_BAR; PG8_WAIT_L(0); PG8_MMA(1, 0, At, B0); PG8_BAR; PG8_SCHED;
            PG8_STAGE(PG8_SB(0, 1), b2 + hstep, voffB);
            PG8_WAIT_V(6); PG8_BAR; PG8_MMA(1, 1, At, B1); PG8_BAR;
            PG8_LDB(B0, 1, 0); PG8_SCHED; PG8_LDA(At, 1, 0); PG8_STAGE(PG8_SA(0, 1), a2 + hstep, voffA);
            PG8_WAIT_L(8); PG8_BAR; PG8_WAIT_L(0); PG8_MMA(0, 0, At, B0); PG8_BAR; PG8_SCHED;
            PG8_LDB(B1, 1, 1); PG8_STAGE(PG8_SB(1, 0), b3, voffB);
            PG8_BAR; PG8_WAIT_L(0); PG8_MMA(0, 1, At, B1); PG8_BAR;
            PG8_LDA(At, 1, 1); PG8_STAGE(PG8_SA(1, 0), a3, voffA);
            PG8_BAR; PG8_WAIT_L(0); PG8_MMA(1, 0, At, B0); PG8_BAR; PG8_SCHED;
            PG8_STAGE(PG8_SB(1, 1), b3 + hstep, voffB);
            PG8_WAIT_V(6); PG8_BAR; PG8_MMA(1, 1, At, B1); PG8_BAR;
            }
        }
        if constexpr (ALIGN_EPI) { if (wr == 0) PG8_BAR; }
        if constexpr (!Epi::AFTER_DRAIN) { E(acc, cur, wr, wc, fr, fq); S.done(cur); }
        if (!has_next) break;
#pragma unroll
        for (int a = 0; a < 2; ++a)
#pragma unroll
            for (int b = 0; b < 2; ++b)
#pragma unroll
                for (int m = 0; m < 4; ++m)
#pragma unroll
                    for (int n = 0; n < 2; ++n) acc[a][b][m][n] = (f32x4){0.f, 0.f, 0.f, 0.f};
        cur = nxt; cA = nA; cB = nB; ++ui;
        if constexpr (ALIGN_EPI) { if (wr == 1) PG8_BAR; }
    }
    PG8_WAIT_V(0);
    if constexpr (!ALIGN_EPI) { if (wr == 0) PG8_BAR; }
    PG8_BAR;
    if constexpr (Epi::AFTER_DRAIN) { E.fused(acc, cur, wr, wc, fr, fq, lds, wid, lane); S.done(cur); }
#undef PG8_SA
#undef PG8_SB
#undef PG8_STAGE
#undef PG8_LDA
#undef PG8_LDB
#undef PG8_MMA
#undef PG8_WAIT_V
#undef PG8_WAIT_L
#undef PG8_BAR
#undef PG8_SCHED
}
}
#define GAS __attribute__((address_space(1)))
#define LAS __attribute__((address_space(3)))
typedef unsigned short bf16;
typedef unsigned v4u __attribute__((ext_vector_type(4)));
typedef float f32x4 __attribute__((ext_vector_type(4)));
typedef short bf16x8 __attribute__((ext_vector_type(8)));
typedef GAS unsigned gu32;
typedef GAS unsigned long long gu64;
#define RLX_AGENT __ATOMIC_RELAXED, __HIP_MEMORY_SCOPE_AGENT
#define LDS_WAIT() asm volatile("s_waitcnt lgkmcnt(0)" ::: "memory")
#define VM_WAIT() asm volatile("s_waitcnt vmcnt(0)" ::: "memory")
__device__ __forceinline__ unsigned long long rt() { return __builtin_amdgcn_s_memrealtime(); }
__device__ __forceinline__ unsigned f2bf(float f) { unsigned u = __builtin_bit_cast(unsigned, f); return (u + 0x7fffu + ((u >> 16) & 1u)) >> 16; }
__device__ __forceinline__ unsigned pk2(float lo, float hi) { return f2bf(lo) | (f2bf(hi) << 16); }

#define XB_TMO      128
#define XB_XCNT(j)  (256  + 64 * (j))
#define XB_XSUB(j)  (1280 + 64 * (j))
#define XB_XGEN(j)  (2304 + 64 * (j))
#define XB_TOP      3328
#define XB_TOPGEN   3392
#define XCD_BAR_WORDS 3456
#define XB_SPIN_CAP (1u << 18)

__device__ __forceinline__ unsigned xb_ld(unsigned* p)              { return __hip_atomic_load(p, __ATOMIC_RELAXED, __HIP_MEMORY_SCOPE_AGENT); }
__device__ __forceinline__ unsigned xb_add(unsigned* p, unsigned v) { return __hip_atomic_fetch_add(p, v, __ATOMIC_RELAXED, __HIP_MEMORY_SCOPE_AGENT); }
__device__ __forceinline__ unsigned xb_xcc_id() { return (unsigned)__builtin_amdgcn_s_getreg((3 << 11) | 20) & 0xFu; }
#define XB_SPIN(cond, bar) do { unsigned _sp = 0; while (cond) { __builtin_amdgcn_s_sleep(1); \
    if ((++_sp & 255u) == 0u) { if (xb_ld(&(bar)[XB_TMO])) break; if (_sp > XB_SPIN_CAP) { atomicAdd(&(bar)[XB_TMO], 1u); break; } } } } while (0)

struct XcdBarrier {
    unsigned* bar; unsigned x;
    volatile LAS unsigned* st;
};

__device__ __forceinline__ XcdBarrier xcd_barrier_post(unsigned* bar, volatile LAS unsigned* st) {
    XcdBarrier b; b.bar = bar; b.x = xb_xcc_id(); b.st = st;
    if (threadIdx.x == 0) (void)xb_add(&bar[XB_XCNT(b.x)], 1u);
    return b;
}
__device__ __forceinline__ void xcd_barrier_complete(unsigned* bar, unsigned x, unsigned& nloc, unsigned& nx) {
    const unsigned G = gridDim.x * gridDim.y * gridDim.z;
    unsigned sum, cnt, mine, sp = 0u;
    for (;;) {
        sum = 0u; cnt = 0u; mine = 0u;
#pragma unroll
        for (unsigned j = 0; j < 16; ++j) { const unsigned c = xb_ld(&bar[XB_XCNT(j)]); sum += c; cnt += (c > 0u) ? 1u : 0u; mine = (j == x) ? c : mine; }
        if (sum == G) break;
        __builtin_amdgcn_s_sleep(1);
        if ((++sp & 255u) == 0u) { if (xb_ld(&bar[XB_TMO])) break; if (sp > XB_SPIN_CAP) { atomicAdd(&bar[XB_TMO], 1u); break; } }
    }
    nloc = mine > 0u ? mine : 1u; nx = cnt > 0u ? cnt : 1u;
}

__device__ __forceinline__ void xcd_barrier(const XcdBarrier& b) {
    asm volatile("s_waitcnt vmcnt(0)" ::: "memory");
    __syncthreads();
    if (threadIdx.x == 0) {
        unsigned* bar = b.bar;
        __builtin_amdgcn_s_waitcnt(0);
        unsigned nloc = b.st[0], nx = b.st[1];
        if (nloc == 0u) { xcd_barrier_complete(bar, b.x, nloc, nx); b.st[0] = nloc; b.st[1] = nx; }
        const unsigned old = xb_add(&bar[XB_XSUB(b.x)], 1u);
        const unsigned gen = old / nloc;
        if (old + 1u == (gen + 1u) * nloc) {
            __builtin_amdgcn_fence(__ATOMIC_RELEASE, "agent");
            asm volatile("s_waitcnt vmcnt(0)" ::: "memory");
            const unsigned og = xb_add(&bar[XB_TOP], 1u);
            const unsigned tg = og / nx;
            if (og + 1u == (tg + 1u) * nx) xb_add(&bar[XB_TOPGEN], 1u);
            else XB_SPIN(xb_ld(&bar[XB_TOPGEN]) == tg, bar);
            __builtin_amdgcn_fence(__ATOMIC_ACQUIRE, "agent");
            xb_add(&bar[XB_XGEN(b.x)], 1u);
            asm volatile("s_waitcnt vmcnt(0)" ::: "memory");
        } else {
            XB_SPIN(xb_ld(&bar[XB_XGEN(b.x)]) == gen, bar);
            __builtin_amdgcn_fence(__ATOMIC_ACQUIRE, "agent");
            asm volatile("s_waitcnt vmcnt(0)" ::: "memory");
        }
    }
    __syncthreads();
}

typedef float f32x16 __attribute__((ext_vector_type(16)));
typedef short s16x4 __attribute__((ext_vector_type(4)));
typedef unsigned u32x2v __attribute__((ext_vector_type(2)));
typedef LAS unsigned char* ldsp_t;
#define WAITV0_BAR() asm volatile("s_waitcnt vmcnt(0) lgkmcnt(0)\n\ts_barrier" ::: "memory")
#define LGKM_BAR() asm volatile("s_waitcnt lgkmcnt(0)\n\ts_barrier" ::: "memory")
__device__ __forceinline__ int crow(int r, int hi) { return (r & 3) + 8 * (r >> 2) + 4 * hi; }
__device__ __forceinline__ unsigned cvtpk(float lo, float hi) { unsigned r; asm volatile("v_cvt_pk_bf16_f32 %0, %1, %2" : "=v"(r) : "v"(lo), "v"(hi)); return r; }
__device__ __forceinline__ float bf2f(unsigned short b) { return __uint_as_float((unsigned)b << 16); }
__device__ __forceinline__ float bflo(unsigned w) { return __uint_as_float(w << 16); }
__device__ __forceinline__ float bfhi(unsigned w) { return __uint_as_float(w & 0xffff0000u); }
__device__ __forceinline__ float ex2(float x) { return __builtin_amdgcn_exp2f(x); }
__device__ __forceinline__ float fexpn(float x) { return __builtin_amdgcn_exp2f(x * LOG2E); }
__device__ __forceinline__ float swap_max(float v) { auto rr = __builtin_amdgcn_permlane32_swap(__float_as_uint(v), __float_as_uint(v), false, false); return fmaxf(__uint_as_float(rr[0]), __uint_as_float(rr[1])); }
__device__ __forceinline__ float swap_sum(float v) { auto rr = __builtin_amdgcn_permlane32_swap(__float_as_uint(v), __float_as_uint(v), false, false); return __uint_as_float(rr[0]) + __uint_as_float(rr[1]); }
__device__ __forceinline__ s16x4 vtr(LAS const unsigned char* p) { return __builtin_bit_cast(s16x4, __builtin_amdgcn_ds_read_tr16_b64_v4i16((LAS s16x4*)p)); }
__device__ __forceinline__ bf16x8 cat8(s16x4 a, s16x4 b) { return (bf16x8){a[0], a[1], a[2], a[3], b[0], b[1], b[2], b[3]}; }
__device__ __forceinline__ bf16x8 accfrag(const f32x16& x, int s) {
    v4u w; w.x = cvtpk(x[8 * s + 0], x[8 * s + 1]); w.y = cvtpk(x[8 * s + 2], x[8 * s + 3]); w.z = cvtpk(x[8 * s + 4], x[8 * s + 5]); w.w = cvtpk(x[8 * s + 6], x[8 * s + 7]);
    return __builtin_bit_cast(bf16x8, w);
}
#define DMA16(gsrc, ldsdst) __builtin_amdgcn_global_load_lds((const unsigned*)(gsrc), (LAS unsigned*)(ldsdst), 16, 0, 0)
__device__ __forceinline__ void dma_vimg(const bf16* src, int pitch, ldsp_t img, int wid, int lane) {
    const int sub = lane >> 5, row = (lane & 31) >> 2, ch = lane & 3;
#pragma unroll
    for (int j = 0; j < 2; ++j) DMA16(src + (size_t)(8 * wid + row) * pitch + 32 * (2 * j + sub) + 8 * ch, img + (wid * 4 + 2 * j) * 512);
}
__device__ __forceinline__ int vtr_lane_off(int lane) { return ((lane >> 4) & 1) * 32 + (lane & 3) * 8 + ((lane & 15) >> 2) * 64; }

namespace att {
constexpr int BUFB = 32768, KIMG = 16384, XOFF = 65536;
__device__ __forceinline__ void unit(int b, int h, int qblk, const bf16* Q, const bf16* K, const bf16* V, bf16* MIX, float lam, const float* gsub, ldsp_t lds) {
    int tid = threadIdx.x; asm volatile("" : "+v"(tid));
    const int lane = tid & 63, wid = __builtin_amdgcn_readfirstlane(tid >> 6), r32 = lane & 31, hi = lane >> 5, mp = wid >> 2, qb = wid & 3;
    const int q0 = qblk * 128, NT = 2 * (qblk + 1);
    const size_t rowbase = (size_t)b * SEQ;
    const int qg = q0 + 32 * qb + r32;
    bf16x8 qr[4];
    { const bf16* qp = Q + (rowbase + qg) * AW + h * 128 + mp * 64 + hi * 8;
#pragma unroll
      for (int d0 = 0; d0 < 4; ++d0) qr[d0] = *(const bf16x8*)(qp + 16 * d0); }
    const bf16* ksrc = K + (rowbase + lane) * AW + h * 128 + mp * 64 + 2 * (wid & 3) * 8;
    const bf16* vsrc = V + rowbase * AW + h * 128;
    const int kdst = mp * 8192 + 2 * (wid & 3) * 1024;
#define ATT_DMA(t, buf) do { const bf16* ks_ = ksrc + (size_t)(t) * 64 * AW; DMA16(ks_, lds + (buf) * BUFB + kdst); DMA16(ks_ + 8, lds + (buf) * BUFB + kdst + 1024); \
        dma_vimg(vsrc + (size_t)(t) * 64 * AW, AW, lds + (buf) * BUFB + KIMG, wid, lane); } while (0)
    f32x16 o[4];
#pragma unroll
    for (int i = 0; i < 4; ++i) o[i] = (f32x16){};
    float mrun = -1e30f, lsum = 0.f;
    const int vlo = vtr_lane_off(lane) + 4 * hi * 64;
    ATT_DMA(0, 0);
    WAITV0_BAR();
    for (int t = 0; t < NT; ++t) {
        const int buf = t & 1;
        if (t + 1 < NT) ATT_DMA(t + 1, buf ^ 1);
        if (64 * t <= q0 + 32 * qb + 31) {
            const LAS unsigned char* kb = lds + buf * BUFB + mp * 8192 + hi * 1024 + r32 * 16;
            f32x16 p0 = (f32x16){}, p1 = (f32x16){};
#pragma unroll
            for (int d0 = 0; d0 < 4; ++d0) {
                const bf16x8 k0 = *(const LAS bf16x8*)(kb + d0 * 2048), k1 = *(const LAS bf16x8*)(kb + d0 * 2048 + 512);
                p0 = __builtin_amdgcn_mfma_f32_32x32x16_bf16(k0, qr[d0], p0, 0, 0, 0);
                p1 = __builtin_amdgcn_mfma_f32_32x32x16_bf16(k1, qr[d0], p1, 0, 0, 0);
            }
            if (64 * t + 63 > q0 + 32 * qb) {
#pragma unroll
                for (int r = 0; r < 16; ++r) { const int kv = 64 * t + crow(r, hi); if (kv > qg) p0[r] = -1e30f; if (kv + 32 > qg) p1[r] = -1e30f; }
            }
            float mt = fmaxf(p0[0], p1[0]);
#pragma unroll
            for (int r = 1; r < 16; ++r) mt = fmaxf(mt, fmaxf(p0[r], p1[r]));
            mt = swap_max(mt);
            const float mnew = fmaxf(mrun, mt);
            if (__any(mnew > mrun)) {
                const float al = ex2(mrun - mnew); lsum *= al;
#pragma unroll
                for (int i = 0; i < 4; ++i)
#pragma unroll
                    for (int r = 0; r < 16; ++r) o[i][r] *= al;
            }
            mrun = mnew;
            float ps = 0.f;
#pragma unroll
            for (int r = 0; r < 16; ++r) { p0[r] = ex2(p0[r] - mnew); p1[r] = ex2(p1[r] - mnew); ps += p0[r] + p1[r]; }
            lsum += ps;
            bf16x8 pw[4]; pw[0] = accfrag(p0, 0); pw[1] = accfrag(p0, 1); pw[2] = accfrag(p1, 0); pw[3] = accfrag(p1, 1);
            const LAS unsigned char* vb = lds + buf * BUFB + KIMG + vlo;
#pragma unroll
            for (int s = 0; s < 4; ++s)
#pragma unroll
                for (int db = 0; db < 4; ++db) {
                    const bf16x8 vf = cat8(vtr(vb + ((2 * s) * 4 + db) * 512), vtr(vb + ((2 * s + 1) * 4 + db) * 512));
                    o[db] = __builtin_amdgcn_mfma_f32_32x32x16_bf16(vf, pw[s], o[db], 0, 0, 0);
                }
        }
        WAITV0_BAR();
    }
#undef ATT_DMA
    const float inv = 1.0f / swap_sum(lsum);
    LAS float* X = (LAS float*)(lds + XOFF);
    if (mp == 1) { const float sc = lam * inv;
#pragma unroll
        for (int db = 0; db < 4; ++db)
#pragma unroll
            for (int r = 0; r < 16; ++r) X[(qb * 64 + db * 16 + r) * 64 + lane] = o[db][r] * sc; }
    LGKM_BAR();
    if (mp == 0) {
        float ss = 0.f;
#pragma unroll
        for (int db = 0; db < 4; ++db)
#pragma unroll
            for (int r = 0; r < 16; ++r) { const float a = o[db][r] * inv - X[(qb * 64 + db * 16 + r) * 64 + lane]; o[db][r] = a; ss += a * a; }
        ss = swap_sum(ss);
        const float rs = (1.0f - LAM_INIT) / sqrtf(ss * (1.0f / 128.0f) + EPS);
        bf16* orow = MIX + (rowbase + qg) * D + h * 128;
#pragma unroll
        for (int db = 0; db < 4; ++db)
#pragma unroll
            for (int g = 0; g < 4; ++g) { const int d = 32 * db + 8 * g + 4 * hi; const f32x4 gg = *(const f32x4*)(gsub + d);
                u32x2v w; w.x = cvtpk(o[db][4 * g] * rs * gg[0], o[db][4 * g + 1] * rs * gg[1]); w.y = cvtpk(o[db][4 * g + 2] * rs * gg[2], o[db][4 * g + 3] * rs * gg[3]);
                *(u32x2v*)(orow + d) = w; }
    }
}
}

namespace hg {
constexpr int QE_OFF = 0, QE_P = 136  , KE_OFF = 17408, KLT_OFF = 34816, KLT_P = 72, V_OFF = 53248, G_OFF = 86016, QT_OFF = 86528, LDS_END = 88576;
__device__ __forceinline__ void unit(int bh, const bf16* RQ, const bf16* RK, const bf16* RV, const float* LOGF, bf16* OREC, float* sout, ldsp_t lds) {
    int tid = threadIdx.x; asm volatile("" : "+v"(tid));
    const int lane = tid & 63, wid = __builtin_amdgcn_readfirstlane(tid >> 6), r32 = lane & 31, hi = lane >> 5, th = wid >> 2, eb = wid & 3;
    const int b = bh >> 2, h = bh & 3;
    const size_t rowbase = (size_t)b * SEQ; const int col0 = h * 128;
    const int d = tid & 127, tq = tid >> 7;
    LAS bf16* QE = (LAS bf16*)(lds + QE_OFF); LAS bf16* KE = (LAS bf16*)(lds + KE_OFF); LAS bf16* KLT = (LAS bf16*)(lds + KLT_OFF);
    LAS float* G = (LAS float*)(lds + G_OFF); LAS float* QT = (LAS float*)(lds + QT_OFF);
    float lf[16]; unsigned short rq[16], rk[16];
    f32x16 S[4];
#pragma unroll
    for (int i = 0; i < 4; ++i) S[i] = (f32x16){};
    const int vlo = vtr_lane_off(lane);
#define HG_LOAD(n) do { const size_t g0_ = (rowbase + 64 * (n) + 16 * tq) * RW + col0 + d; _Pragma("unroll") for (int i = 0; i < 16; ++i) { lf[i] = LOGF[g0_ + (size_t)i * RW]; rq[i] = RQ[g0_ + (size_t)i * RW]; rk[i] = RK[g0_ + (size_t)i * RW]; } \
        dma_vimg(RV + (rowbase + 64 * (n)) * RW + col0, RW, lds + V_OFF + ((n) & 1) * 16384, wid, lane); } while (0)
#define HG_PREP() do { float cs_[16]; float c_ = 0.f; _Pragma("unroll") for (int i = 0; i < 16; ++i) { c_ += lf[i]; cs_[i] = c_; } \
        QT[tq * 128 + d] = c_; LGKM_BAR(); \
        float off_ = 0.f, tot_ = 0.f; _Pragma("unroll") for (int q = 0; q < 4; ++q) { const float v_ = QT[q * 128 + d]; tot_ += v_; if (q < tq) off_ += v_; } \
        if (tq == 0) G[d] = fexpn(tot_); \
        unsigned klw_[8]; \
        _Pragma("unroll") for (int i = 0; i < 16; i += 2) { \
            const float b0_ = cs_[i] + off_, b1_ = cs_[i + 1] + off_; const float q0_ = bf2f(rq[i]), q1_ = bf2f(rq[i + 1]), k0_ = bf2f(rk[i]), k1_ = bf2f(rk[i + 1]); \
            const unsigned qe_ = cvtpk(q0_ * fexpn(b0_), q1_ * fexpn(b1_)), ke_ = cvtpk(k0_ * fexpn(-b0_), k1_ * fexpn(-b1_)); \
            klw_[i >> 1] = cvtpk(k0_ * fexpn(tot_ - b0_), k1_ * fexpn(tot_ - b1_)); \
            QE[(16 * tq + i) * QE_P + d] = (bf16)(qe_ & 0xffffu); QE[(16 * tq + i + 1) * QE_P + d] = (bf16)(qe_ >> 16); \
            KE[(16 * tq + i) * QE_P + d] = (bf16)(ke_ & 0xffffu); KE[(16 * tq + i + 1) * QE_P + d] = (bf16)(ke_ >> 16); } \
        *(LAS v4u*)(KLT + d * KLT_P + 16 * tq) = (v4u){klw_[0], klw_[1], klw_[2], klw_[3]}; *(LAS v4u*)(KLT + d * KLT_P + 16 * tq + 8) = (v4u){klw_[4], klw_[5], klw_[6], klw_[7]}; } while (0)
    HG_LOAD(0);
    HG_PREP();
    WAITV0_BAR();
    for (int n = 0; n < 32; ++n) {
        if (n + 1 < 32) HG_LOAD(n + 1);
        const LAS unsigned char* vimg = lds + V_OFF + (n & 1) * 16384;
        f32x16 o = (f32x16){};
        bf16x8 xw[2][2];
#pragma unroll
        for (int sb = 0; sb < 2; ++sb) if (sb <= th) {
            f32x16 x = (f32x16){};
#pragma unroll
            for (int sg = 0; sg < 8; ++sg) {
                const bf16x8 ka = *(const LAS bf16x8*)(KE + (32 * sb + r32) * QE_P + 16 * sg + 8 * hi), qbv = *(const LAS bf16x8*)(QE + (32 * th + r32) * QE_P + 16 * sg + 8 * hi);
                x = __builtin_amdgcn_mfma_f32_32x32x16_bf16(ka, qbv, x, 0, 0, 0);
            }
            if (sb == th) {
#pragma unroll
                for (int r = 0; r < 16; ++r) if (crow(r, hi) > r32) x[r] = 0.f;
            }
            xw[sb][0] = accfrag(x, 0); xw[sb][1] = accfrag(x, 1);
        }
#pragma unroll
        for (int db = 0; db < 4; ++db)
#pragma unroll
            for (int sg = 0; sg < 2; ++sg) {
                const LAS bf16* qp = QE + (32 * th + r32) * QE_P + 32 * db + 16 * sg + 4 * hi;
                const u32x2v a0 = *(const LAS u32x2v*)qp, a1 = *(const LAS u32x2v*)(qp + 8);
                const v4u aw = (v4u){a0.x, a0.y, a1.x, a1.y};
                o = __builtin_amdgcn_mfma_f32_32x32x16_bf16(__builtin_bit_cast(bf16x8, aw), accfrag(S[db], sg), o, 0, 0, 0);
            }
#pragma unroll
        for (int sb = 0; sb < 2; ++sb) if (sb <= th) {
#pragma unroll
            for (int sg = 0; sg < 2; ++sg) {
                const LAS unsigned char* vb = vimg + vlo + 4 * hi * 64 + ((4 * sb + 2 * sg) * 4 + eb) * 512;
                const bf16x8 vf = cat8(vtr(vb), vtr(vb + 4 * 512));
                o = __builtin_amdgcn_mfma_f32_32x32x16_bf16(xw[sb][sg], vf, o, 0, 0, 0);
            }
        }
        { bf16* op = OREC + (rowbase + 64 * n + 32 * th) * RW + col0 + 32 * eb + r32;
#pragma unroll
          for (int r = 0; r < 16; r += 2) { const unsigned w = cvtpk(o[r], o[r + 1]); op[(size_t)crow(r, hi) * RW] = (bf16)(w & 0xffffu); op[(size_t)crow(r + 1, hi) * RW] = (bf16)(w >> 16); } }
#pragma unroll
        for (int db = 0; db < 4; ++db) {
#pragma unroll
            for (int g = 0; g < 4; ++g) { const f32x4 gg = *(const LAS f32x4*)(G + 32 * db + 8 * g + 4 * hi);
                S[db][4 * g] *= gg[0]; S[db][4 * g + 1] *= gg[1]; S[db][4 * g + 2] *= gg[2]; S[db][4 * g + 3] *= gg[3]; }
        }
#pragma unroll
        for (int sg = 0; sg < 4; ++sg) {
            const LAS unsigned char* vb = vimg + vlo + ((2 * sg + hi) * 4 + eb) * 512;
            const bf16x8 vf = cat8(vtr(vb), vtr(vb + 4 * 64));
#pragma unroll
            for (int db = 0; db < 4; ++db) {
                const bf16x8 ka = *(const LAS bf16x8*)(KLT + (32 * db + r32) * KLT_P + 16 * sg + 8 * hi);
                S[db] = __builtin_amdgcn_mfma_f32_32x32x16_bf16(ka, vf, S[db], 0, 0, 0);
            }
        }
        LGKM_BAR();
        if (n + 1 < 32) HG_PREP();
        WAITV0_BAR();
    }
#undef HG_LOAD
#undef HG_PREP
    if (th == 0) { float* sp = sout + (size_t)bh * 16384 + 32 * eb + r32;
#pragma unroll
        for (int db = 0; db < 4; ++db)
#pragma unroll
            for (int r = 0; r < 16; ++r) sp[(size_t)(32 * db + crow(r, hi)) * 128] = S[db][r]; }
}
}

namespace dec {
constexpr int PART = 264;
__device__ __forceinline__ void unit(int bs, int h, const bf16* Q, const bf16* K, const bf16* V, const float* ck, const float* cv, const int* ptab, bf16* MIX, float lam, const float* gsub, ldsp_t lds) {
    int tid = threadIdx.x; asm volatile("" : "+v"(tid));
    const int lane = tid & 63, wid = __builtin_amdgcn_readfirstlane(tid >> 6);
    const size_t row = (size_t)MP + bs;
    LAS float* P = (LAS float*)lds;
    const int c4 = 4 * (lane & 31), half = lane >> 5, mymap = (lane >> 4) & 1;
    f32x4 q4; { const u32x2v qw = *(const u32x2v*)(Q + row * AW + h * 128 + c4); q4 = (f32x4){bflo(qw.x), bfhi(qw.x), bflo(qw.y), bfhi(qw.y)}; }
    float mrun = -1e30f, lrun = 0.f; f32x4 o0 = (f32x4){0.f, 0.f, 0.f, 0.f}, o1 = o0;
    for (int pg = 0; pg < 2; ++pg) {
        const int pid = ptab[bs * NPAGES + 2 * wid + pg];
        const float* kp = ck + ((size_t)pid * PAGE + half) * 512 + h * 128 + c4;
        const float* vp = cv + ((size_t)pid * PAGE + half) * 512 + h * 128 + c4;
        for (int t = 0; t < 8; ++t) {
            f32x4 kk[8], vv[8];
#pragma unroll
            for (int i = 0; i < 8; ++i) kk[i] = __builtin_nontemporal_load((const f32x4*)(kp + (size_t)(16 * t + 2 * i) * 512));
#pragma unroll
            for (int i = 0; i < 8; ++i) vv[i] = __builtin_nontemporal_load((const f32x4*)(vp + (size_t)(16 * t + 2 * i) * 512));
            float pr[8];
#pragma unroll
            for (int i = 0; i < 8; ++i) pr[i] = (kk[i][0] * q4[0] + kk[i][1] * q4[1]) + (kk[i][2] * q4[2] + kk[i][3] * q4[3]);
            float a4[4], a2[2], s;
            { const bool up = (lane & 8) != 0;
#pragma unroll
              for (int i = 0; i < 4; ++i) { const float keep = up ? pr[i + 4] : pr[i], send = up ? pr[i] : pr[i + 4]; a4[i] = keep + __shfl_xor(send, 8); } }
            { const bool up = (lane & 4) != 0;
#pragma unroll
              for (int i = 0; i < 2; ++i) { const float keep = up ? a4[i + 2] : a4[i], send = up ? a4[i] : a4[i + 2]; a2[i] = keep + __shfl_xor(send, 4); } }
            { const bool up = (lane & 2) != 0; const float keep = up ? a2[1] : a2[0], send = up ? a2[0] : a2[1]; s = keep + __shfl_xor(send, 2); }
            s += __shfl_xor(s, 1);
            float mt = s; mt = fmaxf(mt, __shfl_xor(mt, 2)); mt = fmaxf(mt, __shfl_xor(mt, 4)); mt = fmaxf(mt, __shfl_xor(mt, 8)); mt = fmaxf(mt, __shfl_xor(mt, 32));
            const float mnew = fmaxf(mrun, mt), al = ex2(mrun - mnew), p = ex2(s - mnew);
            float psum = p; psum += __shfl_xor(psum, 2); psum += __shfl_xor(psum, 4); psum += __shfl_xor(psum, 8); psum += __shfl_xor(psum, 32);
            lrun = lrun * al + psum; mrun = mnew;
            const float al0 = __shfl(al, 0), al1 = __shfl(al, 16);
            o0 = o0 * al0; o1 = o1 * al1;
#pragma unroll
            for (int i = 0; i < 8; ++i) { const float p0 = __shfl(p, (lane & 32) + 2 * i), p1 = __shfl(p, (lane & 32) + 16 + 2 * i); o0 = o0 + vv[i] * p0; o1 = o1 + vv[i] * p1; }
        }
    }
#pragma unroll
    for (int j = 0; j < 4; ++j) { o0[j] += __shfl_xor(o0[j], 32); o1[j] += __shfl_xor(o1[j], 32); }
    { const float m0 = __shfl(mrun, 0), l0 = __shfl(lrun, 0), m1 = __shfl(mrun, 16), l1 = __shfl(lrun, 16);
      LAS float* pw = P + wid * PART;
      if (lane < 32) { *(LAS f32x4*)(pw + c4) = o0; *(LAS f32x4*)(pw + 128 + c4) = o1; }
      if (lane == 0) { pw[256] = m0; pw[257] = l0; pw[258] = m1; pw[259] = l1; } }
    if (wid == 0) {
        const u32x2v kw = *(const u32x2v*)(K + row * AW + h * 128 + c4);
        float s = (bflo(kw.x) * q4[0] + bfhi(kw.x) * q4[1]) + (bflo(kw.y) * q4[2] + bfhi(kw.y) * q4[3]);
        s += __shfl_xor(s, 1); s += __shfl_xor(s, 2); s += __shfl_xor(s, 4); s += __shfl_xor(s, 8);
        if (lane == 0) P[8 * PART] = s; if (lane == 16) P[8 * PART + 1] = s;
    }
    LGKM_BAR();
    if (wid == 0) {
        float M0 = P[8 * PART], M1 = P[8 * PART + 1]; const float sn0 = M0, sn1 = M1;
#pragma unroll
        for (int w = 0; w < 8; ++w) { M0 = fmaxf(M0, P[w * PART + 256]); M1 = fmaxf(M1, P[w * PART + 258]); }
        const float wn0 = ex2(sn0 - M0), wn1 = ex2(sn1 - M1);
        float L0 = wn0, L1 = wn1; float a[2], bq[2];
        { const bf16* vr = V + row * AW + h * 128; a[0] = wn0 * bf2f(vr[lane]); a[1] = wn0 * bf2f(vr[lane + 64]); bq[0] = wn1 * bf2f(vr[lane]); bq[1] = wn1 * bf2f(vr[lane + 64]); }
#pragma unroll
        for (int w = 0; w < 8; ++w) { const float f0 = ex2(P[w * PART + 256] - M0), f1 = ex2(P[w * PART + 258] - M1);
            L0 += f0 * P[w * PART + 257]; L1 += f1 * P[w * PART + 259];
            a[0] += f0 * P[w * PART + lane]; a[1] += f0 * P[w * PART + lane + 64]; bq[0] += f1 * P[w * PART + 128 + lane]; bq[1] += f1 * P[w * PART + 128 + lane + 64]; }
        const float i0 = 1.0f / L0, i1 = lam / L1;
        const float y0 = a[0] * i0 - bq[0] * i1, y1 = a[1] * i0 - bq[1] * i1;
        float ss = y0 * y0 + y1 * y1;
#pragma unroll
        for (int o = 1; o < 64; o <<= 1) ss += __shfl_xor(ss, o);
        const float rs = (1.0f - LAM_INIT) / sqrtf(ss * (1.0f / 128.0f) + EPS);
        bf16* orow = MIX + row * D + h * 128;
        orow[lane] = (bf16)f2bf(y0 * rs * gsub[lane]); orow[lane + 64] = (bf16)f2bf(y1 * rs * gsub[lane + 64]);
    }
    LGKM_BAR();
}
}

__device__ __forceinline__ void hgrn_step(int bs, int h, const bf16* RQ, const bf16* RK, const bf16* RV, const float* LOGF, const float* S0, float* Sout, bf16* OREC, ldsp_t lds) {
    int tid = threadIdx.x; asm volatile("" : "+v"(tid)); const size_t row = (size_t)MP + bs; const size_t g0 = row * RW + h * 128;
    LAS float* qs = (LAS float*)lds; LAS float* ks = qs + 128; LAS float* fs = qs + 256; LAS float* po = qs + 384;
    if (tid < 128) { qs[tid] = bf2f(RQ[g0 + tid]); ks[tid] = bf2f(RK[g0 + tid]); fs[tid] = fexpn(LOGF[g0 + tid]); }
    const int e = tid & 127, dq = tid >> 7;
    const float v = bf2f(RV[g0 + e]);
    LGKM_BAR();
    const size_t sb = ((size_t)(bs * 4 + h) * 128 + 32 * dq) * 128 + e;
    float acc = 0.f;
#pragma unroll 8
    for (int i = 0; i < 32; ++i) { const int dd = 32 * dq + i; const float sn = fs[dd] * S0[sb + (size_t)i * 128] + ks[dd] * v; Sout[sb + (size_t)i * 128] = sn; acc += qs[dd] * sn; }
    po[dq * 128 + e] = acc;
    LGKM_BAR();
    if (tid < 128) OREC[g0 + tid] = (bf16)f2bf((po[tid] + po[128 + tid]) + (po[256 + tid] + po[384 + tid]));
    LGKM_BAR();
}


template <int MODE, int N, int K, int KC>
__device__ __forceinline__ void samp_item(int item, const bf16* Abf, const float* xs, const float* C4, const float* C5, const float* C6, float* SS1, const bf16* Bt, float* C) {
    int tid = threadIdx.x; asm volatile("" : "+v"(tid));
    const int lane = tid & 63, wid = __builtin_amdgcn_readfirstlane(tid >> 6), r32 = lane & 31, hi = lane >> 5, rb = wid >> 1, cbk = wid & 1;
    constexpr int NCH = N / 64;
    const int nc = item % NCH, kc = item / NCH, n0 = nc * 64 + 32 * cbk, k0 = kc * KC, row = 32 * rb + r32;
    f32x16 acc = (f32x16){};
    float ssp = 0.f, r2 = 0.f;
    if (MODE == 7) r2 = 1.0f / (SS1[row] * (1.0f / D) + EPS);
    const bf16* bp = Bt + (size_t)(n0 + r32) * K + k0 + 8 * hi;
#pragma unroll 4
    for (int s = 0; s < KC / 16; ++s) {
        const int k8 = k0 + 16 * s + 8 * hi;
        bf16x8 a;
        if (MODE == 4) a = *(const bf16x8*)(Abf + (size_t)row * D + k8);
        else {
            f32x4 v0, v1;
            if (MODE == 6) { const float* p = C5 + (size_t)row * FF + k8; v0 = *(const f32x4*)p; v1 = *(const f32x4*)(p + 4);
#pragma unroll
                for (int j = 0; j < 4; ++j) { const float a0 = fmaxf(v0[j], 0.f), a1 = fmaxf(v1[j], 0.f); v0[j] = a0 * a0; v1[j] = a1 * a1; } }
            else { const size_t o = (size_t)row * D + k8; v0 = *(const f32x4*)(xs + o) + *(const f32x4*)(C4 + o); v1 = *(const f32x4*)(xs + o + 4) + *(const f32x4*)(C4 + o + 4);
                if (MODE == 5) ssp += (v0[0] * v0[0] + v0[1] * v0[1]) + (v0[2] * v0[2] + v0[3] * v0[3]) + (v1[0] * v1[0] + v1[1] * v1[1]) + (v1[2] * v1[2] + v1[3] * v1[3]);
                if (MODE == 7) { v0 = v0 + *(const f32x4*)(C6 + o) * r2; v1 = v1 + *(const f32x4*)(C6 + o + 4) * r2; } }
            v4u w; w.x = cvtpk(v0[0], v0[1]); w.y = cvtpk(v0[2], v0[3]); w.z = cvtpk(v1[0], v1[1]); w.w = cvtpk(v1[2], v1[3]); a = __builtin_bit_cast(bf16x8, w);
        }
        const bf16x8 b = *(const bf16x8*)(bp + 16 * s);
        acc = __builtin_amdgcn_mfma_f32_32x32x16_bf16(a, b, acc, 0, 0, 0);
    }
    float* cp = C + (size_t)(32 * rb) * N + n0 + r32;
#pragma unroll
    for (int r = 0; r < 16; ++r) unsafeAtomicAdd(cp + (size_t)crow(r, hi) * N, acc[r]);
    if (MODE == 5 && nc == 0 && cbk == 0) { ssp = swap_sum(ssp); if (hi == 0) unsafeAtomicAdd(SS1 + row, ssp); }
}

constexpr size_t MiB = 1u << 20;
constexpr size_t WS_CTL = 0, CTL_ZERO_BYTES = 1 * MiB;
constexpr size_t WS_WIN = 2 * MiB, WS_WOUT = 9 * MiB, WS_WUP = 11 * MiB, WS_WDN = 19 * MiB, WS_WG = 27 * MiB, WS_WP = 29 * MiB;
constexpr size_t WS_XN = 32 * MiB, WS_PB = 66 * MiB, WS_Q = 76 * MiB, WS_K = 93 * MiB, WS_V = 110 * MiB, WS_RQ = 127 * MiB, WS_RK = 144 * MiB, WS_RV = 161 * MiB, WS_RG = 178 * MiB;
constexpr size_t WS_LOGF = 195 * MiB, WS_OREC = 228 * MiB, WS_MIX = 245 * MiB, WS_X1 = 278 * MiB, WS_A2 = 343 * MiB, WS_A3 = 376 * MiB, WS_PJ = 409 * MiB, WS_H = 442 * MiB;
constexpr size_t WS_SSP1 = 572 * MiB, WS_SSP3 = 574 * MiB;
constexpr size_t WS_SC4 = 576 * MiB, WS_SC5 = 577 * MiB, WS_SC6 = 579 * MiB, WS_SC7 = 580 * MiB, WS_SS1S = 581 * MiB, WS_SC_END = WS_SS1S + 4096, WS_END = 582 * MiB;
static_assert(WS_K - WS_Q == 17 * MiB && WS_V - WS_K == 17 * MiB && WS_RQ - WS_V == 17 * MiB && WS_RK - WS_RQ == 17 * MiB && WS_RV - WS_RK == 17 * MiB && WS_RG - WS_RV == 17 * MiB, "EpiIn buffer stride");
static_assert(WS_XN + (size_t)MT * D * 2 <= WS_PB && WS_PB + (size_t)MT * PLE * 2 <= WS_Q && WS_Q + (size_t)MT * AW * 2 <= WS_K && WS_LOGF + (size_t)MT * RW * 4 <= WS_OREC &&
              WS_MIX + (size_t)MT * D * 2 <= WS_X1 && WS_X1 + (size_t)MT * D * 4 <= WS_A2 && WS_PJ + (size_t)MT * D * 2 <= WS_H && WS_H + (size_t)MT * FF * 2 <= WS_SSP1 && WS_SSP1 + (size_t)MT * 64 <= WS_SSP3, "d_ws map");
constexpr int CW_QA = 64, CW_QD = 128;
constexpr int CW_BAR = 4096;
static_assert((CW_BAR + XCD_BAR_WORDS) * 4 <= (int)CTL_ZERO_BYTES, "CTL words inside the memset region");

constexpr int RING_OFF = 0, RING_BYTES = 131072;
constexpr int LDSCTL_OFF = RING_BYTES, MISC_OFF = LDSCTL_OFF + 320;
constexpr int LDS_BYTES = 147456;
constexpr int NWAVES = 8;
constexpr int N_PHASES = 9;

struct Frame {
    LAS unsigned char* lds; volatile LAS unsigned* MISC; gu32* ctl;
    int tid, lane, wave, vcu, G;
};

__device__ __forceinline__ float wave_sum(float v) {
#pragma unroll
    for (int o = 1; o < 64; o <<= 1) v += __shfl_xor(v, o);
    return v;
}
__device__ __forceinline__ void p0_transpose_item(const float* W, int K, int N, bf16* WT, const float* kscale, LAS float* scr, int item, int lane) {
    const int nblk = N / 32, kb = item / nblk, nb = item % nblk, k0 = 64 * kb, n0 = 32 * nb;
#pragma unroll 8
    for (int i = 0; i < 32; ++i) { const int kk = 2 * i + (lane >> 5); float w = W[(size_t)(k0 + kk) * N + n0 + (lane & 31)]; if (kscale) w *= kscale[k0 + kk]; scr[kk * 33 + (lane & 31)] = w; }
    LDS_WAIT(); asm volatile("" ::: "memory");
    const int c = lane & 7;
#pragma unroll
    for (int j = 0; j < 4; ++j) { const int n = (lane >> 3) + 8 * j; const LAS float* s = scr + (8 * c) * 33 + n;
        v4u o; o.x = pk2(s[0 * 33], s[1 * 33]); o.y = pk2(s[2 * 33], s[3 * 33]); o.z = pk2(s[4 * 33], s[5 * 33]); o.w = pk2(s[6 * 33], s[7 * 33]);
        *(GAS v4u*)(WT + (size_t)(n0 + n) * K + k0 + 8 * c) = o; }
    LDS_WAIT(); asm volatile("" ::: "memory");
}
__device__ __forceinline__ void rms_row_to_bf16(const float* xrow, const float* g, bf16* orow, int lane) {
    const f32x4* xr = (const f32x4*)xrow + lane; const f32x4* gr = (const f32x4*)g + lane;
    f32x4 v[4]; float s = 0.f;
#pragma unroll
    for (int j = 0; j < 4; ++j) { v[j] = xr[64 * j]; s += (v[j].x * v[j].x + v[j].y * v[j].y) + (v[j].z * v[j].z + v[j].w * v[j].w); }
    const float r = 1.0f / sqrtf(wave_sum(s) * (1.f / D) + EPS);
    unsigned long long* o8 = (unsigned long long*)orow + lane;
#pragma unroll
    for (int j = 0; j < 4; ++j) { const f32x4 gg = gr[64 * j]; o8[64 * j] = (unsigned long long)pk2(v[j].x * r * gg.x, v[j].y * r * gg.y) | ((unsigned long long)pk2(v[j].z * r * gg.z, v[j].w * r * gg.w) << 32); }
}


struct Args { const float* in[24]; float* out; unsigned char* ws; int ph_lo, ph_hi, li, pad; };

#define x_prompt (args.in[0])
#define x_sample (args.in[1])
#define cache_k (args.in[2])
#define cache_v (args.in[3])
#define state0 (args.in[4])
#define ptab ((const int*)args.in[5])
#define p_prompt (args.in[6])
#define p_sample (args.in[7])
#define w_in (args.in[8])
#define g_subln (args.in[13])
#define hgrn_lb (args.in[14])
#define g_rec (args.in[15])
#define w_out (args.in[16])
#define g_mix (args.in[17])
#define g_ffn (args.in[18])
#define w_up (args.in[19])
#define w_down (args.in[20])
#define w_gate (args.in[21])
#define w_proj (args.in[22])
#define g_final (args.in[23])
#define OUTP (args.out)
#define WSP(T, off) ((T*)(args.ws + (off)))
#define WinT WSP(bf16, WS_WIN)
#define WoutT WSP(bf16, WS_WOUT)
#define WupT WSP(bf16, WS_WUP)
#define WdnT WSP(bf16, WS_WDN)
#define WgT WSP(bf16, WS_WG)
#define WpT WSP(bf16, WS_WP)
#define XN WSP(bf16, WS_XN)
#define PB WSP(bf16, WS_PB)
#define Qb WSP(bf16, WS_Q)
#define Kb WSP(bf16, WS_K)
#define Vb WSP(bf16, WS_V)
#define RQ WSP(bf16, WS_RQ)
#define RK WSP(bf16, WS_RK)
#define RV WSP(bf16, WS_RV)
#define RG WSP(bf16, WS_RG)
#define LOGF WSP(float, WS_LOGF)
#define OREC WSP(bf16, WS_OREC)
#define MIX WSP(bf16, WS_MIX)
#define X1 WSP(float, WS_X1)
#define A2 WSP(bf16, WS_A2)
#define A3 WSP(bf16, WS_A3)
#define PJ WSP(bf16, WS_PJ)
#define HB WSP(bf16, WS_H)
#define SSP1 WSP(float, WS_SSP1)
#define SSP3 WSP(float, WS_SSP3)
#define SC4 WSP(float, WS_SC4)
#define SC5 WSP(float, WS_SC5)
#define SC6 WSP(float, WS_SC6)
#define SC7 WSP(float, WS_SC7)
#define SS1S WSP(float, WS_SS1S)

__global__ void __launch_bounds__(NWAVES * 64, 2) mk_fwd(Args args) {
    extern __shared__ __attribute__((aligned(16))) unsigned char lds_raw[];
    Frame F;
    F.lds = (LAS unsigned char*)lds_raw;
    F.MISC = (volatile LAS unsigned*)(F.lds + MISC_OFF);
    F.tid = threadIdx.x; F.lane = F.tid & 63; F.wave = __builtin_amdgcn_readfirstlane(F.tid >> 6);
    F.G = gridDim.x; { const int bx = blockIdx.x; F.vcu = (F.G % 8 == 0) ? (bx % 8) * (F.G / 8) + bx / 8 : bx; }
    F.ctl = (gu32*)(args.ws + WS_CTL);
    for (int u = F.tid; u < (LDS_BYTES - LDSCTL_OFF) / 4; u += NWAVES * 64) ((LAS unsigned*)(F.lds + LDSCTL_OFF))[u] = 0u;
    __syncthreads();
    if (F.wave == 0) {
        const float a = args.in[9][F.lane] * args.in[10][F.lane], b = args.in[11][F.lane] * args.in[12][F.lane];
        const float lam = fexpn(wave_sum(a)) - fexpn(wave_sum(b)) + LAM_INIT;
        if (F.lane == 0) F.MISC[4] = __float_as_uint(lam);
    }
    XcdBarrier bar; bar.bar = (unsigned*)(F.ctl + CW_BAR); bar.x = 0; bar.st = nullptr;
    if (MK_N_LAUNCHES == 1) bar = xcd_barrier_post((unsigned*)(F.ctl + CW_BAR), F.MISC + 8);
    __syncthreads();
#define GRID_BAR() do { if (MK_N_LAUNCHES == 1) xcd_barrier(bar); } while (0)
    const int lo = args.ph_lo, hi = args.ph_hi;
#ifndef PH_MASK
#define PH_MASK 0x1ff
#endif
#define IN(k) ((((PH_MASK) >> (k)) & 1) && lo <= (k) && (k) < hi)
#define BOTH(k) (IN(k) && IN((k) + 1))
    const int gw = F.vcu * NWAVES + F.wave, NGW = F.G * NWAVES;

    if (IN(0)) {
        int tl_ = threadIdx.x; asm volatile("" : "+v"(tl_)); const int lane = tl_ & 63;
        LAS float* scr = (LAS float*)(F.lds + RING_OFF + F.wave * 16384);
        constexpr int I_IN = (D / 64) * (NIN / 32), I_O = (D / 64) * (D / 32), I_UP = (D / 64) * (FF / 32), I_DN = (FF / 64) * (D / 32), I_G = I_O, I_P = (PLE / 64) * (D / 32);
        constexpr int NITEMS = I_IN + I_O + I_UP + I_DN + I_G + I_P;
        for (int it = gw; it < NITEMS; it += NGW) {
            int r = it;
            if (r < I_IN) { p0_transpose_item(w_in, D, NIN, WinT, nullptr, scr, r, lane); continue; } r -= I_IN;
            if (r < I_O) { p0_transpose_item(w_out, D, D, WoutT, nullptr, scr, r, lane); continue; } r -= I_O;
            if (r < I_UP) { p0_transpose_item(w_up, D, FF, WupT, g_ffn, scr, r, lane); continue; } r -= I_UP;
            if (r < I_DN) { p0_transpose_item(w_down, FF, D, WdnT, nullptr, scr, r, lane); continue; } r -= I_DN;
            if (r < I_G) { p0_transpose_item(w_gate, D, D, WgT, nullptr, scr, r, lane); continue; } r -= I_G;
            p0_transpose_item(w_proj, PLE, D, WpT, nullptr, scr, r, lane);
        }
        for (int m = gw; m < MT; m += NGW) {
            if (m < MP + MS) {
                const float* xr = m < MP ? x_prompt + (size_t)m * D : x_sample + (size_t)(m - MP) * D;
                rms_row_to_bf16(xr, g_mix, XN + (size_t)m * D, lane);
                const float* pr = m < MP ? p_prompt + (size_t)m * PLE : p_sample + (size_t)(m - MP) * PLE;
                const f32x4 pv = ((const f32x4*)pr)[lane];
                ((unsigned long long*)(PB + (size_t)m * PLE))[lane] = (unsigned long long)pk2(pv.x, pv.y) | ((unsigned long long)pk2(pv.z, pv.w) << 32);
            } else {
                unsigned long long* o8 = (unsigned long long*)(XN + (size_t)m * D) + lane;
#pragma unroll
                for (int j = 0; j < 4; ++j) o8[64 * j] = 0ull;
                ((unsigned long long*)(PB + (size_t)m * PLE))[lane] = 0ull;
            }
        }
        { v4u* z = (v4u*)(args.ws + WS_SC4); const size_t nz = (WS_SC_END - WS_SC4) / 16;
          for (size_t i = (size_t)blockIdx.x * (NWAVES * 64) + tl_; i < nz; i += (size_t)F.G * (NWAVES * 64)) z[i] = (v4u){0u, 0u, 0u, 0u}; }
        if (BOTH(0)) GRID_BAR();
    }

    if (IN(1)) {
        { pg8::Gemm g{XN, WinT, MT, NIN, D}; pg8::StaticOrder S; S.init(MT, NIN, F.G, (int)blockIdx.x);
          pg8::EpiIn E{Qb, LOGF, OUTP, hgrn_lb};
          pg8::gemm_phase<pg8::EpiIn, pg8::StaticOrder, true, true>(F.lds + RING_OFF, g, S, E); }
        { pg8::Gemm g{PB, WpT, MT, D, PLE}; pg8::StaticOrder S; S.init(MT, D, F.G, (int)(F.G - 1 - blockIdx.x));
          pg8::EpiBf E{PJ, D};
          pg8::gemm_phase<pg8::EpiBf, pg8::StaticOrder, true, true>(F.lds + RING_OFF, g, S, E); }
        if (BOTH(1)) GRID_BAR();
    }

    if (IN(2)) {
        const float lam = __uint_as_float(F.MISC[4]);
#ifndef SKIP_HG
        if (blockIdx.x < 32) hg::unit((int)blockIdx.x, RQ, RK, RV, LOGF, OREC, OUTP + OUT_SP, F.lds + RING_OFF);
#endif
#ifndef SKIP_ATT
        for (;;) {
            if (F.tid == 0) F.MISC[0] = __hip_atomic_fetch_add(F.ctl + CW_QA, 1u, RLX_AGENT);
            LGKM_BAR();
            const int idx = (int)F.MISC[0];
            if (idx >= 512) break;
            const int qblk = 15 - (idx >> 5), bh = idx & 31;
            att::unit(bh >> 2, bh & 3, qblk, Qb, Kb, Vb, MIX, lam, g_subln, F.lds + RING_OFF);
        }
#endif
#ifndef SKIP_DEC
        for (;;) {
            if (F.tid == 0) F.MISC[1] = __hip_atomic_fetch_add(F.ctl + CW_QD, 1u, RLX_AGENT);
            LGKM_BAR();
            const int idx = (int)F.MISC[1];
            if (idx >= 512) break;
            dec::unit(idx >> 2, idx & 3, Qb, Kb, Vb, cache_k, cache_v, ptab, MIX, lam, g_subln, F.lds + RING_OFF);
        }
#endif
        for (int it = F.vcu; it < 512; it += F.G) hgrn_step(it >> 2, it & 3, RQ, RK, RV, LOGF, state0, OUTP + OUT_SS, OREC, F.lds + RING_OFF);
        if (BOTH(2)) GRID_BAR();
    }

    if (IN(3)) {
        int tl_ = threadIdx.x; asm volatile("" : "+v"(tl_)); const int lane = tl_ & 63;
        for (int m = gw; m < MP + MS; m += NGW) {
            const v4u ow = ((const v4u*)(OREC + (size_t)m * RW))[lane]; const v4u gw4 = ((const v4u*)(RG + (size_t)m * RW))[lane];
            float o[8] = {bflo(ow.x), bfhi(ow.x), bflo(ow.y), bfhi(ow.y), bflo(ow.z), bfhi(ow.z), bflo(ow.w), bfhi(ow.w)};
            const float gt[8] = {bflo(gw4.x), bfhi(gw4.x), bflo(gw4.y), bfhi(gw4.y), bflo(gw4.z), bfhi(gw4.z), bflo(gw4.w), bfhi(gw4.w)};
            float s = 0.f;
#pragma unroll
            for (int j = 0; j < 8; ++j) s += o[j] * o[j];
            const float r = 1.0f / sqrtf(wave_sum(s) * (1.f / RW) + EPS);
            const f32x4 g0 = ((const f32x4*)g_rec)[2 * lane], g1 = ((const f32x4*)g_rec)[2 * lane + 1];
            v4u w; w.x = pk2(o[0] * r * g0.x * gt[0], o[1] * r * g0.y * gt[1]); w.y = pk2(o[2] * r * g0.z * gt[2], o[3] * r * g0.w * gt[3]);
            w.z = pk2(o[4] * r * g1.x * gt[4], o[5] * r * g1.y * gt[5]); w.w = pk2(o[6] * r * g1.z * gt[6], o[7] * r * g1.w * gt[7]);
            ((v4u*)(MIX + (size_t)m * D + AW))[lane] = w;
        }
        if (BOTH(3)) GRID_BAR();
    }

    if (IN(4)) {
        pg8::Gemm g{MIX, WoutT, MP, D, D}; pg8::StaticOrder S; S.init(MP, D, F.G, (int)blockIdx.x);
        pg8::EpiOut E{x_prompt, x_sample, X1, A2, SSP1};
        pg8::gemm_phase<pg8::EpiOut, pg8::StaticOrder, true, true>(F.lds + RING_OFF, g, S, E);
        for (int it = blockIdx.x; it < 256; it += F.G) samp_item<4, D, D, 64>(it, MIX + (size_t)MP * D, nullptr, nullptr, nullptr, nullptr, nullptr, WoutT, SC4);
        if (BOTH(4)) GRID_BAR();
    }
    if (IN(5)) {
        pg8::Gemm g{A2, WupT, MP, FF, D}; pg8::StaticOrder S; S.init(MP, FF, F.G, (int)blockIdx.x);
        pg8::EpiUp E{HB, FF};
        pg8::gemm_phase<pg8::EpiUp, pg8::StaticOrder, true, true>(F.lds + RING_OFF, g, S, E);
        for (int it = blockIdx.x; it < 256; it += F.G) samp_item<5, FF, D, 256>(it, nullptr, x_sample, SC4, nullptr, nullptr, SS1S, WupT, SC5);
        if (BOTH(5)) GRID_BAR();
    }
    if (IN(6)) {
        pg8::Gemm g{HB, WdnT, MP, D, FF}; pg8::StaticOrder S; S.init(MP, D, F.G, (int)blockIdx.x);
        pg8::EpiDown E{X1, A3, SSP1};
        pg8::gemm_phase<pg8::EpiDown, pg8::StaticOrder, true, true>(F.lds + RING_OFF, g, S, E);
        for (int it = blockIdx.x; it < 256; it += F.G) samp_item<6, D, FF, 256>(it, nullptr, nullptr, nullptr, SC5, nullptr, nullptr, WdnT, SC6);
        if (BOTH(6)) GRID_BAR();
    }
    if (IN(7)) {
        pg8::Gemm g{A3, WgT, MP, D, D}; pg8::StaticOrder S; S.init(MP, D, F.G, (int)blockIdx.x);
        pg8::EpiGate E{X1, PJ, OUTP, SSP3};
        pg8::gemm_phase<pg8::EpiGate, pg8::StaticOrder, true, true>(F.lds + RING_OFF, g, S, E);
        for (int it = blockIdx.x; it < 256; it += F.G) samp_item<7, D, D, 64>(it, nullptr, x_sample, SC4, nullptr, SC6, SS1S, WgT, SC7);
        if (BOTH(7)) GRID_BAR();
    }
    if (IN(8)) {
        int tl_ = threadIdx.x; asm volatile("" : "+v"(tl_)); const int lane = tl_ & 63;
        for (int m = gw; m < MP; m += NGW) {
            float* yr = OUTP + OUT_YP + (size_t)m * D;
            const f32x4* sp = (const f32x4*)(SSP3 + (size_t)m * 16);
            const f32x4 ps = (sp[0] + sp[1]) + (sp[2] + sp[3]);
            const float r = 1.0f / sqrtf(((ps.x + ps.y) + (ps.z + ps.w)) * (1.f / D) + EPS);
            f32x4* y4 = (f32x4*)yr + lane; const f32x4* g4 = (const f32x4*)g_final + lane;
#pragma unroll
            for (int j = 0; j < 4; ++j) { const f32x4 v = y4[64 * j], gg = g4[64 * j]; y4[64 * j] = v * r * gg; }
        }
        for (int sr = NGW - 1 - gw; sr < MS; sr += NGW) {
            const float r2 = 1.0f / (SS1S[sr] * (1.0f / D) + EPS);
            const f32x4* xs4 = (const f32x4*)(x_sample + (size_t)sr * D) + lane; const f32x4* c4 = (const f32x4*)(SC4 + (size_t)sr * D) + lane;
            const f32x4* c6 = (const f32x4*)(SC6 + (size_t)sr * D) + lane; const f32x4* c7 = (const f32x4*)(SC7 + (size_t)sr * D) + lane;
            const u32x2v* pj = (const u32x2v*)(PJ + (size_t)(MP + sr) * D) + lane;
            f32x4 v[4]; float s = 0.f;
#pragma unroll
            for (int j = 0; j < 4; ++j) { const f32x4 x2 = xs4[64 * j] + c4[64 * j] + c6[64 * j] * r2, gt = c7[64 * j]; const u32x2v pw = pj[64 * j];
                v[j].x = x2.x + pg8::sigmoidf_(gt.x) * bflo(pw.x); v[j].y = x2.y + pg8::sigmoidf_(gt.y) * bfhi(pw.x); v[j].z = x2.z + pg8::sigmoidf_(gt.z) * bflo(pw.y); v[j].w = x2.w + pg8::sigmoidf_(gt.w) * bfhi(pw.y);
                s += (v[j].x * v[j].x + v[j].y * v[j].y) + (v[j].z * v[j].z + v[j].w * v[j].w); }
            const float r = 1.0f / sqrtf(wave_sum(s) * (1.f / D) + EPS);
            f32x4* y4 = (f32x4*)(OUTP + OUT_YS + (size_t)sr * D) + lane; const f32x4* g4 = (const f32x4*)g_final + lane;
#pragma unroll
            for (int j = 0; j < 4; ++j) y4[64 * j] = v[j] * r * g4[64 * j];
        }
    }
#undef IN
#undef BOTH
#undef GRID_BAR
}

#undef x_prompt
#undef x_sample
#undef cache_k
#undef cache_v
#undef state0
#undef ptab
#undef p_prompt
#undef p_sample
#undef w_in
#undef g_subln
#undef hgrn_lb
#undef g_rec
#undef w_out
#undef g_mix
#undef g_ffn
#undef w_up
#undef w_down
#undef w_gate
#undef w_proj
#undef g_final
#undef OUTP
#undef WSP
#undef WinT
#undef WoutT
#undef WupT
#undef WdnT
#undef WgT
#undef WpT
#undef XN
#undef PB
#undef Qb
#undef Kb
#undef Vb
#undef RQ
#undef RK
#undef RV
#undef RG
#undef LOGF
#undef OREC
#undef MIX
#undef X1
#undef A2
#undef A3
#undef PJ
#undef HB
#undef SSP1
#undef SSP3
#undef SC4
#undef SC5
#undef SC6
#undef SC7
#undef SS1S
extern "C" void kernel_launch(void* const* d_in, const int* in_sizes, int n_in, void* d_out, int out_size, void* d_ws, size_t ws_size, hipStream_t stream) {
    static int grid = 0;
    if (grid == 0) {
        if (n_in != 24 || in_sizes[0] != MP * D || (size_t)out_size != OUT_END || ws_size < WS_END) {
            fprintf(stderr, "kernel_launch: unexpected shapes: n_in %d, in0 %d, out %d, ws %zu; nothing launched\n", n_in, n_in > 0 ? in_sizes[0] : -1, out_size, ws_size); grid = -1; return; }
        int dev = 0, cus = 0, per_cu = 0;
        if (hipGetDevice(&dev) != hipSuccess || hipDeviceGetAttribute(&cus, hipDeviceAttributeMultiprocessorCount, dev) != hipSuccess) { grid = -1; return; }
        if (hipFuncSetAttribute((const void*)mk_fwd, hipFuncAttributeMaxDynamicSharedMemorySize, LDS_BYTES) != hipSuccess) { fprintf(stderr, "kernel_launch: hipFuncSetAttribute failed\n"); grid = -1; return; }
        if (hipOccupancyMaxActiveBlocksPerMultiprocessor(&per_cu, (const void*)mk_fwd, NWAVES * 64, LDS_BYTES) != hipSuccess || per_cu < 1) {
            fprintf(stderr, "kernel_launch: occupancy query reports %d workgroups per CU; nothing launched\n", per_cu); (void)hipGetLastError(); grid = -1; return; }
        (void)hipGetLastError();
        grid = cus;
    }
    if (grid < 0) return;
    if (hipMemsetAsync((char*)d_ws + WS_CTL, 0, CTL_ZERO_BYTES, stream) != hipSuccess) return;
    Args a{};
    for (int i = 0; i < 24; ++i) a.in[i] = (const float*)d_in[i];
    a.out = (float*)d_out; a.ws = (unsigned char*)d_ws;
    if (MK_N_LAUNCHES == 1) {
        a.ph_lo = 0; a.ph_hi = N_PHASES; a.li = 0;
        hipLaunchKernelGGL(mk_fwd, dim3(grid), dim3(NWAVES * 64), LDS_BYTES, stream, a);
    } else {
        for (int li = 0; li < N_PHASES; ++li) { a.ph_lo = li; a.ph_hi = li + 1; a.li = li; hipLaunchKernelGGL(mk_fwd, dim3(grid), dim3(NWAVES * 64), LDS_BYTES, stream, a); }
    }
}
```

```cpp
#include <hip/hip_runtime.h>
#include <hip/hip_bf16.h>
#include <cstdio>
#include <cstdint>
#include <cmath>

#ifndef MK_N_LAUNCHES
#define MK_N_LAUNCHES 1
#endif

constexpr int D = 1024, NB = 8, SEQ = 2048, MP = NB * SEQ, MS = 128, MT = 16640  ;
constexpr int NIN = 3584, FF = 4096, PLE = 256, AW = 512, RW = 512, NPAGES = 16, PAGE = 128;
constexpr float EPS = 1e-6f;
constexpr float LOG2E = 1.4426950408889634f;
constexpr float QSCALE = 0.125f * LOG2E;
constexpr float LAM_INIT = 0.2f;
constexpr size_t OUT_YP = 0, OUT_YS = OUT_YP + (size_t)MP * D, OUT_KP = OUT_YS + (size_t)MS * D, OUT_VP = OUT_KP + (size_t)MP * AW, OUT_SP = OUT_VP + (size_t)MP * AW,
                 OUT_KS = OUT_SP + (size_t)NB * 4 * 128 * 128, OUT_VS = OUT_KS + (size_t)MS * AW, OUT_SS = OUT_VS + (size_t)MS * AW, OUT_END = OUT_SS + (size_t)MS * 4 * 128 * 128;

namespace pg8 {
#define PG8_LAS __attribute__((address_space(3)))
typedef unsigned short bf16_t;
typedef short bf16x8 __attribute__((ext_vector_type(8)));
typedef float f32x4 __attribute__((ext_vector_type(4)));
typedef unsigned u32x4 __attribute__((ext_vector_type(4)));
typedef unsigned u32x2 __attribute__((ext_vector_type(2)));
constexpr int BM = 256, BK = 64, HALF = 128, HTB = HALF * BK * 2  , STAGE_BYTES = 8 * HTB, NXCD = 8, WGM = 8;

__host__ __device__ __forceinline__ int lds_byte(int r, int c) { const int st = (r >> 4) * 2 + (c >> 5), rr = r & 15, cc = c & 31, ob = rr * 64 + cc * 2; return st * 1024 + (ob ^ (((ob >> 9) & 1) << 5)); }
__host__ __device__ __forceinline__ void stage_rc(int b, int& R, int& C) { const int st = b / 1024, sb = b % 1024, swz = sb ^ (((sb >> 9) & 1) << 5); R = (st >> 1) * 16 + swz / 64; C = (st & 1) * 32 + (swz % 64) / 2; }
__host__ __device__ __forceinline__ int perm32(int rho) { const int n = rho >> 4, i = rho & 15; return 8 * (i >> 2) + 4 * n + (i & 3); }

struct Unit { int pm, pn; };
struct Gemm { const bf16_t* A; const bf16_t* Bt; int M, N, K; };

struct StaticOrder {
    int nM, nN, nwg, G, c;
    __host__ __device__ void init(int M, int N, int G_, int c_) { nM = M / BM; nN = N / BM; nwg = nM * nN; G = G_; c = c_; }
    __host__ __device__ bool next(int i, Unit& u) const {
        const long L = (long)i * G + c; if (L >= nwg) return false;
        int wgid = (int)L; { const int q = nwg / NXCD, r = nwg % NXCD, xcd = wgid % NXCD, off = wgid / NXCD; wgid = (xcd < r ? xcd * (q + 1) : r * (q + 1) + (xcd - r) * q) + off; }
        const int nig = WGM * nN, gid = wgid / nig, fm = gid * WGM, gsz = (nM - fm) < WGM ? (nM - fm) : WGM;
        u.pm = fm + ((wgid % nig) % gsz); u.pn = (wgid % nig) / gsz; return true;
    }
    __device__ __forceinline__ void a_ready(const Unit&) const {}
    __device__ __forceinline__ void done(const Unit&) const {}
};

__device__ __forceinline__ unsigned cvt_pk_bf16(float lo, float hi) { unsigned r; asm volatile("v_cvt_pk_bf16_f32 %0, %1, %2" : "=v"(r) : "v"(lo), "v"(hi)); return r; }
__device__ __forceinline__ u32x4 pack8(const f32x4 v0, const f32x4 v1) { u32x4 w; w.x = cvt_pk_bf16(v0[0], v0[1]); w.y = cvt_pk_bf16(v0[2], v0[3]); w.z = cvt_pk_bf16(v1[0], v1[1]); w.w = cvt_pk_bf16(v1[2], v1[3]); return w; }
__device__ __forceinline__ float fexp(float x) { return __builtin_amdgcn_exp2f(x * 1.4426950408889634f); }
__device__ __forceinline__ float frcp(float x) { return __builtin_amdgcn_rcpf(x); }
__device__ __forceinline__ float sigmoidf_(float x) { return frcp(1.0f + fexp(-x)); }
__device__ __forceinline__ float siluf_(float x) { return x * sigmoidf_(x); }
__device__ __forceinline__ f32x4 map4_silu(f32x4 v) { return (f32x4){siluf_(v[0]), siluf_(v[1]), siluf_(v[2]), siluf_(v[3])}; }

struct EpiIn {
    static constexpr bool PERM = true, AFTER_DRAIN = false;
    bf16_t* Q0; float* LOGF; float* out; const float* hlb;
    static constexpr size_t BUFSTRIDE = (size_t)17 * 1024 * 1024 / 2;
    __device__ __forceinline__ void operator()(const f32x4 (&acc)[2][2][4][2], const Unit& u, int wr, int wc, int fr, int fq) const {
        const int type = u.pn >> 1;
        const int cb = (u.pn & 1) * 256 + wc * 32 + 8 * fq;
        const int row0 = u.pm * BM + wr * 64 + fr;
        const bool prow = u.pm < 64;
        if (type == 0 || type == 3 || type == 5 || type == 6) {
            bf16_t* base = Q0 + (size_t)type * BUFSTRIDE;
#pragma unroll
            for (int ai = 0; ai < 2; ++ai)
#pragma unroll
                for (int m = 0; m < 4; ++m) { bf16_t* rowp = base + (size_t)(row0 + ai * HALF + m * 16) * 512 + cb;
#pragma unroll
                    for (int bj = 0; bj < 2; ++bj) { f32x4 v0 = acc[ai][bj][m][0], v1 = acc[ai][bj][m][1];
                        if (type == 0) { v0 = v0 * QSCALE; v1 = v1 * QSCALE; }
                        else if (type != 5) { v0 = map4_silu(v0); v1 = map4_silu(v1); }
                        *(u32x4*)(rowp + bj * HALF) = pack8(v0, v1); } }
        } else if (type == 1 || type == 2) {
            bf16_t* base = Q0 + (size_t)type * BUFSTRIDE;
            float* ob = out + (type == 1 ? (prow ? OUT_KP : OUT_KS) : (prow ? OUT_VP : OUT_VS));
#pragma unroll
            for (int ai = 0; ai < 2; ++ai)
#pragma unroll
                for (int m = 0; m < 4; ++m) { const int row = row0 + ai * HALF + m * 16; bf16_t* rowp = base + (size_t)row * 512 + cb;
                    const bool ok = prow || ai == 0; float* orow = ob + (size_t)(prow ? row : row - MP) * 512 + cb;
#pragma unroll
                    for (int bj = 0; bj < 2; ++bj) { const f32x4 v0 = acc[ai][bj][m][0], v1 = acc[ai][bj][m][1];
                        *(u32x4*)(rowp + bj * HALF) = pack8(v0, v1);
                        if (ok) { *(f32x4*)(orow + bj * HALF) = v0; *(f32x4*)(orow + bj * HALF + 4) = v1; } } }
        } else {
#pragma unroll
            for (int bj = 0; bj < 2; ++bj) {
                f32x4 lb[2];
#pragma unroll
                for (int n = 0; n < 2; ++n) { const f32x4 l0 = *(const f32x4*)(hlb + cb + bj * HALF + 4 * n), l1 = *(const f32x4*)(hlb + 512 + cb + bj * HALF + 4 * n);
#pragma unroll
                    for (int j = 0; j < 4; ++j) lb[n][j] = frcp(1.0f + fexp(l1[j] - l0[j])); }
#pragma unroll
                for (int ai = 0; ai < 2; ++ai)
#pragma unroll
                    for (int m = 0; m < 4; ++m) { const size_t ro = (size_t)(row0 + ai * HALF + m * 16) * 512 + cb + bj * HALF; f32x4 lf[2], kk[2];
#pragma unroll
                        for (int n = 0; n < 2; ++n)
#pragma unroll
                            for (int j = 0; j < 4; ++j) { const float x = acc[ai][bj][m][n][j], e = fexp(-x), sg = frcp(1.0f + e), l = lb[n][j];
                                const float f = l + (1.0f - l) * sg; lf[n][j] = __builtin_amdgcn_logf(f) * 0.6931471805599453f; kk[n][j] = (1.0f - l) * (e * sg); }
                        *(f32x4*)(LOGF + ro) = lf[0]; *(f32x4*)(LOGF + ro + 4) = lf[1];
                        *(u32x4*)(Q0 + 4 * BUFSTRIDE + ro) = pack8(kk[0], kk[1]); }
            }
        }
    }
};

struct EpiBf {
    static constexpr bool PERM = true, AFTER_DRAIN = false;
    bf16_t* O; int ldc;
    __device__ __forceinline__ void operator()(const f32x4 (&acc)[2][2][4][2], const Unit& u, int wr, int wc, int fr, int fq) const {
        const int row0 = u.pm * BM + wr * 64 + fr, col0 = u.pn * BM + wc * 32 + 8 * fq;
#pragma unroll
        for (int ai = 0; ai < 2; ++ai)
#pragma unroll
            for (int m = 0; m < 4; ++m) { bf16_t* rowp = O + (size_t)(row0 + ai * HALF + m * 16) * ldc + col0;
#pragma unroll
                for (int bj = 0; bj < 2; ++bj) *(u32x4*)(rowp + bj * HALF) = pack8(acc[ai][bj][m][0], acc[ai][bj][m][1]); }
    }
};
struct EpiUp {
    static constexpr bool PERM = true, AFTER_DRAIN = false;
    bf16_t* O; int ldc;
    __device__ __forceinline__ void operator()(const f32x4 (&acc)[2][2][4][2], const Unit& u, int wr, int wc, int fr, int fq) const {
        const int row0 = u.pm * BM + wr * 64 + fr, col0 = u.pn * BM + wc * 32 + 8 * fq;
#pragma unroll
        for (int ai = 0; ai < 2; ++ai)
#pragma unroll
            for (int m = 0; m < 4; ++m) { bf16_t* rowp = O + (size_t)(row0 + ai * HALF + m * 16) * ldc + col0;
#pragma unroll
                for (int bj = 0; bj < 2; ++bj) { f32x4 v0 = acc[ai][bj][m][0], v1 = acc[ai][bj][m][1];
#pragma unroll
                    for (int j = 0; j < 4; ++j) { const float a = fmaxf(v0[j], 0.f), b = fmaxf(v1[j], 0.f); v0[j] = a * a; v1[j] = b * b; }
                    *(u32x4*)(rowp + bj * HALF) = pack8(v0, v1); } }
    }
};
struct EpiOut {
    static constexpr bool PERM = true, AFTER_DRAIN = false;
    const float* xp; const float* xs; float* X1; bf16_t* A2; float* SSP;
    __device__ __forceinline__ void operator()(const f32x4 (&acc)[2][2][4][2], const Unit& u, int wr, int wc, int fr, int fq) const {
        const int row0 = u.pm * BM + wr * 64 + fr, col0 = u.pn * BM + wc * 32 + 8 * fq; const bool prow = u.pm < 64;
#pragma unroll
        for (int ai = 0; ai < 2; ++ai) { if (!prow && ai == 1) break;
#pragma unroll
            for (int m = 0; m < 4; ++m) { const int row = row0 + ai * HALF + m * 16; const float* xr = (prow ? xp + (size_t)row * D : xs + (size_t)(row - MP) * D) + col0;
                float s = 0.f;
#pragma unroll
                for (int bj = 0; bj < 2; ++bj) { const f32x4 a0 = *(const f32x4*)(xr + bj * HALF), a1 = *(const f32x4*)(xr + bj * HALF + 4);
                    const f32x4 v0 = a0 + acc[ai][bj][m][0], v1 = a1 + acc[ai][bj][m][1];
                    s += (v0[0] * v0[0] + v0[1] * v0[1]) + (v0[2] * v0[2] + v0[3] * v0[3]) + (v1[0] * v1[0] + v1[1] * v1[1]) + (v1[2] * v1[2] + v1[3] * v1[3]);
                    float* o = X1 + (size_t)row * D + col0 + bj * HALF; *(f32x4*)o = v0; *(f32x4*)(o + 4) = v1;
                    *(u32x4*)(A2 + (size_t)row * D + col0 + bj * HALF) = pack8(v0, v1); }
                s += __shfl_xor(s, 16); s += __shfl_xor(s, 32);
                if (fq == 0) SSP[(size_t)row * 16 + u.pn * 4 + wc] = s; } }
    }
};
struct EpiDown {
    static constexpr bool PERM = true, AFTER_DRAIN = false;
    const float* X1; float* X2; bf16_t* A3; const float* SSP;
    __device__ __forceinline__ void operator()(const f32x4 (&acc)[2][2][4][2], const Unit& u, int wr, int wc, int fr, int fq) const {
        const int row0 = u.pm * BM + wr * 64 + fr, col0 = u.pn * BM + wc * 32 + 8 * fq; const bool prow = u.pm < 64;
#pragma unroll
        for (int ai = 0; ai < 2; ++ai) { if (!prow && ai == 1) break;
#pragma unroll
            for (int m = 0; m < 4; ++m) { const int row = row0 + ai * HALF + m * 16;
                const f32x4 p0 = *(const f32x4*)(SSP + (size_t)row * 16), p1 = *(const f32x4*)(SSP + (size_t)row * 16 + 4), p2 = *(const f32x4*)(SSP + (size_t)row * 16 + 8), p3 = *(const f32x4*)(SSP + (size_t)row * 16 + 12);
                const f32x4 ps = (p0 + p1) + (p2 + p3); const float ss = (ps[0] + ps[1]) + (ps[2] + ps[3]);
                const float r2 = frcp(ss * (1.0f / D) + EPS);
#pragma unroll
                for (int bj = 0; bj < 2; ++bj) { const float* xi = X1 + (size_t)row * D + col0 + bj * HALF; float* o = X2 + (size_t)row * D + col0 + bj * HALF;
                    const f32x4 v0 = *(const f32x4*)xi + acc[ai][bj][m][0] * r2, v1 = *(const f32x4*)(xi + 4) + acc[ai][bj][m][1] * r2;
                    *(f32x4*)o = v0; *(f32x4*)(o + 4) = v1;
                    *(u32x4*)(A3 + (size_t)row * D + col0 + bj * HALF) = pack8(v0, v1); } } }
    }
};
struct EpiGate {
    static constexpr bool PERM = true, AFTER_DRAIN = false;
    const float* X1; const bf16_t* PJ; float* out; float* SSP;
    __device__ __forceinline__ void operator()(const f32x4 (&acc)[2][2][4][2], const Unit& u, int wr, int wc, int fr, int fq) const {
        const int row0 = u.pm * BM + wr * 64 + fr, col0 = u.pn * BM + wc * 32 + 8 * fq; const bool prow = u.pm < 64;
#pragma unroll
        for (int ai = 0; ai < 2; ++ai) { if (!prow && ai == 1) break;
#pragma unroll
            for (int m = 0; m < 4; ++m) { const int row = row0 + ai * HALF + m * 16; float* orow = out + (size_t)row * D + col0;
                float s = 0.f;
#pragma unroll
                for (int bj = 0; bj < 2; ++bj) { const float* xr = X1 + (size_t)row * D + col0 + bj * HALF; const f32x4 a0 = *(const f32x4*)xr, a1 = *(const f32x4*)(xr + 4);
                    const u32x4 pj = *(const u32x4*)(PJ + (size_t)row * D + col0 + bj * HALF);
                    f32x4 v0, v1;
#pragma unroll
                    for (int j = 0; j < 4; ++j) { const unsigned w0 = pj[j >> 1], w1 = pj[2 + (j >> 1)];
                        const float pa = __uint_as_float((j & 1) ? (w0 & 0xffff0000u) : (w0 << 16)), pb = __uint_as_float((j & 1) ? (w1 & 0xffff0000u) : (w1 << 16));
                        v0[j] = a0[j] + sigmoidf_(acc[ai][bj][m][0][j]) * pa; v1[j] = a1[j] + sigmoidf_(acc[ai][bj][m][1][j]) * pb; }
                    s += (v0[0] * v0[0] + v0[1] * v0[1]) + (v0[2] * v0[2] + v0[3] * v0[3]) + (v1[0] * v1[0] + v1[1] * v1[1]) + (v1[2] * v1[2] + v1[3] * v1[3]);
                    *(f32x4*)(orow + bj * HALF) = v0; *(f32x4*)(orow + bj * HALF + 4) = v1; }
                s += __shfl_xor(s, 16); s += __shfl_xor(s, 32);
                if (fq == 0) SSP[(size_t)row * 16 + u.pn * 4 + wc] = s; } }
    }
};

template <class Epi, class Sched, bool ALIGN_EPI = false, bool SP2 = false>
__device__ __forceinline__ void gemm_phase(PG8_LAS unsigned char* lds, const Gemm g, const Sched& S, const Epi& E) {
    const int tid = threadIdx.x, wid = __builtin_amdgcn_readfirstlane(tid >> 6), lane = tid & 63, wr = wid >> 2, wc = wid & 3, fr = lane & 15, fq = lane >> 4;
    const int K = g.K, nt = K / BK;
    unsigned voffA[2], voffB[2];
#pragma unroll
    for (int i = 0; i < 2; ++i) { int R, C; stage_rc(tid * 16 + i * 8192, R, C); const int Rb = Epi::PERM ? ((R & ~31) + perm32(R & 31)) : R;
        voffA[i] = (unsigned)(R * K + C) * 2u; voffB[i] = (unsigned)(Rb * K + C) * 2u; }
    const size_t kstep = (size_t)(BK * 2);
    const size_t hstep = (size_t)HALF * K * 2;
    const size_t tstep = 2 * hstep;
    const unsigned ldsw = (unsigned)wid * 1024u;
    const int aoff = lds_byte(wr * 64 + fr, fq * 8), boff = lds_byte(wc * 32 + fr, fq * 8);
#define PG8_SA(b, h) (((b) * 2 + (h)) * HTB)
#define PG8_SB(b, h) ((4 + (b) * 2 + (h)) * HTB)
#define PG8_STAGE(bufoff, gbase, voff) do { _Pragma("unroll") for (int _i = 0; _i < 2; ++_i) \
        __builtin_amdgcn_global_load_lds((const unsigned*)((const char*)(gbase) + (voff)[_i]), (PG8_LAS unsigned*)(lds + (bufoff) + ldsw + _i * 8192), 16, 0, 0); } while (0)
#define PG8_LDA(dst, b, h) do { _Pragma("unroll") for (int m = 0; m < 4; ++m) _Pragma("unroll") for (int k = 0; k < 2; ++k) dst[m][k] = *(const PG8_LAS bf16x8*)(lds + PG8_SA(b, h) + aoff + m * 2048 + k * 1024); } while (0)
#define PG8_LDB(dst, b, h) do { _Pragma("unroll") for (int n = 0; n < 2; ++n) _Pragma("unroll") for (int k = 0; k < 2; ++k) dst[n][k] = *(const PG8_LAS bf16x8*)(lds + PG8_SB(b, h) + boff + n * 2048 + k * 1024); } while (0)
#define PG8_MMA(ai, bj, At, Bt) do { __builtin_amdgcn_s_setprio(1); _Pragma("unroll") for (int m = 0; m < 4; ++m) _Pragma("unroll") for (int n = 0; n < 2; ++n) _Pragma("unroll") for (int k = 0; k < 2; ++k) \
        acc[ai][bj][m][n] = __builtin_amdgcn_mfma_f32_16x16x32_bf16(Bt[n][k], At[m][k], acc[ai][bj][m][n], 0, 0, 0); __builtin_amdgcn_s_setprio(0); } while (0)
#define PG8_WAIT_V(n) asm volatile("s_waitcnt vmcnt(" #n ")" ::: "memory")
#define PG8_WAIT_L(n) asm volatile("s_waitcnt lgkmcnt(" #n ")" ::: "memory")
#define PG8_BAR __builtin_amdgcn_s_barrier()
#define PG8_SCHED __builtin_amdgcn_sched_barrier(0)
    Unit cur, nxt; int ui = 0;
    if (!S.next(0, cur)) return;
    f32x4 acc[2][2][4][2];
#pragma unroll
    for (int a = 0; a < 2; ++a)
#pragma unroll
        for (int b = 0; b < 2; ++b)
#pragma unroll
            for (int m = 0; m < 4; ++m)
#pragma unroll
                for (int n = 0; n < 2; ++n) acc[a][b][m][n] = (f32x4){0.f, 0.f, 0.f, 0.f};
    bf16x8 At[4][2], B0[2][2], B1[2][2];
    const char* cA = (const char*)g.A + (size_t)cur.pm * tstep; const char* cB = (const char*)g.Bt + (size_t)cur.pn * tstep;
    S.a_ready(cur);
    if constexpr (SP2) {
        PG8_STAGE(PG8_SB(0, 0), cB, voffB); PG8_STAGE(PG8_SB(0, 1), cB + hstep, voffB); PG8_STAGE(PG8_SA(0, 0), cA, voffA); PG8_STAGE(PG8_SA(0, 1), cA + hstep, voffA);
        if (wr == 1) PG8_BAR;
        PG8_WAIT_V(2); PG8_BAR;
        PG8_STAGE(PG8_SB(1, 0), cB + kstep, voffB); PG8_STAGE(PG8_SA(1, 0), cA + kstep, voffA); PG8_STAGE(PG8_SB(1, 1), cB + hstep + kstep, voffB);
        PG8_WAIT_V(6); PG8_BAR;
    } else {
        PG8_STAGE(PG8_SB(0, 0), cB, voffB); PG8_STAGE(PG8_SA(0, 0), cA, voffA); PG8_STAGE(PG8_SB(0, 1), cB + hstep, voffB); PG8_STAGE(PG8_SA(0, 1), cA + hstep, voffA);
        if (wr == 1) PG8_BAR;
        PG8_WAIT_V(4); PG8_BAR;
        PG8_STAGE(PG8_SB(1, 0), cB + kstep, voffB); PG8_STAGE(PG8_SA(1, 0), cA + kstep, voffA); PG8_STAGE(PG8_SB(1, 1), cB + hstep + kstep, voffB);
        PG8_WAIT_V(6); PG8_BAR;
    }
    for (;;) {
        const bool has_next = S.next(ui + 1, nxt);
        const char* nA = has_next ? (const char*)g.A + (size_t)nxt.pm * tstep : cA; const char* nB = has_next ? (const char*)g.Bt + (size_t)nxt.pn * tstep : cB;
        for (int t = 0; t < nt; t += 2) {
            const bool last = (t == nt - 2);
            const char* a1 = cA + (size_t)(t + 1) * kstep;
            const char* a2 = last ? nA : cA + (size_t)(t + 2) * kstep; const char* b2 = last ? nB : cB + (size_t)(t + 2) * kstep;
            const char* a3 = a2 + kstep; const char* b3 = b2 + kstep;
            if (last && has_next) S.a_ready(nxt);
            if constexpr (SP2) {
            PG8_LDB(B0, 0, 0); PG8_LDB(B1, 0, 1); PG8_SCHED; PG8_LDA(At, 0, 0); PG8_STAGE(PG8_SA(1, 1), a1 + hstep, voffA);
            PG8_WAIT_V(8); PG8_WAIT_L(0); PG8_BAR; PG8_MMA(0, 0, At, B0); PG8_MMA(0, 1, At, B1); PG8_BAR; PG8_SCHED;
            PG8_LDA(At, 0, 1); PG8_STAGE(PG8_SB(0, 0), b2, voffB); PG8_STAGE(PG8_SB(0, 1), b2 + hstep, voffB); PG8_STAGE(PG8_SA(0, 0), a2, voffA);
            PG8_WAIT_V(8); PG8_WAIT_L(0); PG8_BAR; PG8_MMA(1, 0, At, B0); PG8_MMA(1, 1, At, B1); PG8_BAR; PG8_SCHED;
            PG8_LDB(B0, 1, 0); PG8_LDB(B1, 1, 1); PG8_SCHED; PG8_LDA(At, 1, 0); PG8_STAGE(PG8_SA(0, 1), a2 + hstep, voffA);
            PG8_WAIT_V(8); PG8_WAIT_L(0); PG8_BAR; PG8_MMA(0, 0, At, B0); PG8_MMA(0, 1, At, B1); PG8_BAR; PG8_SCHED;
            PG8_LDA(At, 1, 1); PG8_STAGE(PG8_SB(1, 0), b3, voffB); PG8_STAGE(PG8_SB(1, 1), b3 + hstep, voffB); PG8_STAGE(PG8_SA(1, 0), a3, voffA);
            PG8_WAIT_V(8); PG8_WAIT_L(0); PG8_BAR; PG8_MMA(1, 0, At, B0); PG8_MMA(1, 1, At, B1); PG8_BAR; PG8_SCHED;
            } else {
            PG8_LDB(B0, 0, 0); PG8_SCHED; PG8_LDA(At, 0, 0); PG8_STAGE(PG8_SA(1, 1), a1 + hstep, voffA);
            PG8_WAIT_L(8); PG8_BAR; PG8_WAIT_L(0); PG8_MMA(0, 0, At, B0); PG8_BAR; PG8_SCHED;
            PG8_LDB(B1, 0, 1); PG8_STAGE(PG8_SB(0, 0), b2, voffB);
            PG8_BAR; PG8_WAIT_L(0); PG8_MMA(0, 1, At, B1); PG8_BAR;
            PG8_LDA(At, 0, 1); PG8_STAGE(PG8_SA(0, 0), a2, voffA);
            PG8_BAR; PG8_WAIT_L(0); PG8_MMA(1, 0, At, B0); PG8_BAR; PG8_SCHED;
            PG8_STAGE(PG8_SB(0, 1), b2 + hstep, voffB);
            PG8_WAIT_V(6); PG8_BAR; PG8_MMA(1, 1, At, B1); PG8_BAR;
            PG8_LDB(B0, 1, 0); PG8_SCHED; PG8_LDA(At, 1, 0); PG8_STAGE(PG8_SA(0, 1), a2 + hstep, voffA);
            PG8_WAIT_L(8); PG8_BAR; PG8_WAIT_L(0); PG8_MMA(0, 0, At, B0); PG8_BAR; PG8_SCHED;
            PG8_LDB(B1, 1, 1); PG8_STAGE(PG8_SB(1, 0), b3, voffB);
            PG8_BAR; PG8_WAIT_L(0); PG8_MMA(0, 1, At, B1); PG8_BAR;
            PG8_LDA(At, 1, 1); PG8_STAGE(PG8_SA(1, 0), a3, voffA);
            PG8_BAR; PG8_WAIT_L(0); PG8_MMA(1, 0, At, B0); PG8_BAR; PG8_SCHED;
            PG8_STAGE(PG8_SB(1, 1), b3 + hstep, voffB);
            PG8_WAIT_V(6); PG8_BAR; PG8_MMA(1, 1, At, B1); PG8_BAR;
            }
        }
        if constexpr (ALIGN_EPI) { if (wr == 0) PG8_BAR; }
        if constexpr (!Epi::AFTER_DRAIN) { E(acc, cur, wr, wc, fr, fq); S.done(cur); }
        if (!has_next) break;
#pragma unroll
        for (int a = 0; a < 2; ++a)
#pragma unroll
            for (int b = 0; b < 2; ++b)
#pragma unroll
                for (int m = 0; m < 4; ++m)
#pragma unroll
                    for (int n = 0; n < 2; ++n) acc[a][b][m][n] = (f32x4){0.f, 0.f, 0.f, 0.f};
        cur = nxt; cA = nA; cB = nB; ++ui;
        if constexpr (ALIGN_EPI) { if (wr == 1) PG8_BAR; }
    }
    PG8_WAIT_V(0);
    if constexpr (!ALIGN_EPI) { if (wr == 0) PG8_BAR; }
    PG8_BAR;
    if constexpr (Epi::AFTER_DRAIN) { E.fused(acc, cur, wr, wc, fr, fq, lds, wid, lane); S.done(cur); }
#undef PG8_SA
#undef PG8_SB
#undef PG8_STAGE
#undef PG8_LDA
#undef PG8_LDB
#undef PG8_MMA
#undef PG8_WAIT_V
#undef PG8_WAIT_L
#undef PG8_BAR
#undef PG8_SCHED
}
}
#define GAS __attribute__((address_space(1)))
#define LAS __attribute__((address_space(3)))
typedef unsigned short bf16;
typedef unsigned v4u __attribute__((ext_vector_type(4)));
typedef float f32x4 __attribute__((ext_vector_type(4)));
typedef short bf16x8 __attribute__((ext_vector_type(8)));
typedef GAS unsigned gu32;
typedef GAS unsigned long long gu64;
#define RLX_AGENT __ATOMIC_RELAXED, __HIP_MEMORY_SCOPE_AGENT
#define LDS_WAIT() asm volatile("s_waitcnt lgkmcnt(0)" ::: "memory")
#define VM_WAIT() asm volatile("s_waitcnt vmcnt(0)" ::: "memory")
__device__ __forceinline__ unsigned long long rt() { return __builtin_amdgcn_s_memrealtime(); }
__device__ __forceinline__ unsigned f2bf(float f) { unsigned u = __builtin_bit_cast(unsigned, f); return (u + 0x7fffu + ((u >> 16) & 1u)) >> 16; }
__device__ __forceinline__ unsigned pk2(float lo, float hi) { return f2bf(lo) | (f2bf(hi) << 16); }

#define XB_TMO      128
#define XB_XCNT(j)  (256  + 64 * (j))
#define XB_XSUB(j)  (1280 + 64 * (j))
#define XB_XGEN(j)  (2304 + 64 * (j))
#define XB_TOP      3328
#define XB_TOPGEN   3392
#define XCD_BAR_WORDS 3456
#define XB_SPIN_CAP (1u << 18)

__device__ __forceinline__ unsigned xb_ld(unsigned* p)              { return __hip_atomic_load(p, __ATOMIC_RELAXED, __HIP_MEMORY_SCOPE_AGENT); }
__device__ __forceinline__ unsigned xb_add(unsigned* p, unsigned v) { return __hip_atomic_fetch_add(p, v, __ATOMIC_RELAXED, __HIP_MEMORY_SCOPE_AGENT); }
__device__ __forceinline__ unsigned xb_xcc_id() { return (unsigned)__builtin_amdgcn_s_getreg((3 << 11) | 20) & 0xFu; }
#define XB_SPIN(cond, bar) do { unsigned _sp = 0; while (cond) { __builtin_amdgcn_s_sleep(1); \
    if ((++_sp & 255u) == 0u) { if (xb_ld(&(bar)[XB_TMO])) break; if (_sp > XB_SPIN_CAP) { atomicAdd(&(bar)[XB_TMO], 1u); break; } } } } while (0)

struct XcdBarrier {
    unsigned* bar; unsigned x;
    volatile LAS unsigned* st;
};

__device__ __forceinline__ XcdBarrier xcd_barrier_post(unsigned* bar, volatile LAS unsigned* st) {
    XcdBarrier b; b.bar = bar; b.x = xb_xcc_id(); b.st = st;
    if (threadIdx.x == 0) (void)xb_add(&bar[XB_XCNT(b.x)], 1u);
    return b;
}
__device__ __forceinline__ void xcd_barrier_complete(unsigned* bar, unsigned x, unsigned& nloc, unsigned& nx) {
    const unsigned G = gridDim.x * gridDim.y * gridDim.z;
    unsigned sum, cnt, mine, sp = 0u;
    for (;;) {
        sum = 0u; cnt = 0u; mine = 0u;
#pragma unroll
        for (unsigned j = 0; j < 16; ++j) { const unsigned c = xb_ld(&bar[XB_XCNT(j)]); sum += c; cnt += (c > 0u) ? 1u : 0u; mine = (j == x) ? c : mine; }
        if (sum == G) break;
        __builtin_amdgcn_s_sleep(1);
        if ((++sp & 255u) == 0u) { if (xb_ld(&bar[XB_TMO])) break; if (sp > XB_SPIN_CAP) { atomicAdd(&bar[XB_TMO], 1u); break; } }
    }
    nloc = mine > 0u ? mine : 1u; nx = cnt > 0u ? cnt : 1u;
}

__device__ __forceinline__ void xcd_barrier(const XcdBarrier& b) {
    asm volatile("s_waitcnt vmcnt(0)" ::: "memory");
    __syncthreads();
    if (threadIdx.x == 0) {
        unsigned* bar = b.bar;
        __builtin_amdgcn_s_waitcnt(0);
        unsigned nloc = b.st[0], nx = b.st[1];
        if (nloc == 0u) { xcd_barrier_complete(bar, b.x, nloc, nx); b.st[0] = nloc; b.st[1] = nx; }
        const unsigned old = xb_add(&bar[XB_XSUB(b.x)], 1u);
        const unsigned gen = old / nloc;
        if (old + 1u == (gen + 1u) * nloc) {
            __builtin_amdgcn_fence(__ATOMIC_RELEASE, "agent");
            asm volatile("s_waitcnt vmcnt(0)" ::: "memory");
            const unsigned og = xb_add(&bar[XB_TOP], 1u);
            const unsigned tg = og / nx;
            if (og + 1u == (tg + 1u) * nx) xb_add(&bar[XB_TOPGEN], 1u);
            else XB_SPIN(xb_ld(&bar[XB_TOPGEN]) == tg, bar);
            __builtin_amdgcn_fence(__ATOMIC_ACQUIRE, "agent");
            xb_add(&bar[XB_XGEN(b.x)], 1u);
            asm volatile("s_waitcnt vmcnt(0)" ::: "memory");
        } else {
            XB_SPIN(xb_ld(&bar[XB_XGEN(b.x)]) == gen, bar);
            __builtin_amdgcn_fence(__ATOMIC_ACQUIRE, "agent");
            asm volatile("s_waitcnt vmcnt(0)" ::: "memory");
        }
    }
    __syncthreads();
}

typedef float f32x16 __attribute__((ext_vector_type(16)));
typedef short s16x4 __attribute__((ext_vector_type(4)));
typedef unsigned u32x2v __attribute__((ext_vector_type(2)));
typedef LAS unsigned char* ldsp_t;
#define WAITV0_BAR() asm volatile("s_waitcnt vmcnt(0) lgkmcnt(0)\n\ts_barrier" ::: "memory")
#define LGKM_BAR() asm volatile("s_waitcnt lgkmcnt(0)\n\ts_barrier" ::: "memory")
__device__ __forceinline__ int crow(int r, int hi) { return (r & 3) + 8 * (r >> 2) + 4 * hi; }
__device__ __forceinline__ unsigned cvtpk(float lo, float hi) { unsigned r; asm volatile("v_cvt_pk_bf16_f32 %0, %1, %2" : "=v"(r) : "v"(lo), "v"(hi)); return r; }
__device__ __forceinline__ float bf2f(unsigned short b) { return __uint_as_float((unsigned)b << 16); }
__device__ __forceinline__ float bflo(unsigned w) { return __uint_as_float(w << 16); }
__device__ __forceinline__ float bfhi(unsigned w) { return __uint_as_float(w & 0xffff0000u); }
__device__ __forceinline__ float ex2(float x) { return __builtin_amdgcn_exp2f(x); }
__device__ __forceinline__ float fexpn(float x) { return __builtin_amdgcn_exp2f(x * LOG2E); }
__device__ __forceinline__ float swap_max(float v) { auto rr = __builtin_amdgcn_permlane32_swap(__float_as_uint(v), __float_as_uint(v), false, false); return fmaxf(__uint_as_float(rr[0]), __uint_as_float(rr[1])); }
__device__ __forceinline__ float swap_sum(float v) { auto rr = __builtin_amdgcn_permlane32_swap(__float_as_uint(v), __float_as_uint(v), false, false); return __uint_as_float(rr[0]) + __uint_as_float(rr[1]); }
__device__ __forceinline__ s16x4 vtr(LAS const unsigned char* p) { return __builtin_bit_cast(s16x4, __builtin_amdgcn_ds_read_tr16_b64_v4i16((LAS s16x4*)p)); }
__device__ __forceinline__ bf16x8 cat8(s16x4 a, s16x4 b) { return (bf16x8){a[0], a[1], a[2], a[3], b[0], b[1], b[2], b[3]}; }
__device__ __forceinline__ bf16x8 accfrag(const f32x16& x, int s) {
    v4u w; w.x = cvtpk(x[8 * s + 0], x[8 * s + 1]); w.y = cvtpk(x[8 * s + 2], x[8 * s + 3]); w.z = cvtpk(x[8 * s + 4], x[8 * s + 5]); w.w = cvtpk(x[8 * s + 6], x[8 * s + 7]);
    return __builtin_bit_cast(bf16x8, w);
}
#define DMA16(gsrc, ldsdst) __builtin_amdgcn_global_load_lds((const unsigned*)(gsrc), (LAS unsigned*)(ldsdst), 16, 0, 0)
__device__ __forceinline__ void dma_vimg(const bf16* src, int pitch, ldsp_t img, int wid, int lane) {
    const int sub = lane >> 5, row = (lane & 31) >> 2, ch = lane & 3;
#pragma unroll
    for (int j = 0; j < 2; ++j) DMA16(src + (size_t)(8 * wid + row) * pitch + 32 * (2 * j + sub) + 8 * ch, img + (wid * 4 + 2 * j) * 512);
}
__device__ __forceinline__ int vtr_lane_off(int lane) { return ((lane >> 4) & 1) * 32 + (lane & 3) * 8 + ((lane & 15) >> 2) * 64; }

namespace att {
constexpr int BUFB = 32768, KIMG = 16384, XOFF = 65536;
__device__ __forceinline__ void unit(int b, int h, int qblk, const bf16* Q, const bf16* K, const bf16* V, bf16* MIX, float lam, const float* gsub, ldsp_t lds) {
    int tid = threadIdx.x; asm volatile("" : "+v"(tid));
    const int lane = tid & 63, wid = __builtin_amdgcn_readfirstlane(tid >> 6), r32 = lane & 31, hi = lane >> 5, mp = wid >> 2, qb = wid & 3;
    const int q0 = qblk * 128, NT = 2 * (qblk + 1);
    const size_t rowbase = (size_t)b * SEQ;
    const int qg = q0 + 32 * qb + r32;
    bf16x8 qr[4];
    { const bf16* qp = Q + (rowbase + qg) * AW + h * 128 + mp * 64 + hi * 8;
#pragma unroll
      for (int d0 = 0; d0 < 4; ++d0) qr[d0] = *(const bf16x8*)(qp + 16 * d0); }
    const bf16* ksrc = K + (rowbase + lane) * AW + h * 128 + mp * 64 + 2 * (wid & 3) * 8;
    const bf16* vsrc = V + rowbase * AW + h * 128;
    const int kdst = mp * 8192 + 2 * (wid & 3) * 1024;
#define ATT_DMA(t, buf) do { const bf16* ks_ = ksrc + (size_t)(t) * 64 * AW; DMA16(ks_, lds + (buf) * BUFB + kdst); DMA16(ks_ + 8, lds + (buf) * BUFB + kdst + 1024); \
        dma_vimg(vsrc + (size_t)(t) * 64 * AW, AW, lds + (buf) * BUFB + KIMG, wid, lane); } while (0)
    f32x16 o[4];
#pragma unroll
    for (int i = 0; i < 4; ++i) o[i] = (f32x16){};
    float mrun = -1e30f, lsum = 0.f;
    const int vlo = vtr_lane_off(lane) + 4 * hi * 64;
    ATT_DMA(0, 0);
    WAITV0_BAR();
    for (int t = 0; t < NT; ++t) {
        const int buf = t & 1;
        if (t + 1 < NT) ATT_DMA(t + 1, buf ^ 1);
        if (64 * t <= q0 + 32 * qb + 31) {
            const LAS unsigned char* kb = lds + buf * BUFB + mp * 8192 + hi * 1024 + r32 * 16;
            f32x16 p0 = (f32x16){}, p1 = (f32x16){};
#pragma unroll
            for (int d0 = 0; d0 < 4; ++d0) {
                const bf16x8 k0 = *(const LAS bf16x8*)(kb + d0 * 2048), k1 = *(const LAS bf16x8*)(kb + d0 * 2048 + 512);
                p0 = __builtin_amdgcn_mfma_f32_32x32x16_bf16(k0, qr[d0], p0, 0, 0, 0);
                p1 = __builtin_amdgcn_mfma_f32_32x32x16_bf16(k1, qr[d0], p1, 0, 0, 0);
            }
            if (64 * t + 63 > q0 + 32 * qb) {
#pragma unroll
                for (int r = 0; r < 16; ++r) { const int kv = 64 * t + crow(r, hi); if (kv > qg) p0[r] = -1e30f; if (kv + 32 > qg) p1[r] = -1e30f; }
            }
            float mt = fmaxf(p0[0], p1[0]);
#pragma unroll
            for (int r = 1; r < 16; ++r) mt = fmaxf(mt, fmaxf(p0[r], p1[r]));
            mt = swap_max(mt);
            const float mnew = fmaxf(mrun, mt);
            if (__any(mnew > mrun)) {
                const float al = ex2(mrun - mnew); lsum *= al;
#pragma unroll
                for (int i = 0; i < 4; ++i)
#pragma unroll
                    for (int r = 0; r < 16; ++r) o[i][r] *= al;
            }
            mrun = mnew;
            float ps = 0.f;
#pragma unroll
            for (int r = 0; r < 16; ++r) { p0[r] = ex2(p0[r] - mnew); p1[r] = ex2(p1[r] - mnew); ps += p0[r] + p1[r]; }
            lsum += ps;
            bf16x8 pw[4]; pw[0] = accfrag(p0, 0); pw[1] = accfrag(p0, 1); pw[2] = accfrag(p1, 0); pw[3] = accfrag(p1, 1);
            const LAS unsigned char* vb = lds + buf * BUFB + KIMG + vlo;
#pragma unroll
            for (int s = 0; s < 4; ++s)
#pragma unroll
                for (int db = 0; db < 4; ++db) {
                    const bf16x8 vf = cat8(vtr(vb + ((2 * s) * 4 + db) * 512), vtr(vb + ((2 * s + 1) * 4 + db) * 512));
                    o[db] = __builtin_amdgcn_mfma_f32_32x32x16_bf16(vf, pw[s], o[db], 0, 0, 0);
                }
        }
        WAITV0_BAR();
    }
#undef ATT_DMA
    const float inv = 1.0f / swap_sum(lsum);
    LAS float* X = (LAS float*)(lds + XOFF);
    if (mp == 1) { const float sc = lam * inv;
#pragma unroll
        for (int db = 0; db < 4; ++db)
#pragma unroll
            for (int r = 0; r < 16; ++r) X[(qb * 64 + db * 16 + r) * 64 + lane] = o[db][r] * sc; }
    LGKM_BAR();
    if (mp == 0) {
        float ss = 0.f;
#pragma unroll
        for (int db = 0; db < 4; ++db)
#pragma unroll
            for (int r = 0; r < 16; ++r) { const float a = o[db][r] * inv - X[(qb * 64 + db * 16 + r) * 64 + lane]; o[db][r] = a; ss += a * a; }
        ss = swap_sum(ss);
        const float rs = (1.0f - LAM_INIT) / sqrtf(ss * (1.0f / 128.0f) + EPS);
        bf16* orow = MIX + (rowbase + qg) * D + h * 128;
#pragma unroll
        for (int db = 0; db < 4; ++db)
#pragma unroll
            for (int g = 0; g < 4; ++g) { const int d = 32 * db + 8 * g + 4 * hi; const f32x4 gg = *(const f32x4*)(gsub + d);
                u32x2v w; w.x = cvtpk(o[db][4 * g] * rs * gg[0], o[db][4 * g + 1] * rs * gg[1]); w.y = cvtpk(o[db][4 * g + 2] * rs * gg[2], o[db][4 * g + 3] * rs * gg[3]);
                *(u32x2v*)(orow + d) = w; }
    }
}
}

namespace hg {
constexpr int QE_OFF = 0, QE_P = 136  , KE_OFF = 17408, KLT_OFF = 34816, KLT_P = 72, V_OFF = 53248, G_OFF = 86016, QT_OFF = 86528, LDS_END = 88576;
__device__ __forceinline__ void unit(int bh, const bf16* RQ, const bf16* RK, const bf16* RV, const float* LOGF, bf16* OREC, float* sout, ldsp_t lds) {
    int tid = threadIdx.x; asm volatile("" : "+v"(tid));
    const int lane = tid & 63, wid = __builtin_amdgcn_readfirstlane(tid >> 6), r32 = lane & 31, hi = lane >> 5, th = wid >> 2, eb = wid & 3;
    const int b = bh >> 2, h = bh & 3;
    const size_t rowbase = (size_t)b * SEQ; const int col0 = h * 128;
    const int d = tid & 127, tq = tid >> 7;
    LAS bf16* QE = (LAS bf16*)(lds + QE_OFF); LAS bf16* KE = (LAS bf16*)(lds + KE_OFF); LAS bf16* KLT = (LAS bf16*)(lds + KLT_OFF);
    LAS float* G = (LAS float*)(lds + G_OFF); LAS float* QT = (LAS float*)(lds + QT_OFF);
    float lf[16]; unsigned short rq[16], rk[16];
    f32x16 S[4];
#pragma unroll
    for (int i = 0; i < 4; ++i) S[i] = (f32x16){};
    const int vlo = vtr_lane_off(lane);
#define HG_LOAD(n) do { const size_t g0_ = (rowbase + 64 * (n) + 16 * tq) * RW + col0 + d; _Pragma("unroll") for (int i = 0; i < 16; ++i) { lf[i] = LOGF[g0_ + (size_t)i * RW]; rq[i] = RQ[g0_ + (size_t)i * RW]; rk[i] = RK[g0_ + (size_t)i * RW]; } \
        dma_vimg(RV + (rowbase + 64 * (n)) * RW + col0, RW, lds + V_OFF + ((n) & 1) * 16384, wid, lane); } while (0)
#define HG_PREP() do { float cs_[16]; float c_ = 0.f; _Pragma("unroll") for (int i = 0; i < 16; ++i) { c_ += lf[i]; cs_[i] = c_; } \
        QT[tq * 128 + d] = c_; LGKM_BAR(); \
        float off_ = 0.f, tot_ = 0.f; _Pragma("unroll") for (int q = 0; q < 4; ++q) { const float v_ = QT[q * 128 + d]; tot_ += v_; if (q < tq) off_ += v_; } \
        if (tq == 0) G[d] = fexpn(tot_); \
        unsigned klw_[8]; \
        _Pragma("unroll") for (int i = 0; i < 16; i += 2) { \
            const float b0_ = cs_[i] + off_, b1_ = cs_[i + 1] + off_; const float q0_ = bf2f(rq[i]), q1_ = bf2f(rq[i + 1]), k0_ = bf2f(rk[i]), k1_ = bf2f(rk[i + 1]); \
            const unsigned qe_ = cvtpk(q0_ * fexpn(b0_), q1_ * fexpn(b1_)), ke_ = cvtpk(k0_ * fexpn(-b0_), k1_ * fexpn(-b1_)); \
            klw_[i >> 1] = cvtpk(k0_ * fexpn(tot_ - b0_), k1_ * fexpn(tot_ - b1_)); \
            QE[(16 * tq + i) * QE_P + d] = (bf16)(qe_ & 0xffffu); QE[(16 * tq + i + 1) * QE_P + d] = (bf16)(qe_ >> 16); \
            KE[(16 * tq + i) * QE_P + d] = (bf16)(ke_ & 0xffffu); KE[(16 * tq + i + 1) * QE_P + d] = (bf16)(ke_ >> 16); } \
        *(LAS v4u*)(KLT + d * KLT_P + 16 * tq) = (v4u){klw_[0], klw_[1], klw_[2], klw_[3]}; *(LAS v4u*)(KLT + d * KLT_P + 16 * tq + 8) = (v4u){klw_[4], klw_[5], klw_[6], klw_[7]}; } while (0)
    HG_LOAD(0);
    HG_PREP();
    WAITV0_BAR();
    for (int n = 0; n < 32; ++n) {
        if (n + 1 < 32) HG_LOAD(n + 1);
        const LAS unsigned char* vimg = lds + V_OFF + (n & 1) * 16384;
        f32x16 o = (f32x16){};
        bf16x8 xw[2][2];
#pragma unroll
        for (int sb = 0; sb < 2; ++sb) if (sb <= th) {
            f32x16 x = (f32x16){};
#pragma unroll
            for (int sg = 0; sg < 8; ++sg) {
                const bf16x8 ka = *(const LAS bf16x8*)(KE + (32 * sb + r32) * QE_P + 16 * sg + 8 * hi), qbv = *(const LAS bf16x8*)(QE + (32 * th + r32) * QE_P + 16 * sg + 8 * hi);
                x = __builtin_amdgcn_mfma_f32_32x32x16_bf16(ka, qbv, x, 0, 0, 0);
            }
            if (sb == th) {
#pragma unroll
                for (int r = 0; r < 16; ++r) if (crow(r, hi) > r32) x[r] = 0.f;
            }
            xw[sb][0] = accfrag(x, 0); xw[sb][1] = accfrag(x, 1);
        }
#pragma unroll
        for (int db = 0; db < 4; ++db)
#pragma unroll
            for (int sg = 0; sg < 2; ++sg) {
                const LAS bf16* qp = QE + (32 * th + r32) * QE_P + 32 * db + 16 * sg + 4 * hi;
                const u32x2v a0 = *(const LAS u32x2v*)qp, a1 = *(const LAS u32x2v*)(qp + 8);
                const v4u aw = (v4u){a0.x, a0.y, a1.x, a1.y};
                o = __builtin_amdgcn_mfma_f32_32x32x16_bf16(__builtin_bit_cast(bf16x8, aw), accfrag(S[db], sg), o, 0, 0, 0);
            }
#pragma unroll
        for (int sb = 0; sb < 2; ++sb) if (sb <= th) {
#pragma unroll
            for (int sg = 0; sg < 2; ++sg) {
                const LAS unsigned char* vb = vimg + vlo + 4 * hi * 64 + ((4 * sb + 2 * sg) * 4 + eb) * 512;
                const bf16x8 vf = cat8(vtr(vb), vtr(vb + 4 * 512));
                o = __builtin_amdgcn_mfma_f32_32x32x16_bf16(xw[sb][sg], vf, o, 0, 0, 0);
            }
        }
        { bf16* op = OREC + (rowbase + 64 * n + 32 * th) * RW + col0 + 32 * eb + r32;
#pragma unroll
          for (int r = 0; r < 16; r += 2) { const unsigned w = cvtpk(o[r], o[r + 1]); op[(size_t)crow(r, hi) * RW] = (bf16)(w & 0xffffu); op[(size_t)crow(r + 1, hi) * RW] = (bf16)(w >> 16); } }
#pragma unroll
        for (int db = 0; db < 4; ++db) {
#pragma unroll
            for (int g = 0; g < 4; ++g) { const f32x4 gg = *(const LAS f32x4*)(G + 32 * db + 8 * g + 4 * hi);
                S[db][4 * g] *= gg[0]; S[db][4 * g + 1] *= gg[1]; S[db][4 * g + 2] *= gg[2]; S[db][4 * g + 3] *= gg[3]; }
        }
#pragma unroll
        for (int sg = 0; sg < 4; ++sg) {
            const LAS unsigned char* vb = vimg + vlo + ((2 * sg + hi) * 4 + eb) * 512;
            const bf16x8 vf = cat8(vtr(vb), vtr(vb + 4 * 64));
#pragma unroll
            for (int db = 0; db < 4; ++db) {
                const bf16x8 ka = *(const LAS bf16x8*)(KLT + (32 * db + r32) * KLT_P + 16 * sg + 8 * hi);
                S[db] = __builtin_amdgcn_mfma_f32_32x32x16_bf16(ka, vf, S[db], 0, 0, 0);
            }
        }
        LGKM_BAR();
        if (n + 1 < 32) HG_PREP();
        WAITV0_BAR();
    }
#undef HG_LOAD
#undef HG_PREP
    if (th == 0) { float* sp = sout + (size_t)bh * 16384 + 32 * eb + r32;
#pragma unroll
        for (int db = 0; db < 4; ++db)
#pragma unroll
            for (int r = 0; r < 16; ++r) sp[(size_t)(32 * db + crow(r, hi)) * 128] = S[db][r]; }
}
}

namespace dec {
constexpr int PART = 264;
__device__ __forceinline__ void unit(int bs, int h, const bf16* Q, const bf16* K, const bf16* V, const float* ck, const float* cv, const int* ptab, bf16* MIX, float lam, const float* gsub, ldsp_t lds) {
    int tid = threadIdx.x; asm volatile("" : "+v"(tid));
    const int lane = tid & 63, wid = __builtin_amdgcn_readfirstlane(tid >> 6);
    const size_t row = (size_t)MP + bs;
    LAS float* P = (LAS float*)lds;
    const int c4 = 4 * (lane & 31), half = lane >> 5, mymap = (lane >> 4) & 1;
    f32x4 q4; { const u32x2v qw = *(const u32x2v*)(Q + row * AW + h * 128 + c4); q4 = (f32x4){bflo(qw.x), bfhi(qw.x), bflo(qw.y), bfhi(qw.y)}; }
    float mrun = -1e30f, lrun = 0.f; f32x4 o0 = (f32x4){0.f, 0.f, 0.f, 0.f}, o1 = o0;
    for (int pg = 0; pg < 2; ++pg) {
        const int pid = ptab[bs * NPAGES + 2 * wid + pg];
        const float* kp = ck + ((size_t)pid * PAGE + half) * 512 + h * 128 + c4;
        const float* vp = cv + ((size_t)pid * PAGE + half) * 512 + h * 128 + c4;
        for (int t = 0; t < 8; ++t) {
            f32x4 kk[8], vv[8];
#pragma unroll
            for (int i = 0; i < 8; ++i) kk[i] = __builtin_nontemporal_load((const f32x4*)(kp + (size_t)(16 * t + 2 * i) * 512));
#pragma unroll
            for (int i = 0; i < 8; ++i) vv[i] = __builtin_nontemporal_load((const f32x4*)(vp + (size_t)(16 * t + 2 * i) * 512));
            float pr[8];
#pragma unroll
            for (int i = 0; i < 8; ++i) pr[i] = (kk[i][0] * q4[0] + kk[i][1] * q4[1]) + (kk[i][2] * q4[2] + kk[i][3] * q4[3]);
            float a4[4], a2[2], s;
            { const bool up = (lane & 8) != 0;
#pragma unroll
              for (int i = 0; i < 4; ++i) { const float keep = up ? pr[i + 4] : pr[i], send = up ? pr[i] : pr[i + 4]; a4[i] = keep + __shfl_xor(send, 8); } }
            { const bool up = (lane & 4) != 0;
#pragma unroll
              for (int i = 0; i < 2; ++i) { const float keep = up ? a4[i + 2] : a4[i], send = up ? a4[i] : a4[i + 2]; a2[i] = keep + __shfl_xor(send, 4); } }
            { const bool up = (lane & 2) != 0; const float keep = up ? a2[1] : a2[0], send = up ? a2[0] : a2[1]; s = keep + __shfl_xor(send, 2); }
            s += __shfl_xor(s, 1);
            float mt = s; mt = fmaxf(mt, __shfl_xor(mt, 2)); mt = fmaxf(mt, __shfl_xor(mt, 4)); mt = fmaxf(mt, __shfl_xor(mt, 8)); mt = fmaxf(mt, __shfl_xor(mt, 32));
            const float mnew = fmaxf(mrun, mt), al = ex2(mrun - mnew), p = ex2(s - mnew);
            float psum = p; psum += __shfl_xor(psum, 2); psum += __shfl_xor(psum, 4); psum += __shfl_xor(psum, 8); psum += __shfl_xor(psum, 32);
            lrun = lrun * al + psum; mrun = mnew;
            const float al0 = __shfl(al, 0), al1 = __shfl(al, 16);
            o0 = o0 * al0; o1 = o1 * al1;
#pragma unroll
            for (int i = 0; i < 8; ++i) { const float p0 = __shfl(p, (lane & 32) + 2 * i), p1 = __shfl(p, (lane & 32) + 16 + 2 * i); o0 = o0 + vv[i] * p0; o1 = o1 + vv[i] * p1; }
        }
    }
#pragma unroll
    for (int j = 0; j < 4; ++j) { o0[j] += __shfl_xor(o0[j], 32); o1[j] += __shfl_xor(o1[j], 32); }
    { const float m0 = __shfl(mrun, 0), l0 = __shfl(lrun, 0), m1 = __shfl(mrun, 16), l1 = __shfl(lrun, 16);
      LAS float* pw = P + wid * PART;
      if (lane < 32) { *(LAS f32x4*)(pw + c4) = o0; *(LAS f32x4*)(pw + 128 + c4) = o1; }
      if (lane == 0) { pw[256] = m0; pw[257] = l0; pw[258] = m1; pw[259] = l1; } }
    if (wid == 0) {
        const u32x2v kw = *(const u32x2v*)(K + row * AW + h * 128 + c4);
        float s = (bflo(kw.x) * q4[0] + bfhi(kw.x) * q4[1]) + (bflo(kw.y) * q4[2] + bfhi(kw.y) * q4[3]);
        s += __shfl_xor(s, 1); s += __shfl_xor(s, 2); s += __shfl_xor(s, 4); s += __shfl_xor(s, 8);
        if (lane == 0) P[8 * PART] = s; if (lane == 16) P[8 * PART + 1] = s;
    }
    LGKM_BAR();
    if (wid == 0) {
        float M0 = P[8 * PART], M1 = P[8 * PART + 1]; const float sn0 = M0, sn1 = M1;
#pragma unroll
        for (int w = 0; w < 8; ++w) { M0 = fmaxf(M0, P[w * PART + 256]); M1 = fmaxf(M1, P[w * PART + 258]); }
        const float wn0 = ex2(sn0 - M0), wn1 = ex2(sn1 - M1);
        float L0 = wn0, L1 = wn1; float a[2], bq[2];
        { const bf16* vr = V + row * AW + h * 128; a[0] = wn0 * bf2f(vr[lane]); a[1] = wn0 * bf2f(vr[lane + 64]); bq[0] = wn1 * bf2f(vr[lane]); bq[1] = wn1 * bf2f(vr[lane + 64]); }
#pragma unroll
        for (int w = 0; w < 8; ++w) { const float f0 = ex2(P[w * PART + 256] - M0), f1 = ex2(P[w * PART + 258] - M1);
            L0 += f0 * P[w * PART + 257]; L1 += f1 * P[w * PART + 259];
            a[0] += f0 * P[w * PART + lane]; a[1] += f0 * P[w * PART + lane + 64]; bq[0] += f1 * P[w * PART + 128 + lane]; bq[1] += f1 * P[w * PART + 128 + lane + 64]; }
        const float i0 = 1.0f / L0, i1 = lam / L1;
        const float y0 = a[0] * i0 - bq[0] * i1, y1 = a[1] * i0 - bq[1] * i1;
        float ss = y0 * y0 + y1 * y1;
#pragma unroll
        for (int o = 1; o < 64; o <<= 1) ss += __shfl_xor(ss, o);
        const float rs = (1.0f - LAM_INIT) / sqrtf(ss * (1.0f / 128.0f) + EPS);
        bf16* orow = MIX + row * D + h * 128;
        orow[lane] = (bf16)f2bf(y0 * rs * gsub[lane]); orow[lane + 64] = (bf16)f2bf(y1 * rs * gsub[lane + 64]);
    }
    LGKM_BAR();
}
}

__device__ __forceinline__ void hgrn_step(int bs, int h, const bf16* RQ, const bf16* RK, const bf16* RV, const float* LOGF, const float* S0, float* Sout, bf16* OREC, ldsp_t lds) {
    int tid = threadIdx.x; asm volatile("" : "+v"(tid)); const size_t row = (size_t)MP + bs; const size_t g0 = row * RW + h * 128;
    LAS float* qs = (LAS float*)lds; LAS float* ks = qs + 128; LAS float* fs = qs + 256; LAS float* po = qs + 384;
    if (tid < 128) { qs[tid] = bf2f(RQ[g0 + tid]); ks[tid] = bf2f(RK[g0 + tid]); fs[tid] = fexpn(LOGF[g0 + tid]); }
    const int e = tid & 127, dq = tid >> 7;
    const float v = bf2f(RV[g0 + e]);
    LGKM_BAR();
    const size_t sb = ((size_t)(bs * 4 + h) * 128 + 32 * dq) * 128 + e;
    float acc = 0.f;
#pragma unroll 8
    for (int i = 0; i < 32; ++i) { const int dd = 32 * dq + i; const float sn = fs[dd] * S0[sb + (size_t)i * 128] + ks[dd] * v; Sout[sb + (size_t)i * 128] = sn; acc += qs[dd] * sn; }
    po[dq * 128 + e] = acc;
    LGKM_BAR();
    if (tid < 128) OREC[g0 + tid] = (bf16)f2bf((po[tid] + po[128 + tid]) + (po[256 + tid] + po[384 + tid]));
    LGKM_BAR();
}


template <int MODE, int N, int K, int KC>
__device__ __forceinline__ void samp_item(int item, const bf16* Abf, const float* xs, const float* C4, const float* C5, const float* C6, float* SS1, const bf16* Bt, float* C) {
    int tid = threadIdx.x; asm volatile("" : "+v"(tid));
    const int lane = tid & 63, wid = __builtin_amdgcn_readfirstlane(tid >> 6), r32 = lane & 31, hi = lane >> 5, rb = wid >> 1, cbk = wid & 1;
    constexpr int NCH = N / 64;
    const int nc = item % NCH, kc = item / NCH, n0 = nc * 64 + 32 * cbk, k0 = kc * KC, row = 32 * rb + r32;
    f32x16 acc = (f32x16){};
    float ssp = 0.f, r2 = 0.f;
    if (MODE == 7) r2 = 1.0f / (SS1[row] * (1.0f / D) + EPS);
    const bf16* bp = Bt + (size_t)(n0 + r32) * K + k0 + 8 * hi;
#pragma unroll 4
    for (int s = 0; s < KC / 16; ++s) {
        const int k8 = k0 + 16 * s + 8 * hi;
        bf16x8 a;
        if (MODE == 4) a = *(const bf16x8*)(Abf + (size_t)row * D + k8);
        else {
            f32x4 v0, v1;
            if (MODE == 6) { const float* p = C5 + (size_t)row * FF + k8; v0 = *(const f32x4*)p; v1 = *(const f32x4*)(p + 4);
#pragma unroll
                for (int j = 0; j < 4; ++j) { const float a0 = fmaxf(v0[j], 0.f), a1 = fmaxf(v1[j], 0.f); v0[j] = a0 * a0; v1[j] = a1 * a1; } }
            else { const size_t o = (size_t)row * D + k8; v0 = *(const f32x4*)(xs + o) + *(const f32x4*)(C4 + o); v1 = *(const f32x4*)(xs + o + 4) + *(const f32x4*)(C4 + o + 4);
                if (MODE == 5) ssp += (v0[0] * v0[0] + v0[1] * v0[1]) + (v0[2] * v0[2] + v0[3] * v0[3]) + (v1[0] * v1[0] + v1[1] * v1[1]) + (v1[2] * v1[2] + v1[3] * v1[3]);
                if (MODE == 7) { v0 = v0 + *(const f32x4*)(C6 + o) * r2; v1 = v1 + *(const f32x4*)(C6 + o + 4) * r2; } }
            v4u w; w.x = cvtpk(v0[0], v0[1]); w.y = cvtpk(v0[2], v0[3]); w.z = cvtpk(v1[0], v1[1]); w.w = cvtpk(v1[2], v1[3]); a = __builtin_bit_cast(bf16x8, w);
        }
        const bf16x8 b = *(const bf16x8*)(bp + 16 * s);
        acc = __builtin_amdgcn_mfma_f32_32x32x16_bf16(a, b, acc, 0, 0, 0);
    }
    float* cp = C + (size_t)(32 * rb) * N + n0 + r32;
#pragma unroll
    for (int r = 0; r < 16; ++r) unsafeAtomicAdd(cp + (size_t)crow(r, hi) * N, acc[r]);
    if (MODE == 5 && nc == 0 && cbk == 0) { ssp = swap_sum(ssp); if (hi == 0) unsafeAtomicAdd(SS1 + row, ssp); }
}

constexpr size_t MiB = 1u << 20;
constexpr size_t WS_CTL = 0, CTL_ZERO_BYTES = 1 * MiB;
constexpr size_t WS_WIN = 2 * MiB, WS_WOUT = 9 * MiB, WS_WUP = 11 * MiB, WS_WDN = 19 * MiB, WS_WG = 27 * MiB, WS_WP = 29 * MiB;
constexpr size_t WS_XN = 32 * MiB, WS_PB = 66 * MiB, WS_Q = 76 * MiB, WS_K = 93 * MiB, WS_V = 110 * MiB, WS_RQ = 127 * MiB, WS_RK = 144 * MiB, WS_RV = 161 * MiB, WS_RG = 178 * MiB;
constexpr size_t WS_LOGF = 195 * MiB, WS_OREC = 228 * MiB, WS_MIX = 245 * MiB, WS_X1 = 278 * MiB, WS_A2 = 343 * MiB, WS_A3 = 376 * MiB, WS_PJ = 409 * MiB, WS_H = 442 * MiB;
constexpr size_t WS_SSP1 = 572 * MiB, WS_SSP3 = 574 * MiB;
constexpr size_t WS_X2 = 582 * MiB;
constexpr size_t WS_SC4 = 576 * MiB, WS_SC5 = 577 * MiB, WS_SC6 = 579 * MiB, WS_SC7 = 580 * MiB, WS_SS1S = 581 * MiB, WS_SC_END = WS_SS1S + 4096, WS_END = 648 * MiB;
static_assert(WS_K - WS_Q == 17 * MiB && WS_V - WS_K == 17 * MiB && WS_RQ - WS_V == 17 * MiB && WS_RK - WS_RQ == 17 * MiB && WS_RV - WS_RK == 17 * MiB && WS_RG - WS_RV == 17 * MiB, "EpiIn buffer stride");
static_assert(WS_XN + (size_t)MT * D * 2 <= WS_PB && WS_PB + (size_t)MT * PLE * 2 <= WS_Q && WS_Q + (size_t)MT * AW * 2 <= WS_K && WS_LOGF + (size_t)MT * RW * 4 <= WS_OREC &&
              WS_MIX + (size_t)MT * D * 2 <= WS_X1 && WS_X1 + (size_t)MT * D * 4 <= WS_A2 && WS_PJ + (size_t)MT * D * 2 <= WS_H && WS_H + (size_t)MT * FF * 2 <= WS_SSP1 && WS_SSP1 + (size_t)MT * 64 <= WS_SSP3, "d_ws map");
constexpr int CW_QA = 64, CW_QD = 128;
constexpr int CW_BAR = 4096;
static_assert((CW_BAR + XCD_BAR_WORDS) * 4 <= (int)CTL_ZERO_BYTES, "CTL words inside the memset region");

constexpr int RING_OFF = 0, RING_BYTES = 131072;
constexpr int LDSCTL_OFF = RING_BYTES, MISC_OFF = LDSCTL_OFF + 320;
constexpr int LDS_BYTES = 147456;
constexpr int NWAVES = 8;
constexpr int N_PHASES = 9;
#ifndef DEC_FIRST_FROM
#define DEC_FIRST_FROM 156
#endif

struct Frame {
    LAS unsigned char* lds; volatile LAS unsigned* MISC; gu32* ctl;
    int tid, lane, wave, vcu, G;
};

__device__ __forceinline__ float wave_sum(float v) {
#pragma unroll
    for (int o = 1; o < 64; o <<= 1) v += __shfl_xor(v, o);
    return v;
}
__device__ __forceinline__ void p0_transpose_item(const float* W, int K, int N, bf16* WT, const float* kscale, LAS float* scr, int item, int lane) {
    const int nblk = N / 32, kb = item / nblk, nb = item % nblk, k0 = 64 * kb, n0 = 32 * nb;
#pragma unroll 8
    for (int i = 0; i < 32; ++i) { const int kk = 2 * i + (lane >> 5); float w = W[(size_t)(k0 + kk) * N + n0 + (lane & 31)]; if (kscale) w *= kscale[k0 + kk]; scr[kk * 33 + (lane & 31)] = w; }
    LDS_WAIT(); asm volatile("" ::: "memory");
    const int c = lane & 7;
#pragma unroll
    for (int j = 0; j < 4; ++j) { const int n = (lane >> 3) + 8 * j; const LAS float* s = scr + (8 * c) * 33 + n;
        v4u o; o.x = pk2(s[0 * 33], s[1 * 33]); o.y = pk2(s[2 * 33], s[3 * 33]); o.z = pk2(s[4 * 33], s[5 * 33]); o.w = pk2(s[6 * 33], s[7 * 33]);
        *(GAS v4u*)(WT + (size_t)(n0 + n) * K + k0 + 8 * c) = o; }
    LDS_WAIT(); asm volatile("" ::: "memory");
}
__device__ __forceinline__ void rms_row_to_bf16(const float* xrow, const float* g, bf16* orow, int lane) {
    const f32x4* xr = (const f32x4*)xrow + lane; const f32x4* gr = (const f32x4*)g + lane;
    f32x4 v[4]; float s = 0.f;
#pragma unroll
    for (int j = 0; j < 4; ++j) { v[j] = xr[64 * j]; s += (v[j].x * v[j].x + v[j].y * v[j].y) + (v[j].z * v[j].z + v[j].w * v[j].w); }
    const float r = 1.0f / sqrtf(wave_sum(s) * (1.f / D) + EPS);
    unsigned long long* o8 = (unsigned long long*)orow + lane;
#pragma unroll
    for (int j = 0; j < 4; ++j) { const f32x4 gg = gr[64 * j]; o8[64 * j] = (unsigned long long)pk2(v[j].x * r * gg.x, v[j].y * r * gg.y) | ((unsigned long long)pk2(v[j].z * r * gg.z, v[j].w * r * gg.w) << 32); }
}


struct Args { const float* in[24]; float* out; unsigned char* ws; int ph_lo, ph_hi, li, pad; };

#define x_prompt (args.in[0])
#define x_sample (args.in[1])
#define cache_k (args.in[2])
#define cache_v (args.in[3])
#define state0 (args.in[4])
#define ptab ((const int*)args.in[5])
#define p_prompt (args.in[6])
#define p_sample (args.in[7])
#define w_in (args.in[8])
#define g_subln (args.in[13])
#define hgrn_lb (args.in[14])
#define g_rec (args.in[15])
#define w_out (args.in[16])
#define g_mix (args.in[17])
#define g_ffn (args.in[18])
#define w_up (args.in[19])
#define w_down (args.in[20])
#define w_gate (args.in[21])
#define w_proj (args.in[22])
#define g_final (args.in[23])
#define OUTP (args.out)
#define WSP(T, off) ((T*)(args.ws + (off)))
#define WinT WSP(bf16, WS_WIN)
#define WoutT WSP(bf16, WS_WOUT)
#define WupT WSP(bf16, WS_WUP)
#define WdnT WSP(bf16, WS_WDN)
#define WgT WSP(bf16, WS_WG)
#define WpT WSP(bf16, WS_WP)
#define XN WSP(bf16, WS_XN)
#define PB WSP(bf16, WS_PB)
#define Qb WSP(bf16, WS_Q)
#define Kb WSP(bf16, WS_K)
#define Vb WSP(bf16, WS_V)
#define RQ WSP(bf16, WS_RQ)
#define RK WSP(bf16, WS_RK)
#define RV WSP(bf16, WS_RV)
#define RG WSP(bf16, WS_RG)
#define LOGF WSP(float, WS_LOGF)
#define OREC WSP(bf16, WS_OREC)
#define MIX WSP(bf16, WS_MIX)
#define X1 WSP(float, WS_X1)
#define A2 WSP(bf16, WS_A2)
#define A3 WSP(bf16, WS_A3)
#define PJ WSP(bf16, WS_PJ)
#define HB WSP(bf16, WS_H)
#define SSP1 WSP(float, WS_SSP1)
#define SSP3 WSP(float, WS_SSP3)
#define SC4 WSP(float, WS_SC4)
#define X2 WSP(float, WS_X2)
#define SC5 WSP(float, WS_SC5)
#define SC6 WSP(float, WS_SC6)
#define SC7 WSP(float, WS_SC7)
#define SS1S WSP(float, WS_SS1S)

__global__ void __launch_bounds__(NWAVES * 64, 2) mk_fwd(Args args) {
    extern __shared__ __attribute__((aligned(16))) unsigned char lds_raw[];
    Frame F;
    F.lds = (LAS unsigned char*)lds_raw;
    F.MISC = (volatile LAS unsigned*)(F.lds + MISC_OFF);
    F.tid = threadIdx.x; F.lane = F.tid & 63; F.wave = __builtin_amdgcn_readfirstlane(F.tid >> 6);
    F.G = gridDim.x; { const int bx = blockIdx.x; F.vcu = (F.G % 8 == 0) ? (bx % 8) * (F.G / 8) + bx / 8 : bx; }
    F.ctl = (gu32*)(args.ws + WS_CTL);
    for (int u = F.tid; u < (LDS_BYTES - LDSCTL_OFF) / 4; u += NWAVES * 64) ((LAS unsigned*)(F.lds + LDSCTL_OFF))[u] = 0u;
    __syncthreads();
    if (F.wave == 0) {
        const float a = args.in[9][F.lane] * args.in[10][F.lane], b = args.in[11][F.lane] * args.in[12][F.lane];
        const float lam = fexpn(wave_sum(a)) - fexpn(wave_sum(b)) + LAM_INIT;
        if (F.lane == 0) F.MISC[4] = __float_as_uint(lam);
    }
    XcdBarrier bar; bar.bar = (unsigned*)(F.ctl + CW_BAR); bar.x = 0; bar.st = nullptr;
    if (MK_N_LAUNCHES == 1) bar = xcd_barrier_post((unsigned*)(F.ctl + CW_BAR), F.MISC + 8);
    __syncthreads();
#define GRID_BAR() do { if (MK_N_LAUNCHES == 1) xcd_barrier(bar); } while (0)
    const int lo = args.ph_lo, hi = args.ph_hi;
#ifndef PH_MASK
#define PH_MASK 0x1ff
#endif
#ifndef PROBE_REP
#define PROBE_REP -1
#endif
#ifndef PROBE_MASK
#define PROBE_MASK 0
#endif
#define REPN(k) (((PROBE_REP) == (k) || (((PROBE_MASK) >> ((k) >= 20 ? (k) - 8 : (k))) & 1)) ? 2 : 1)
#define IN(k) ((((PH_MASK) >> (k)) & 1) && lo <= (k) && (k) < hi)
#define BOTH(k) (IN(k) && IN((k) + 1))
    const int gw = F.vcu * NWAVES + F.wave, NGW = F.G * NWAVES;

    if (IN(0)) {
        int tl_ = threadIdx.x; asm volatile("" : "+v"(tl_)); const int lane = tl_ & 63;
        LAS float* scr = (LAS float*)(F.lds + RING_OFF + F.wave * 16384);
        constexpr int I_IN = (D / 64) * (NIN / 32), I_O = (D / 64) * (D / 32), I_UP = (D / 64) * (FF / 32), I_DN = (FF / 64) * (D / 32), I_G = I_O, I_P = (PLE / 64) * (D / 32);
        constexpr int NITEMS = I_IN + I_O + I_UP + I_DN + I_G + I_P;
        _Pragma("unroll") for (int rep_ = 0; rep_ < REPN(0); ++rep_) {
        for (int it = gw; it < NITEMS; it += NGW) {
            int r = it;
            if (r < I_IN) { p0_transpose_item(w_in, D, NIN, WinT, nullptr, scr, r, lane); continue; } r -= I_IN;
            if (r < I_O) { p0_transpose_item(w_out, D, D, WoutT, nullptr, scr, r, lane); continue; } r -= I_O;
            if (r < I_UP) { p0_transpose_item(w_up, D, FF, WupT, g_ffn, scr, r, lane); continue; } r -= I_UP;
            if (r < I_DN) { p0_transpose_item(w_down, FF, D, WdnT, nullptr, scr, r, lane); continue; } r -= I_DN;
            if (r < I_G) { p0_transpose_item(w_gate, D, D, WgT, nullptr, scr, r, lane); continue; } r -= I_G;
            p0_transpose_item(w_proj, PLE, D, WpT, nullptr, scr, r, lane);
        }
        for (int m = gw; m < MT; m += NGW) {
            if (m < MP + MS) {
                const float* xr = m < MP ? x_prompt + (size_t)m * D : x_sample + (size_t)(m - MP) * D;
                rms_row_to_bf16(xr, g_mix, XN + (size_t)m * D, lane);
                const float* pr = m < MP ? p_prompt + (size_t)m * PLE : p_sample + (size_t)(m - MP) * PLE;
                const f32x4 pv = ((const f32x4*)pr)[lane];
                ((unsigned long long*)(PB + (size_t)m * PLE))[lane] = (unsigned long long)pk2(pv.x, pv.y) | ((unsigned long long)pk2(pv.z, pv.w) << 32);
            } else {
                unsigned long long* o8 = (unsigned long long*)(XN + (size_t)m * D) + lane;
#pragma unroll
                for (int j = 0; j < 4; ++j) o8[64 * j] = 0ull;
                ((unsigned long long*)(PB + (size_t)m * PLE))[lane] = 0ull;
            }
        }
        }
        { v4u* z = (v4u*)(args.ws + WS_SC4); const size_t nz = (WS_SC_END - WS_SC4) / 16;
          for (size_t i = (size_t)blockIdx.x * (NWAVES * 64) + tl_; i < nz; i += (size_t)F.G * (NWAVES * 64)) z[i] = (v4u){0u, 0u, 0u, 0u}; }
        if (BOTH(0)) GRID_BAR();
    }

    if (IN(1)) {
        { pg8::Gemm g{XN, WinT, MT, NIN, D}; pg8::StaticOrder S; S.init(MT, NIN, F.G, (int)blockIdx.x);
          pg8::EpiIn E{Qb, LOGF, OUTP, hgrn_lb};
          _Pragma("unroll") for (int rep_ = 0; rep_ < REPN(10); ++rep_) pg8::gemm_phase<pg8::EpiIn, pg8::StaticOrder, true, true>(F.lds + RING_OFF, g, S, E); }
        { pg8::Gemm g{PB, WpT, MT, D, PLE}; pg8::StaticOrder S; S.init(MT, D, F.G, (int)(F.G - 1 - blockIdx.x));
          pg8::EpiBf E{PJ, D};
          _Pragma("unroll") for (int rep_ = 0; rep_ < REPN(11); ++rep_) pg8::gemm_phase<pg8::EpiBf, pg8::StaticOrder, true, true>(F.lds + RING_OFF, g, S, E); }
        if (BOTH(1)) GRID_BAR();
    }

    if (IN(2)) {
        const float lam = __uint_as_float(F.MISC[4]);
#ifndef SKIP_DEC
        if ((int)blockIdx.x >= DEC_FIRST_FROM) for (;;) {
            if (F.tid == 0) F.MISC[1] = __hip_atomic_fetch_add(F.ctl + CW_QD, 1u, RLX_AGENT);
            LGKM_BAR();
            const int idx = (int)F.MISC[1];
            if (idx >= 512) break;
            dec::unit(idx >> 2, idx & 3, Qb, Kb, Vb, cache_k, cache_v, ptab, MIX, lam, g_subln, F.lds + RING_OFF);
        }
#endif
#ifndef SKIP_HG
        _Pragma("unroll") for (int rep_ = 0; rep_ < REPN(20); ++rep_) if (blockIdx.x < 32) hg::unit((int)blockIdx.x, RQ, RK, RV, LOGF, OREC, OUTP + OUT_SP, F.lds + RING_OFF);
#endif
#ifndef SKIP_ATT
        _Pragma("unroll") for (int rep_ = 0; rep_ < REPN(21); ++rep_) for (;;) {
            if (F.tid == 0) F.MISC[0] = __hip_atomic_fetch_add(F.ctl + CW_QA + 256 * rep_, 1u, RLX_AGENT);
            LGKM_BAR();
            const int idx = (int)F.MISC[0];
            if (idx >= 512) break;
            const int qblk = 15 - (idx >> 5), bh = idx & 31;
            att::unit(bh >> 2, bh & 3, qblk, Qb, Kb, Vb, MIX, lam, g_subln, F.lds + RING_OFF);
        }
#endif
#ifndef SKIP_DEC
        _Pragma("unroll") for (int rep_ = 0; rep_ < REPN(22); ++rep_) for (;;) {
            if (F.tid == 0) F.MISC[1] = __hip_atomic_fetch_add(F.ctl + CW_QD + 256 * rep_, 1u, RLX_AGENT);
            LGKM_BAR();
            const int idx = (int)F.MISC[1];
            if (idx >= 512) break;
            dec::unit(idx >> 2, idx & 3, Qb, Kb, Vb, cache_k, cache_v, ptab, MIX, lam, g_subln, F.lds + RING_OFF);
        }
#endif
        _Pragma("unroll") for (int rep_ = 0; rep_ < REPN(23); ++rep_) for (int it = F.vcu; it < 512; it += F.G) hgrn_step(it >> 2, it & 3, RQ, RK, RV, LOGF, state0, OUTP + OUT_SS, OREC, F.lds + RING_OFF);
        if (BOTH(2)) GRID_BAR();
    }

    if (IN(3)) {
        int tl_ = threadIdx.x; asm volatile("" : "+v"(tl_)); const int lane = tl_ & 63;
        _Pragma("unroll") for (int rep_ = 0; rep_ < REPN(3); ++rep_) for (int m = gw; m < MP + MS; m += NGW) {
            const v4u ow = ((const v4u*)(OREC + (size_t)m * RW))[lane]; const v4u gw4 = ((const v4u*)(RG + (size_t)m * RW))[lane];
            float o[8] = {bflo(ow.x), bfhi(ow.x), bflo(ow.y), bfhi(ow.y), bflo(ow.z), bfhi(ow.z), bflo(ow.w), bfhi(ow.w)};
            const float gt[8] = {bflo(gw4.x), bfhi(gw4.x), bflo(gw4.y), bfhi(gw4.y), bflo(gw4.z), bfhi(gw4.z), bflo(gw4.w), bfhi(gw4.w)};
            float s = 0.f;
#pragma unroll
            for (int j = 0; j < 8; ++j) s += o[j] * o[j];
            const float r = 1.0f / sqrtf(wave_sum(s) * (1.f / RW) + EPS);
            const f32x4 g0 = ((const f32x4*)g_rec)[2 * lane], g1 = ((const f32x4*)g_rec)[2 * lane + 1];
            v4u w; w.x = pk2(o[0] * r * g0.x * gt[0], o[1] * r * g0.y * gt[1]); w.y = pk2(o[2] * r * g0.z * gt[2], o[3] * r * g0.w * gt[3]);
            w.z = pk2(o[4] * r * g1.x * gt[4], o[5] * r * g1.y * gt[5]); w.w = pk2(o[6] * r * g1.z * gt[6], o[7] * r * g1.w * gt[7]);
            ((v4u*)(MIX + (size_t)m * D + AW))[lane] = w;
        }
        if (BOTH(3)) GRID_BAR();
    }

    if (IN(4)) {
        pg8::Gemm g{MIX, WoutT, MP, D, D}; pg8::StaticOrder S; S.init(MP, D, F.G, (int)blockIdx.x);
        pg8::EpiOut E{x_prompt, x_sample, X1, A2, SSP1};
        _Pragma("unroll") for (int rep_ = 0; rep_ < REPN(4); ++rep_) pg8::gemm_phase<pg8::EpiOut, pg8::StaticOrder, true, true>(F.lds + RING_OFF, g, S, E);
        for (int it = blockIdx.x; it < 256; it += F.G) samp_item<4, D, D, 64>(it, MIX + (size_t)MP * D, nullptr, nullptr, nullptr, nullptr, nullptr, WoutT, SC4);
        if (BOTH(4)) GRID_BAR();
    }
    if (IN(5)) {
        pg8::Gemm g{A2, WupT, MP, FF, D}; pg8::StaticOrder S; S.init(MP, FF, F.G, (int)blockIdx.x);
        pg8::EpiUp E{HB, FF};
        _Pragma("unroll") for (int rep_ = 0; rep_ < REPN(5); ++rep_) pg8::gemm_phase<pg8::EpiUp, pg8::StaticOrder, true, true>(F.lds + RING_OFF, g, S, E);
        for (int it = blockIdx.x; it < 256; it += F.G) samp_item<5, FF, D, 256>(it, nullptr, x_sample, SC4, nullptr, nullptr, SS1S, WupT, SC5);
        if (BOTH(5)) GRID_BAR();
    }
    if (IN(6)) {
        pg8::Gemm g{HB, WdnT, MP, D, FF}; pg8::StaticOrder S; S.init(MP, D, F.G, (int)blockIdx.x);
        pg8::EpiDown E{X1, X2, A3, SSP1};
        _Pragma("unroll") for (int rep_ = 0; rep_ < REPN(6); ++rep_) pg8::gemm_phase<pg8::EpiDown, pg8::StaticOrder, true, true>(F.lds + RING_OFF, g, S, E);
        for (int it = blockIdx.x; it < 256; it += F.G) samp_item<6, D, FF, 256>(it, nullptr, nullptr, nullptr, SC5, nullptr, nullptr, WdnT, SC6);
        if (BOTH(6)) GRID_BAR();
    }
    if (IN(7)) {
        pg8::Gemm g{A3, WgT, MP, D, D}; pg8::StaticOrder S; S.init(MP, D, F.G, (int)blockIdx.x);
        pg8::EpiGate E{X2, PJ, X1, SSP3};
        _Pragma("unroll") for (int rep_ = 0; rep_ < REPN(7); ++rep_) pg8::gemm_phase<pg8::EpiGate, pg8::StaticOrder, true, true>(F.lds + RING_OFF, g, S, E);
        for (int it = blockIdx.x; it < 256; it += F.G) samp_item<7, D, D, 64>(it, nullptr, x_sample, SC4, nullptr, SC6, SS1S, WgT, SC7);
        if (BOTH(7)) GRID_BAR();
    }
    if (IN(8)) {
        int tl_ = threadIdx.x; asm volatile("" : "+v"(tl_)); const int lane = tl_ & 63;
        _Pragma("unroll") for (int rep_ = 0; rep_ < REPN(8); ++rep_) for (int m = gw; m < MP; m += NGW) {
            float* yr = OUTP + OUT_YP + (size_t)m * D; const f32x4* x4 = (const f32x4*)(X1 + (size_t)m * D) + lane;
            const f32x4* sp = (const f32x4*)(SSP3 + (size_t)m * 16);
            const f32x4 ps = (sp[0] + sp[1]) + (sp[2] + sp[3]);
            const float r = 1.0f / sqrtf(((ps.x + ps.y) + (ps.z + ps.w)) * (1.f / D) + EPS);
            f32x4* y4 = (f32x4*)yr + lane; const f32x4* g4 = (const f32x4*)g_final + lane;
#pragma unroll
            for (int j = 0; j < 4; ++j) { const f32x4 v = x4[64 * j], gg = g4[64 * j]; y4[64 * j] = v * r * gg; }
        }
        for (int sr = NGW - 1 - gw; sr < MS; sr += NGW) {
            const float r2 = 1.0f / (SS1S[sr] * (1.0f / D) + EPS);
            const f32x4* xs4 = (const f32x4*)(x_sample + (size_t)sr * D) + lane; const f32x4* c4 = (const f32x4*)(SC4 + (size_t)sr * D) + lane;
            const f32x4* c6 = (const f32x4*)(SC6 + (size_t)sr * D) + lane; const f32x4* c7 = (const f32x4*)(SC7 + (size_t)sr * D) + lane;
            const u32x2v* pj = (const u32x2v*)(PJ + (size_t)(MP + sr) * D) + lane;
            f32x4 v[4]; float s = 0.f;
#pragma unroll
            for (int j = 0; j < 4; ++j) { const f32x4 x2 = xs4[64 * j] + c4[64 * j] + c6[64 * j] * r2, gt = c7[64 * j]; const u32x2v pw = pj[64 * j];
                v[j].x = x2.x + pg8::sigmoidf_(gt.x) * bflo(pw.x); v[j].y = x2.y + pg8::sigmoidf_(gt.y) * bfhi(pw.x); v[j].z = x2.z + pg8::sigmoidf_(gt.z) * bflo(pw.y); v[j].w = x2.w + pg8::sigmoidf_(gt.w) * bfhi(pw.y);
                s += (v[j].x * v[j].x + v[j].y * v[j].y) + (v[j].z * v[j].z + v[j].w * v[j].w); }
            const float r = 1.0f / sqrtf(wave_sum(s) * (1.f / D) + EPS);
            f32x4* y4 = (f32x4*)(OUTP + OUT_YS + (size_t)sr * D) + lane; const f32x4* g4 = (const f32x4*)g_final + lane;
#pragma unroll
            for (int j = 0; j < 4; ++j) y4[64 * j] = v[j] * r * g4[64 * j];
        }
    }
#undef IN
#undef BOTH
#undef GRID_BAR
}

#undef x_prompt
#undef x_sample
#undef cache_k
#undef cache_v
#undef state0
#undef ptab
#undef p_prompt
#undef p_sample
#undef w_in
#undef g_subln
#undef hgrn_lb
#undef g_rec
#undef w_out
#undef g_mix
#undef g_ffn
#undef w_up
#undef w_down
#undef w_gate
#undef w_proj
#undef g_final
#undef OUTP
#undef WSP
#undef WinT
#undef WoutT
#undef WupT
#undef WdnT
#undef WgT
#undef WpT
#undef XN
#undef PB
#undef Qb
#undef Kb
#undef Vb
#undef RQ
#undef RK
#undef RV
#undef RG
#undef LOGF
#undef OREC
#undef MIX
#undef X1
#undef A2
#undef A3
#undef PJ
#undef HB
#undef SSP1
#undef SSP3
#undef SC4
#undef X2
#undef SC5
#undef SC6
#undef SC7
#undef SS1S
extern "C" void kernel_launch(void* const* d_in, const int* in_sizes, int n_in, void* d_out, int out_size, void* d_ws, size_t ws_size, hipStream_t stream) {
    static int grid = 0;
    if (grid == 0) {
        if (n_in != 24 || in_sizes[0] != MP * D || (size_t)out_size != OUT_END || ws_size < WS_END) {
            fprintf(stderr, "kernel_launch: unexpected shapes: n_in %d, in0 %d, out %d, ws %zu; nothing launched\n", n_in, n_in > 0 ? in_sizes[0] : -1, out_size, ws_size); grid = -1; return; }
        int dev = 0, cus = 0, per_cu = 0;
        if (hipGetDevice(&dev) != hipSuccess || hipDeviceGetAttribute(&cus, hipDeviceAttributeMultiprocessorCount, dev) != hipSuccess) { grid = -1; return; }
        if (hipFuncSetAttribute((const void*)mk_fwd, hipFuncAttributeMaxDynamicSharedMemorySize, LDS_BYTES) != hipSuccess) { fprintf(stderr, "kernel_launch: hipFuncSetAttribute failed\n"); grid = -1; return; }
        if (hipOccupancyMaxActiveBlocksPerMultiprocessor(&per_cu, (const void*)mk_fwd, NWAVES * 64, LDS_BYTES) != hipSuccess || per_cu < 1) {
            fprintf(stderr, "kernel_launch: occupancy query reports %d workgroups per CU; nothing launched\n", per_cu); (void)hipGetLastError(); grid = -1; return; }
        (void)hipGetLastError();
        grid = cus;
    }
    if (grid < 0) return;
    if (hipMemsetAsync((char*)d_ws + WS_CTL, 0, CTL_ZERO_BYTES, stream) != hipSuccess) return;
    Args a{};
    for (int i = 0; i < 24; ++i) a.in[i] = (const float*)d_in[i];
    a.out = (float*)d_out; a.ws = (unsigned char*)d_ws;
    if (MK_N_LAUNCHES == 1) {
        a.ph_lo = 0; a.ph_hi = N_PHASES; a.li = 0;
        hipLaunchKernelGGL(mk_fwd, dim3(grid), dim3(NWAVES * 64), LDS_BYTES, stream, a);
    } else {
        for (int li = 0; li < N_PHASES; ++li) { a.ph_lo = li; a.ph_hi = li + 1; a.li = li; hipLaunchKernelGGL(mk_fwd, dim3(grid), dim3(NWAVES * 64), LDS_BYTES, stream, a); }
    }
}
```

```cpp
#include <hip/hip_runtime.h>
#include <hip/hip_bf16.h>
#include <cstdio>
#include <cstdint>
#include <cmath>

#ifndef MK_N_LAUNCHES
#define MK_N_LAUNCHES 1
#endif

constexpr int D = 1024, NB = 8, SEQ = 2048, MP = NB * SEQ, MS = 128, MT = 16640  ;
constexpr int NIN = 3584, FF = 4096, PLE = 256, AW = 512, RW = 512, NPAGES = 16, PAGE = 128;
constexpr float EPS = 1e-6f;
constexpr float LOG2E = 1.4426950408889634f;
constexpr float QSCALE = 0.125f * LOG2E;
constexpr float LAM_INIT = 0.2f;
constexpr size_t OUT_YP = 0, OUT_YS = OUT_YP + (size_t)MP * D, OUT_KP = OUT_YS + (size_t)MS * D, OUT_VP = OUT_KP + (size_t)MP * AW, OUT_SP = OUT_VP + (size_t)MP * AW,
                 OUT_KS = OUT_SP + (size_t)NB * 4 * 128 * 128, OUT_VS = OUT_KS + (size_t)MS * AW, OUT_SS = OUT_VS + (size_t)MS * AW, OUT_END = OUT_SS + (size_t)MS * 4 * 128 * 128;

namespace pg8 {
#define PG8_LAS __attribute__((address_space(3)))
typedef unsigned short bf16_t;
typedef short bf16x8 __attribute__((ext_vector_type(8)));
typedef float f32x4 __attribute__((ext_vector_type(4)));
typedef unsigned u32x4 __attribute__((ext_vector_type(4)));
typedef unsigned u32x2 __attribute__((ext_vector_type(2)));
constexpr int BM = 256, BK = 64, HALF = 128, HTB = HALF * BK * 2  , STAGE_BYTES = 8 * HTB, NXCD = 8, WGM = 8;

__host__ __device__ __forceinline__ int lds_byte(int r, int c) { const int st = (r >> 4) * 2 + (c >> 5), rr = r & 15, cc = c & 31, ob = rr * 64 + cc * 2; return st * 1024 + (ob ^ (((ob >> 9) & 1) << 5)); }
__host__ __device__ __forceinline__ void stage_rc(int b, int& R, int& C) { const int st = b / 1024, sb = b % 1024, swz = sb ^ (((sb >> 9) & 1) << 5); R = (st >> 1) * 16 + swz / 64; C = (st & 1) * 32 + (swz % 64) / 2; }
__host__ __device__ __forceinline__ int perm32(int rho) { const int n = rho >> 4, i = rho & 15; return 8 * (i >> 2) + 4 * n + (i & 3); }

struct Unit { int pm, pn; };
struct Gemm { const bf16_t* A; const bf16_t* Bt; int M, N, K; };

struct StaticOrder {
    int nM, nN, nwg, G, c;
    __host__ __device__ void init(int M, int N, int G_, int c_) { nM = M / BM; nN = N / BM; nwg = nM * nN; G = G_; c = c_; }
    __host__ __device__ bool next(int i, Unit& u) const {
        const long L = (long)i * G + c; if (L >= nwg) return false;
        int wgid = (int)L; { const int q = nwg / NXCD, r = nwg % NXCD, xcd = wgid % NXCD, off = wgid / NXCD; wgid = (xcd < r ? xcd * (q + 1) : r * (q + 1) + (xcd - r) * q) + off; }
        const int nig = WGM * nN, gid = wgid / nig, fm = gid * WGM, gsz = (nM - fm) < WGM ? (nM - fm) : WGM;
        u.pm = fm + ((wgid % nig) % gsz); u.pn = (wgid % nig) / gsz; return true;
    }
    __device__ __forceinline__ void a_ready(const Unit&) const {}
    __device__ __forceinline__ void done(const Unit&) const {}
};

__device__ __forceinline__ unsigned cvt_pk_bf16(float lo, float hi) { unsigned r; asm volatile("v_cvt_pk_bf16_f32 %0, %1, %2" : "=v"(r) : "v"(lo), "v"(hi)); return r; }
__device__ __forceinline__ u32x4 pack8(const f32x4 v0, const f32x4 v1) { u32x4 w; w.x = cvt_pk_bf16(v0[0], v0[1]); w.y = cvt_pk_bf16(v0[2], v0[3]); w.z = cvt_pk_bf16(v1[0], v1[1]); w.w = cvt_pk_bf16(v1[2], v1[3]); return w; }
__device__ __forceinline__ float fexp(float x) { return __builtin_amdgcn_exp2f(x * 1.4426950408889634f); }
__device__ __forceinline__ float frcp(float x) { return __builtin_amdgcn_rcpf(x); }
__device__ __forceinline__ float sigmoidf_(float x) { return frcp(1.0f + fexp(-x)); }
__device__ __forceinline__ float siluf_(float x) { return x * sigmoidf_(x); }
__device__ __forceinline__ f32x4 map4_silu(f32x4 v) { return (f32x4){siluf_(v[0]), siluf_(v[1]), siluf_(v[2]), siluf_(v[3])}; }

struct EpiIn {
    static constexpr bool PERM = true, AFTER_DRAIN = false;
    bf16_t* Q0; float* LOGF; float* out; const float* hlb;
    static constexpr size_t BUFSTRIDE = (size_t)17 * 1024 * 1024 / 2;
    __device__ __forceinline__ void operator()(const f32x4 (&acc)[2][2][4][2], const Unit& u, int wr, int wc, int fr, int fq) const {
        const int type = u.pn >> 1;
        const int cb = (u.pn & 1) * 256 + wc * 32 + 8 * fq;
        const int row0 = u.pm * BM + wr * 64 + fr;
        const bool prow = u.pm < 64;
        if (type == 0 || type == 3 || type == 5 || type == 6) {
            bf16_t* base = Q0 + (size_t)type * BUFSTRIDE;
#pragma unroll
            for (int ai = 0; ai < 2; ++ai)
#pragma unroll
                for (int m = 0; m < 4; ++m) { bf16_t* rowp = base + (size_t)(row0 + ai * HALF + m * 16) * 512 + cb;
#pragma unroll
                    for (int bj = 0; bj < 2; ++bj) { f32x4 v0 = acc[ai][bj][m][0], v1 = acc[ai][bj][m][1];
                        if (type == 0) { v0 = v0 * QSCALE; v1 = v1 * QSCALE; }
                        else if (type != 5) { v0 = map4_silu(v0); v1 = map4_silu(v1); }
                        *(u32x4*)(rowp + bj * HALF) = pack8(v0, v1); } }
        } else if (type == 1 || type == 2) {
            bf16_t* base = Q0 + (size_t)type * BUFSTRIDE;
            float* ob = out + (type == 1 ? (prow ? OUT_KP : OUT_KS) : (prow ? OUT_VP : OUT_VS));
#pragma unroll
            for (int ai = 0; ai < 2; ++ai)
#pragma unroll
                for (int m = 0; m < 4; ++m) { const int row = row0 + ai * HALF + m * 16; bf16_t* rowp = base + (size_t)row * 512 + cb;
                    const bool ok = prow || ai == 0; float* orow = ob + (size_t)(prow ? row : row - MP) * 512 + cb;
#pragma unroll
                    for (int bj = 0; bj < 2; ++bj) { const f32x4 v0 = acc[ai][bj][m][0], v1 = acc[ai][bj][m][1];
                        *(u32x4*)(rowp + bj * HALF) = pack8(v0, v1);
                        if (ok) { *(f32x4*)(orow + bj * HALF) = v0; *(f32x4*)(orow + bj * HALF + 4) = v1; } } }
        } else {
#pragma unroll
            for (int bj = 0; bj < 2; ++bj) {
                f32x4 lb[2];
#pragma unroll
                for (int n = 0; n < 2; ++n) { const f32x4 l0 = *(const f32x4*)(hlb + cb + bj * HALF + 4 * n), l1 = *(const f32x4*)(hlb + 512 + cb + bj * HALF + 4 * n);
#pragma unroll
                    for (int j = 0; j < 4; ++j) lb[n][j] = frcp(1.0f + fexp(l1[j] - l0[j])); }
#pragma unroll
                for (int ai = 0; ai < 2; ++ai)
#pragma unroll
                    for (int m = 0; m < 4; ++m) { const size_t ro = (size_t)(row0 + ai * HALF + m * 16) * 512 + cb + bj * HALF; f32x4 lf[2], kk[2];
#pragma unroll
                        for (int n = 0; n < 2; ++n)
#pragma unroll
                            for (int j = 0; j < 4; ++j) { const float x = acc[ai][bj][m][n][j], e = fexp(-x), sg = frcp(1.0f + e), l = lb[n][j];
                                const float f = l + (1.0f - l) * sg; lf[n][j] = __builtin_amdgcn_logf(f) * 0.6931471805599453f; kk[n][j] = (1.0f - l) * (e * sg); }
                        *(f32x4*)(LOGF + ro) = lf[0]; *(f32x4*)(LOGF + ro + 4) = lf[1];
                        *(u32x4*)(Q0 + 4 * BUFSTRIDE + ro) = pack8(kk[0], kk[1]); }
            }
        }
    }
};

struct EpiBf {
    static constexpr bool PERM = true, AFTER_DRAIN = false;
    bf16_t* O; int ldc;
    __device__ __forceinline__ void operator()(const f32x4 (&acc)[2][2][4][2], const Unit& u, int wr, int wc, int fr, int fq) const {
        const int row0 = u.pm * BM + wr * 64 + fr, col0 = u.pn * BM + wc * 32 + 8 * fq;
#pragma unroll
        for (int ai = 0; ai < 2; ++ai)
#pragma unroll
            for (int m = 0; m < 4; ++m) { bf16_t* rowp = O + (size_t)(row0 + ai * HALF + m * 16) * ldc + col0;
#pragma unroll
                for (int bj = 0; bj < 2; ++bj) *(u32x4*)(rowp + bj * HALF) = pack8(acc[ai][bj][m][0], acc[ai][bj][m][1]); }
    }
};
struct EpiUp {
    static constexpr bool PERM = true, AFTER_DRAIN = false;
    bf16_t* O; int ldc;
    __device__ __forceinline__ void operator()(const f32x4 (&acc)[2][2][4][2], const Unit& u, int wr, int wc, int fr, int fq) const {
        const int row0 = u.pm * BM + wr * 64 + fr, col0 = u.pn * BM + wc * 32 + 8 * fq;
#pragma unroll
        for (int ai = 0; ai < 2; ++ai)
#pragma unroll
            for (int m = 0; m < 4; ++m) { bf16_t* rowp = O + (size_t)(row0 + ai * HALF + m * 16) * ldc + col0;
#pragma unroll
                for (int bj = 0; bj < 2; ++bj) { f32x4 v0 = acc[ai][bj][m][0], v1 = acc[ai][bj][m][1];
#pragma unroll
                    for (int j = 0; j < 4; ++j) { const float a = fmaxf(v0[j], 0.f), b = fmaxf(v1[j], 0.f); v0[j] = a * a; v1[j] = b * b; }
                    *(u32x4*)(rowp + bj * HALF) = pack8(v0, v1); } }
    }
};
struct EpiOut {
    static constexpr bool PERM = true, AFTER_DRAIN = false;
    const float* xp; const float* xs; float* X1; bf16_t* A2; float* SSP;
    __device__ __forceinline__ void operator()(const f32x4 (&acc)[2][2][4][2], const Unit& u, int wr, int wc, int fr, int fq) const {
        const int row0 = u.pm * BM + wr * 64 + fr, col0 = u.pn * BM + wc * 32 + 8 * fq; const bool prow = u.pm < 64;
#pragma unroll
        for (int ai = 0; ai < 2; ++ai) { if (!prow && ai == 1) break;
#pragma unroll
            for (int m = 0; m < 4; ++m) { const int row = row0 + ai * HALF + m * 16; const float* xr = (prow ? xp + (size_t)row * D : xs + (size_t)(row - MP) * D) + col0;
                float s = 0.f;
#pragma unroll
                for (int bj = 0; bj < 2; ++bj) { const f32x4 a0 = *(const f32x4*)(xr + bj * HALF), a1 = *(const f32x4*)(xr + bj * HALF + 4);
                    const f32x4 v0 = a0 + acc[ai][bj][m][0], v1 = a1 + acc[ai][bj][m][1];
                    s += (v0[0] * v0[0] + v0[1] * v0[1]) + (v0[2] * v0[2] + v0[3] * v0[3]) + (v1[0] * v1[0] + v1[1] * v1[1]) + (v1[2] * v1[2] + v1[3] * v1[3]);
                    float* o = X1 + (size_t)row * D + col0 + bj * HALF; *(f32x4*)o = v0; *(f32x4*)(o + 4) = v1;
                    *(u32x4*)(A2 + (size_t)row * D + col0 + bj * HALF) = pack8(v0, v1); }
                s += __shfl_xor(s, 16); s += __shfl_xor(s, 32);
                if (fq == 0) SSP[(size_t)row * 16 + u.pn * 4 + wc] = s; } }
    }
};
struct EpiDown {
    static constexpr bool PERM = true, AFTER_DRAIN = false;
    const float* X1; float* X2; bf16_t* A3; const float* SSP;
    __device__ __forceinline__ void operator()(const f32x4 (&acc)[2][2][4][2], const Unit& u, int wr, int wc, int fr, int fq) const {
        const int row0 = u.pm * BM + wr * 64 + fr, col0 = u.pn * BM + wc * 32 + 8 * fq; const bool prow = u.pm < 64;
#pragma unroll
        for (int ai = 0; ai < 2; ++ai) { if (!prow && ai == 1) break;
#pragma unroll
            for (int m = 0; m < 4; ++m) { const int row = row0 + ai * HALF + m * 16;
                const f32x4 p0 = *(const f32x4*)(SSP + (size_t)row * 16), p1 = *(const f32x4*)(SSP + (size_t)row * 16 + 4), p2 = *(const f32x4*)(SSP + (size_t)row * 16 + 8), p3 = *(const f32x4*)(SSP + (size_t)row * 16 + 12);
                const f32x4 ps = (p0 + p1) + (p2 + p3); const float ss = (ps[0] + ps[1]) + (ps[2] + ps[3]);
                const float r2 = frcp(ss * (1.0f / D) + EPS);
#pragma unroll
                for (int bj = 0; bj < 2; ++bj) { const float* xi = X1 + (size_t)row * D + col0 + bj * HALF; float* o = X2 + (size_t)row * D + col0 + bj * HALF;
                    const f32x4 v0 = *(const f32x4*)xi + acc[ai][bj][m][0] * r2, v1 = *(const f32x4*)(xi + 4) + acc[ai][bj][m][1] * r2;
                    *(f32x4*)o = v0; *(f32x4*)(o + 4) = v1;
                    *(u32x4*)(A3 + (size_t)row * D + col0 + bj * HALF) = pack8(v0, v1); } } }
    }
};
struct EpiGate {
    static constexpr bool PERM = true, AFTER_DRAIN = false;
    const float* X1; const bf16_t* PJ; float* out; float* SSP;
    __device__ __forceinline__ void operator()(const f32x4 (&acc)[2][2][4][2], const Unit& u, int wr, int wc, int fr, int fq) const {
        const int row0 = u.pm * BM + wr * 64 + fr, col0 = u.pn * BM + wc * 32 + 8 * fq; const bool prow = u.pm < 64;
#pragma unroll
        for (int ai = 0; ai < 2; ++ai) { if (!prow && ai == 1) break;
#pragma unroll
            for (int m = 0; m < 4; ++m) { const int row = row0 + ai * HALF + m * 16; float* orow = out + (size_t)row * D + col0;
                float s = 0.f;
#pragma unroll
                for (int bj = 0; bj < 2; ++bj) { const float* xr = X1 + (size_t)row * D + col0 + bj * HALF; const f32x4 a0 = *(const f32x4*)xr, a1 = *(const f32x4*)(xr + 4);
                    const u32x4 pj = *(const u32x4*)(PJ + (size_t)row * D + col0 + bj * HALF);
                    f32x4 v0, v1;
#pragma unroll
                    for (int j = 0; j < 4; ++j) { const unsigned w0 = pj[j >> 1], w1 = pj[2 + (j >> 1)];
                        const float pa = __uint_as_float((j & 1) ? (w0 & 0xffff0000u) : (w0 << 16)), pb = __uint_as_float((j & 1) ? (w1 & 0xffff0000u) : (w1 << 16));
                        v0[j] = a0[j] + sigmoidf_(acc[ai][bj][m][0][j]) * pa; v1[j] = a1[j] + sigmoidf_(acc[ai][bj][m][1][j]) * pb; }
                    s += (v0[0] * v0[0] + v0[1] * v0[1]) + (v0[2] * v0[2] + v0[3] * v0[3]) + (v1[0] * v1[0] + v1[1] * v1[1]) + (v1[2] * v1[2] + v1[3] * v1[3]);
                    *(f32x4*)(orow + bj * HALF) = v0; *(f32x4*)(orow + bj * HALF + 4) = v1; }
                s += __shfl_xor(s, 16); s += __shfl_xor(s, 32);
                if (fq == 0) SSP[(size_t)row * 16 + u.pn * 4 + wc] = s; } }
    }
};

template <class Epi, class Sched, bool ALIGN_EPI = false, bool SP2 = false>
__device__ __forceinline__ void gemm_phase(PG8_LAS unsigned char* lds, const Gemm g, const Sched& S, const Epi& E) {
    const int tid = threadIdx.x, wid = __builtin_amdgcn_readfirstlane(tid >> 6), lane = tid & 63, wr = wid >> 2, wc = wid & 3, fr = lane & 15, fq = lane >> 4;
    const int K = g.K, nt = K / BK;
    unsigned voffA[2], voffB[2];
#pragma unroll
    for (int i = 0; i < 2; ++i) { int R, C; stage_rc(tid * 16 + i * 8192, R, C); const int Rb = Epi::PERM ? ((R & ~31) + perm32(R & 31)) : R;
        voffA[i] = (unsigned)(R * K + C) * 2u; voffB[i] = (unsigned)(Rb * K + C) * 2u; }
    const size_t kstep = (size_t)(BK * 2);
    const size_t hstep = (size_t)HALF * K * 2;
    const size_t tstep = 2 * hstep;
    const unsigned ldsw = (unsigned)wid * 1024u;
    const int aoff = lds_byte(wr * 64 + fr, fq * 8), boff = lds_byte(wc * 32 + fr, fq * 8);
#define PG8_SA(b, h) (((b) * 2 + (h)) * HTB)
#define PG8_SB(b, h) ((4 + (b) * 2 + (h)) * HTB)
#define PG8_STAGE(bufoff, gbase, voff) do { _Pragma("unroll") for (int _i = 0; _i < 2; ++_i) \
        __builtin_amdgcn_global_load_lds((const unsigned*)((const char*)(gbase) + (voff)[_i]), (PG8_LAS unsigned*)(lds + (bufoff) + ldsw + _i * 8192), 16, 0, 0); } while (0)
#define PG8_LDA(dst, b, h) do { _Pragma("unroll") for (int m = 0; m < 4; ++m) _Pragma("unroll") for (int k = 0; k < 2; ++k) dst[m][k] = *(const PG8_LAS bf16x8*)(lds + PG8_SA(b, h) + aoff + m * 2048 + k * 1024); } while (0)
#define PG8_LDB(dst, b, h) do { _Pragma("unroll") for (int n = 0; n < 2; ++n) _Pragma("unroll") for (int k = 0; k < 2; ++k) dst[n][k] = *(const PG8_LAS bf16x8*)(lds + PG8_SB(b, h) + boff + n * 2048 + k * 1024); } while (0)
#define PG8_MMA(ai, bj, At, Bt) do { __builtin_amdgcn_s_setprio(1); _Pragma("unroll") for (int m = 0; m < 4; ++m) _Pragma("unroll") for (int n = 0; n < 2; ++n) _Pragma("unroll") for (int k = 0; k < 2; ++k) \
        acc[ai][bj][m][n] = __builtin_amdgcn_mfma_f32_16x16x32_bf16(Bt[n][k], At[m][k], acc[ai][bj][m][n], 0, 0, 0); __builtin_amdgcn_s_setprio(0); } while (0)
#define PG8_WAIT_V(n) asm volatile("s_waitcnt vmcnt(" #n ")" ::: "memory")
#define PG8_WAIT_L(n) asm volatile("s_waitcnt lgkmcnt(" #n ")" ::: "memory")
#define PG8_BAR __builtin_amdgcn_s_barrier()
#define PG8_SCHED __builtin_amdgcn_sched_barrier(0)
    Unit cur, nxt; int ui = 0;
    if (!S.next(0, cur)) return;
    f32x4 acc[2][2][4][2];
#pragma unroll
    for (int a = 0; a < 2; ++a)
#pragma unroll
        for (int b = 0; b < 2; ++b)
#pragma unroll
            for (int m = 0; m < 4; ++m)
#pragma unroll
                for (int n = 0; n < 2; ++n) acc[a][b][m][n] = (f32x4){0.f, 0.f, 0.f, 0.f};
    bf16x8 At[4][2], B0[2][2], B1[2][2];
    const char* cA = (const char*)g.A + (size_t)cur.pm * tstep; const char* cB = (const char*)g.Bt + (size_t)cur.pn * tstep;
    S.a_ready(cur);
    if constexpr (SP2) {
        PG8_STAGE(PG8_SB(0, 0), cB, voffB); PG8_STAGE(PG8_SB(0, 1), cB + hstep, voffB); PG8_STAGE(PG8_SA(0, 0), cA, voffA); PG8_STAGE(PG8_SA(0, 1), cA + hstep, voffA);
        if (wr == 1) PG8_BAR;
        PG8_WAIT_V(2); PG8_BAR;
        PG8_STAGE(PG8_SB(1, 0), cB + kstep, voffB); PG8_STAGE(PG8_SA(1, 0), cA + kstep, voffA); PG8_STAGE(PG8_SB(1, 1), cB + hstep + kstep, voffB);
        PG8_WAIT_V(6); PG8_BAR;
    } else {
        PG8_STAGE(PG8_SB(0, 0), cB, voffB); PG8_STAGE(PG8_SA(0, 0), cA, voffA); PG8_STAGE(PG8_SB(0, 1), cB + hstep, voffB); PG8_STAGE(PG8_SA(0, 1), cA + hstep, voffA);
        if (wr == 1) PG8_BAR;
        PG8_WAIT_V(4); PG8_BAR;
        PG8_STAGE(PG8_SB(1, 0), cB + kstep, voffB); PG8_STAGE(PG8_SA(1, 0), cA + kstep, voffA); PG8_STAGE(PG8_SB(1, 1), cB + hstep + kstep, voffB);
        PG8_WAIT_V(6); PG8_BAR;
    }
    for (;;) {
        const bool has_next = S.next(ui + 1, nxt);
        const char* nA = has_next ? (const char*)g.A + (size_t)nxt.pm * tstep : cA; const char* nB = has_next ? (const char*)g.Bt + (size_t)nxt.pn * tstep : cB;
        for (int t = 0; t < nt; t += 2) {
            const bool last = (t == nt - 2);
            const char* a1 = cA + (size_t)(t + 1) * kstep;
            const char* a2 = last ? nA : cA + (size_t)(t + 2) * kstep; const char* b2 = last ? nB : cB + (size_t)(t + 2) * kstep;
            const char* a3 = a2 + kstep; const char* b3 = b2 + kstep;
            if (last && has_next) S.a_ready(nxt);
            if constexpr (SP2) {
            PG8_LDB(B0, 0, 0); PG8_LDB(B1, 0, 1); PG8_SCHED; PG8_LDA(At, 0, 0); PG8_STAGE(PG8_SA(1, 1), a1 + hstep, voffA);
            PG8_WAIT_V(8); PG8_WAIT_L(0); PG8_BAR; PG8_MMA(0, 0, At, B0); PG8_MMA(0, 1, At, B1); PG8_BAR; PG8_SCHED;
            PG8_LDA(At, 0, 1); PG8_STAGE(PG8_SB(0, 0), b2, voffB); PG8_STAGE(PG8_SB(0, 1), b2 + hstep, voffB); PG8_STAGE(PG8_SA(0, 0), a2, voffA);
            PG8_WAIT_V(8); PG8_WAIT_L(0); PG8_BAR; PG8_MMA(1, 0, At, B0); PG8_MMA(1, 1, At, B1); PG8_BAR; PG8_SCHED;
            PG8_LDB(B0, 1, 0); PG8_LDB(B1, 1, 1); PG8_SCHED; PG8_LDA(At, 1, 0); PG8_STAGE(PG8_SA(0, 1), a2 + hstep, voffA);
            PG8_WAIT_V(8); PG8_WAIT_L(0); PG8_BAR; PG8_MMA(0, 0, At, B0); PG8_MMA(0, 1, At, B1); PG8_BAR; PG8_SCHED;
            PG8_LDA(At, 1, 1); PG8_STAGE(PG8_SB(1, 0), b3, voffB); PG8_STAGE(PG8_SB(1, 1), b3 + hstep, voffB); PG8_STAGE(PG8_SA(1, 0), a3, voffA);
            PG8_WAIT_V(8); PG8_WAIT_L(0); PG8_BAR; PG8_MMA(1, 0, At, B0); PG8_MMA(1, 1, At, B1); PG8_BAR; PG8_SCHED;
            } else {
            PG8_LDB(B0, 0, 0); PG8_SCHED; PG8_LDA(At, 0, 0); PG8_STAGE(PG8_SA(1, 1), a1 + hstep, voffA);
            PG8_WAIT_L(8); PG8_BAR; PG8_WAIT_L(0); PG8_MMA(0, 0, At, B0); PG8_BAR; PG8_SCHED;
            PG8_LDB(B1, 0, 1); PG8_STAGE(PG8_SB(0, 0), b2, voffB);
            PG8_BAR; PG8_WAIT_L(0); PG8_MMA(0, 1, At, B1); PG8_BAR;
            PG8_LDA(At, 0, 1); PG8_STAGE(PG8_SA(0, 0), a2, voffA);
            PG8_BAR; PG8_WAIT_L(0); PG8_MMA(1, 0, At, B0); PG8_BAR; PG8_SCHED;
            PG8_STAGE(PG8_SB(0, 1), b2 + hstep, voffB);
            PG8_WAIT_V(6); PG8_BAR; PG8_MMA(1, 1, At, B1); PG8_BAR;
            PG8_LDB(B0, 1, 0); PG8_SCHED; PG8_LDA(At, 1, 0); PG8_STAGE(PG8_SA(0, 1), a2 + hstep, voffA);
            PG8_WAIT_L(8); PG8_BAR; PG8_WAIT_L(0); PG8_MMA(0, 0, At, B0); PG8_BAR; PG8_SCHED;
            PG8_LDB(B1, 1, 1); PG8_STAGE(PG8_SB(1, 0), b3, voffB);
            PG8_BAR; PG8_WAIT_L(0); PG8_MMA(0, 1, At, B1); PG8_BAR;
            PG8_LDA(At, 1, 1); PG8_STAGE(PG8_SA(1, 0), a3, voffA);
            PG8_BAR; PG8_WAIT_L(0); PG8_MMA(1, 0, At, B0); PG8_BAR; PG8_SCHED;
            PG8_STAGE(PG8_SB(1, 1), b3 + hstep, voffB);
            PG8_WAIT_V(6); PG8_BAR; PG8_MMA(1, 1, At, B1); PG8_BAR;
            }
        }
        if constexpr (ALIGN_EPI) { if (wr == 0) PG8_BAR; }
        if constexpr (!Epi::AFTER_DRAIN) { E(acc, cur, wr, wc, fr, fq); S.done(cur); }
        if (!has_next) break;
#pragma unroll
        for (int a = 0; a < 2; ++a)
#pragma unroll
            for (int b = 0; b < 2; ++b)
#pragma unroll
                for (int m = 0; m < 4; ++m)
#pragma unroll
                    for (int n = 0; n < 2; ++n) acc[a][b][m][n] = (f32x4){0.f, 0.f, 0.f, 0.f};
        cur = nxt; cA = nA; cB = nB; ++ui;
        if constexpr (ALIGN_EPI) { if (wr == 1) PG8_BAR; }
    }
    PG8_WAIT_V(0);
    if constexpr (!ALIGN_EPI) { if (wr == 0) PG8_BAR; }
    PG8_BAR;
    if constexpr (Epi::AFTER_DRAIN) { E.fused(acc, cur, wr, wc, fr, fq, lds, wid, lane); S.done(cur); }
#undef PG8_SA
#undef PG8_SB
#undef PG8_STAGE
#undef PG8_LDA
#undef PG8_LDB
#undef PG8_MMA
#undef PG8_WAIT_V
#undef PG8_WAIT_L
#undef PG8_BAR
#undef PG8_SCHED
}
}
#define GAS __attribute__((address_space(1)))
#define LAS __attribute__((address_space(3)))
typedef unsigned short bf16;
typedef unsigned v4u __attribute__((ext_vector_type(4)));
typedef float f32x4 __attribute__((ext_vector_type(4)));
typedef short bf16x8 __attribute__((ext_vector_type(8)));
typedef GAS unsigned gu32;
typedef GAS unsigned long long gu64;
#define RLX_AGENT __ATOMIC_RELAXED, __HIP_MEMORY_SCOPE_AGENT
#define LDS_WAIT() asm volatile("s_waitcnt lgkmcnt(0)" ::: "memory")
#define VM_WAIT() asm volatile("s_waitcnt vmcnt(0)" ::: "memory")
__device__ __forceinline__ unsigned long long rt() { return __builtin_amdgcn_s_memrealtime(); }
__device__ __forceinline__ unsigned f2bf(float f) { unsigned u = __builtin_bit_cast(unsigned, f); return (u + 0x7fffu + ((u >> 16) & 1u)) >> 16; }
__device__ __forceinline__ unsigned pk2(float lo, float hi) { return f2bf(lo) | (f2bf(hi) << 16); }

#define XB_TMO      128
#define XB_XCNT(j)  (256  + 64 * (j))
#define XB_XSUB(j)  (1280 + 64 * (j))
#define XB_XGEN(j)  (2304 + 64 * (j))
#define XB_TOP      3328
#define XB_TOPGEN   3392
#define XCD_BAR_WORDS 3456
#define XB_SPIN_CAP (1u << 18)

__device__ __forceinline__ unsigned xb_ld(unsigned* p)              { return __hip_atomic_load(p, __ATOMIC_RELAXED, __HIP_MEMORY_SCOPE_AGENT); }
__device__ __forceinline__ unsigned xb_add(unsigned* p, unsigned v) { return __hip_atomic_fetch_add(p, v, __ATOMIC_RELAXED, __HIP_MEMORY_SCOPE_AGENT); }
__device__ __forceinline__ unsigned xb_xcc_id() { return (unsigned)__builtin_amdgcn_s_getreg((3 << 11) | 20) & 0xFu; }
#define XB_SPIN(cond, bar) do { unsigned _sp = 0; while (cond) { __builtin_amdgcn_s_sleep(1); \
    if ((++_sp & 255u) == 0u) { if (xb_ld(&(bar)[XB_TMO])) break; if (_sp > XB_SPIN_CAP) { atomicAdd(&(bar)[XB_TMO], 1u); break; } } } } while (0)

struct XcdBarrier {
    unsigned* bar; unsigned x;
    volatile LAS unsigned* st;
};

__device__ __forceinline__ XcdBarrier xcd_barrier_post(unsigned* bar, volatile LAS unsigned* st) {
    XcdBarrier b; b.bar = bar; b.x = xb_xcc_id(); b.st = st;
    if (threadIdx.x == 0) (void)xb_add(&bar[XB_XCNT(b.x)], 1u);
    return b;
}
__device__ __forceinline__ void xcd_barrier_complete(unsigned* bar, unsigned x, unsigned& nloc, unsigned& nx) {
    const unsigned G = gridDim.x * gridDim.y * gridDim.z;
    unsigned sum, cnt, mine, sp = 0u;
    for (;;) {
        sum = 0u; cnt = 0u; mine = 0u;
#pragma unroll
        for (unsigned j = 0; j < 16; ++j) { const unsigned c = xb_ld(&bar[XB_XCNT(j)]); sum += c; cnt += (c > 0u) ? 1u : 0u; mine = (j == x) ? c : mine; }
        if (sum == G) break;
        __builtin_amdgcn_s_sleep(1);
        if ((++sp & 255u) == 0u) { if (xb_ld(&bar[XB_TMO])) break; if (sp > XB_SPIN_CAP) { atomicAdd(&bar[XB_TMO], 1u); break; } }
    }
    nloc = mine > 0u ? mine : 1u; nx = cnt > 0u ? cnt : 1u;
}

__device__ __forceinline__ void xcd_barrier(const XcdBarrier& b) {
    asm volatile("s_waitcnt vmcnt(0)" ::: "memory");
    __syncthreads();
    if (threadIdx.x == 0) {
        unsigned* bar = b.bar;
        __builtin_amdgcn_s_waitcnt(0);
        unsigned nloc = b.st[0], nx = b.st[1];
        if (nloc == 0u) { xcd_barrier_complete(bar, b.x, nloc, nx); b.st[0] = nloc; b.st[1] = nx; }
        const unsigned old = xb_add(&bar[XB_XSUB(b.x)], 1u);
        const unsigned gen = old / nloc;
        if (old + 1u == (gen + 1u) * nloc) {
            __builtin_amdgcn_fence(__ATOMIC_RELEASE, "agent");
            asm volatile("s_waitcnt vmcnt(0)" ::: "memory");
            const unsigned og = xb_add(&bar[XB_TOP], 1u);
            const unsigned tg = og / nx;
            if (og + 1u == (tg + 1u) * nx) xb_add(&bar[XB_TOPGEN], 1u);
            else XB_SPIN(xb_ld(&bar[XB_TOPGEN]) == tg, bar);
            __builtin_amdgcn_fence(__ATOMIC_ACQUIRE, "agent");
            xb_add(&bar[XB_XGEN(b.x)], 1u);
            asm volatile("s_waitcnt vmcnt(0)" ::: "memory");
        } else {
            XB_SPIN(xb_ld(&bar[XB_XGEN(b.x)]) == gen, bar);
            __builtin_amdgcn_fence(__ATOMIC_ACQUIRE, "agent");
            asm volatile("s_waitcnt vmcnt(0)" ::: "memory");
        }
    }
    __syncthreads();
}

typedef float f32x16 __attribute__((ext_vector_type(16)));
typedef short s16x4 __attribute__((ext_vector_type(4)));
typedef unsigned u32x2v __attribute__((ext_vector_type(2)));
typedef LAS unsigned char* ldsp_t;
#define WAITV0_BAR() asm volatile("s_waitcnt vmcnt(0) lgkmcnt(0)\n\ts_barrier" ::: "memory")
#define LGKM_BAR() asm volatile("s_waitcnt lgkmcnt(0)\n\ts_barrier" ::: "memory")
__device__ __forceinline__ int crow(int r, int hi) { return (r & 3) + 8 * (r >> 2) + 4 * hi; }
__device__ __forceinline__ unsigned cvtpk(float lo, float hi) { unsigned r; asm volatile("v_cvt_pk_bf16_f32 %0, %1, %2" : "=v"(r) : "v"(lo), "v"(hi)); return r; }
__device__ __forceinline__ float bf2f(unsigned short b) { return __uint_as_float((unsigned)b << 16); }
__device__ __forceinline__ float bflo(unsigned w) { return __uint_as_float(w << 16); }
__device__ __forceinline__ float bfhi(unsigned w) { return __uint_as_float(w & 0xffff0000u); }
__device__ __forceinline__ float ex2(float x) { return __builtin_amdgcn_exp2f(x); }
__device__ __forceinline__ float fexpn(float x) { return __builtin_amdgcn_exp2f(x * LOG2E); }
__device__ __forceinline__ float swap_max(float v) { auto rr = __builtin_amdgcn_permlane32_swap(__float_as_uint(v), __float_as_uint(v), false, false); return fmaxf(__uint_as_float(rr[0]), __uint_as_float(rr[1])); }
__device__ __forceinline__ float swap_sum(float v) { auto rr = __builtin_amdgcn_permlane32_swap(__float_as_uint(v), __float_as_uint(v), false, false); return __uint_as_float(rr[0]) + __uint_as_float(rr[1]); }
__device__ __forceinline__ s16x4 vtr(LAS const unsigned char* p) { return __builtin_bit_cast(s16x4, __builtin_amdgcn_ds_read_tr16_b64_v4i16((LAS s16x4*)p)); }
__device__ __forceinline__ bf16x8 cat8(s16x4 a, s16x4 b) { return (bf16x8){a[0], a[1], a[2], a[3], b[0], b[1], b[2], b[3]}; }
__device__ __forceinline__ bf16x8 accfrag(const f32x16& x, int s) {
    v4u w; w.x = cvtpk(x[8 * s + 0], x[8 * s + 1]); w.y = cvtpk(x[8 * s + 2], x[8 * s + 3]); w.z = cvtpk(x[8 * s + 4], x[8 * s + 5]); w.w = cvtpk(x[8 * s + 6], x[8 * s + 7]);
    return __builtin_bit_cast(bf16x8, w);
}
#define DMA16(gsrc, ldsdst) __builtin_amdgcn_global_load_lds((const unsigned*)(gsrc), (LAS unsigned*)(ldsdst), 16, 0, 0)
__device__ __forceinline__ void dma_vimg(const bf16* src, int pitch, ldsp_t img, int wid, int lane) {
    const int sub = lane >> 5, row = (lane & 31) >> 2, ch = lane & 3;
#pragma unroll
    for (int j = 0; j < 2; ++j) DMA16(src + (size_t)(8 * wid + row) * pitch + 32 * (2 * j + sub) + 8 * ch, img + (wid * 4 + 2 * j) * 512);
}
__device__ __forceinline__ int vtr_lane_off(int lane) { return ((lane >> 4) & 1) * 32 + (lane & 3) * 8 + ((lane & 15) >> 2) * 64; }

namespace att {
constexpr int BUFB = 32768, KIMG = 16384, XOFF = 65536;
__device__ __forceinline__ void unit(int b, int h, int qblk, const bf16* Q, const bf16* K, const bf16* V, bf16* MIX, float lam, const float* gsub, ldsp_t lds) {
    int tid = threadIdx.x; asm volatile("" : "+v"(tid));
    const int lane = tid & 63, wid = __builtin_amdgcn_readfirstlane(tid >> 6), r32 = lane & 31, hi = lane >> 5, mp = wid >> 2, qb = wid & 3;
    const int q0 = qblk * 128, NT = 2 * (qblk + 1);
    const size_t rowbase = (size_t)b * SEQ;
    const int qg = q0 + 32 * qb + r32;
    bf16x8 qr[4];
    { const bf16* qp = Q + (rowbase + qg) * AW + h * 128 + mp * 64 + hi * 8;
#pragma unroll
      for (int d0 = 0; d0 < 4; ++d0) qr[d0] = *(const bf16x8*)(qp + 16 * d0); }
    const bf16* ksrc = K + (rowbase + lane) * AW + h * 128 + mp * 64 + 2 * (wid & 3) * 8;
    const bf16* vsrc = V + rowbase * AW + h * 128;
    const int kdst = mp * 8192 + 2 * (wid & 3) * 1024;
#define ATT_DMA(t, buf) do { const bf16* ks_ = ksrc + (size_t)(t) * 64 * AW; DMA16(ks_, lds + (buf) * BUFB + kdst); DMA16(ks_ + 8, lds + (buf) * BUFB + kdst + 1024); \
        dma_vimg(vsrc + (size_t)(t) * 64 * AW, AW, lds + (buf) * BUFB + KIMG, wid, lane); } while (0)
    f32x16 o[4];
#pragma unroll
    for (int i = 0; i < 4; ++i) o[i] = (f32x16){};
    float mrun = -1e30f, lsum = 0.f;
    const int vlo = vtr_lane_off(lane) + 4 * hi * 64;
    ATT_DMA(0, 0);
    WAITV0_BAR();
    for (int t = 0; t < NT; ++t) {
        const int buf = t & 1;
        if (t + 1 < NT) ATT_DMA(t + 1, buf ^ 1);
        if (64 * t <= q0 + 32 * qb + 31) {
            const LAS unsigned char* kb = lds + buf * BUFB + mp * 8192 + hi * 1024 + r32 * 16;
            f32x16 p0 = (f32x16){}, p1 = (f32x16){};
#pragma unroll
            for (int d0 = 0; d0 < 4; ++d0) {
                const bf16x8 k0 = *(const LAS bf16x8*)(kb + d0 * 2048), k1 = *(const LAS bf16x8*)(kb + d0 * 2048 + 512);
                p0 = __builtin_amdgcn_mfma_f32_32x32x16_bf16(k0, qr[d0], p0, 0, 0, 0);
                p1 = __builtin_amdgcn_mfma_f32_32x32x16_bf16(k1, qr[d0], p1, 0, 0, 0);
            }
            if (64 * t + 63 > q0 + 32 * qb) {
#pragma unroll
                for (int r = 0; r < 16; ++r) { const int kv = 64 * t + crow(r, hi); if (kv > qg) p0[r] = -1e30f; if (kv + 32 > qg) p1[r] = -1e30f; }
            }
            float mt = fmaxf(p0[0], p1[0]);
#pragma unroll
            for (int r = 1; r < 16; ++r) mt = fmaxf(mt, fmaxf(p0[r], p1[r]));
            mt = swap_max(mt);
            const float mnew = fmaxf(mrun, mt);
            if (__any(mnew > mrun)) {
                const float al = ex2(mrun - mnew); lsum *= al;
#pragma unroll
                for (int i = 0; i < 4; ++i)
#pragma unroll
                    for (int r = 0; r < 16; ++r) o[i][r] *= al;
            }
            mrun = mnew;
            float ps = 0.f;
#pragma unroll
            for (int r = 0; r < 16; ++r) { p0[r] = ex2(p0[r] - mnew); p1[r] = ex2(p1[r] - mnew); ps += p0[r] + p1[r]; }
            lsum += ps;
            bf16x8 pw[4]; pw[0] = accfrag(p0, 0); pw[1] = accfrag(p0, 1); pw[2] = accfrag(p1, 0); pw[3] = accfrag(p1, 1);
            const LAS unsigned char* vb = lds + buf * BUFB + KIMG + vlo;
#pragma unroll
            for (int s = 0; s < 4; ++s)
#pragma unroll
                for (int db = 0; db < 4; ++db) {
                    const bf16x8 vf = cat8(vtr(vb + ((2 * s) * 4 + db) * 512), vtr(vb + ((2 * s + 1) * 4 + db) * 512));
                    o[db] = __builtin_amdgcn_mfma_f32_32x32x16_bf16(vf, pw[s], o[db], 0, 0, 0);
                }
        }
        WAITV0_BAR();
    }
#undef ATT_DMA
    const float inv = 1.0f / swap_sum(lsum);
    LAS float* X = (LAS float*)(lds + XOFF);
    if (mp == 1) { const float sc = lam * inv;
#pragma unroll
        for (int db = 0; db < 4; ++db)
#pragma unroll
            for (int r = 0; r < 16; ++r) X[(qb * 64 + db * 16 + r) * 64 + lane] = o[db][r] * sc; }
    LGKM_BAR();
    if (mp == 0) {
        float ss = 0.f;
#pragma unroll
        for (int db = 0; db < 4; ++db)
#pragma unroll
            for (int r = 0; r < 16; ++r) { const float a = o[db][r] * inv - X[(qb * 64 + db * 16 + r) * 64 + lane]; o[db][r] = a; ss += a * a; }
        ss = swap_sum(ss);
        const float rs = (1.0f - LAM_INIT) / sqrtf(ss * (1.0f / 128.0f) + EPS);
        bf16* orow = MIX + (rowbase + qg) * D + h * 128;
#pragma unroll
        for (int db = 0; db < 4; ++db)
#pragma unroll
            for (int g = 0; g < 4; ++g) { const int d = 32 * db + 8 * g + 4 * hi; const f32x4 gg = *(const f32x4*)(gsub + d);
                u32x2v w; w.x = cvtpk(o[db][4 * g] * rs * gg[0], o[db][4 * g + 1] * rs * gg[1]); w.y = cvtpk(o[db][4 * g + 2] * rs * gg[2], o[db][4 * g + 3] * rs * gg[3]);
                *(u32x2v*)(orow + d) = w; }
    }
}
}

namespace hg {
constexpr int QE_OFF = 0, QE_P = 136  , KE_OFF = 17408, KLT_OFF = 34816, KLT_P = 72, V_OFF = 53248, G_OFF = 86016, QT_OFF = 86528, LDS_END = 88576;
__device__ __forceinline__ void unit(int bh, const bf16* RQ, const bf16* RK, const bf16* RV, const float* LOGF, bf16* OREC, float* sout, ldsp_t lds) {
    int tid = threadIdx.x; asm volatile("" : "+v"(tid));
    const int lane = tid & 63, wid = __builtin_amdgcn_readfirstlane(tid >> 6), r32 = lane & 31, hi = lane >> 5, th = wid >> 2, eb = wid & 3;
    const int b = bh >> 2, h = bh & 3;
    const size_t rowbase = (size_t)b * SEQ; const int col0 = h * 128;
    const int d = tid & 127, tq = tid >> 7;
    LAS bf16* QE = (LAS bf16*)(lds + QE_OFF); LAS bf16* KE = (LAS bf16*)(lds + KE_OFF); LAS bf16* KLT = (LAS bf16*)(lds + KLT_OFF);
    LAS float* G = (LAS float*)(lds + G_OFF); LAS float* QT = (LAS float*)(lds + QT_OFF);
    float lf[16]; unsigned short rq[16], rk[16];
    f32x16 S[4];
#pragma unroll
    for (int i = 0; i < 4; ++i) S[i] = (f32x16){};
    const int vlo = vtr_lane_off(lane);
#define HG_LOAD(n) do { const size_t g0_ = (rowbase + 64 * (n) + 16 * tq) * RW + col0 + d; _Pragma("unroll") for (int i = 0; i < 16; ++i) { lf[i] = LOGF[g0_ + (size_t)i * RW]; rq[i] = RQ[g0_ + (size_t)i * RW]; rk[i] = RK[g0_ + (size_t)i * RW]; } \
        dma_vimg(RV + (rowbase + 64 * (n)) * RW + col0, RW, lds + V_OFF + ((n) & 1) * 16384, wid, lane); } while (0)
#define HG_PREP() do { float cs_[16]; float c_ = 0.f; _Pragma("unroll") for (int i = 0; i < 16; ++i) { c_ += lf[i]; cs_[i] = c_; } \
        QT[tq * 128 + d] = c_; LGKM_BAR(); \
        float off_ = 0.f, tot_ = 0.f; _Pragma("unroll") for (int q = 0; q < 4; ++q) { const float v_ = QT[q * 128 + d]; tot_ += v_; if (q < tq) off_ += v_; } \
        if (tq == 0) G[d] = fexpn(tot_); \
        unsigned klw_[8]; \
        _Pragma("unroll") for (int i = 0; i < 16; i += 2) { \
            const float b0_ = cs_[i] + off_, b1_ = cs_[i + 1] + off_; const float q0_ = bf2f(rq[i]), q1_ = bf2f(rq[i + 1]), k0_ = bf2f(rk[i]), k1_ = bf2f(rk[i + 1]); \
            const unsigned qe_ = cvtpk(q0_ * fexpn(b0_), q1_ * fexpn(b1_)), ke_ = cvtpk(k0_ * fexpn(-b0_), k1_ * fexpn(-b1_)); \
            klw_[i >> 1] = cvtpk(k0_ * fexpn(tot_ - b0_), k1_ * fexpn(tot_ - b1_)); \
            QE[(16 * tq + i) * QE_P + d] = (bf16)(qe_ & 0xffffu); QE[(16 * tq + i + 1) * QE_P + d] = (bf16)(qe_ >> 16); \
            KE[(16 * tq + i) * QE_P + d] = (bf16)(ke_ & 0xffffu); KE[(16 * tq + i + 1) * QE_P + d] = (bf16)(ke_ >> 16); } \
        *(LAS v4u*)(KLT + d * KLT_P + 16 * tq) = (v4u){klw_[0], klw_[1], klw_[2], klw_[3]}; *(LAS v4u*)(KLT + d * KLT_P + 16 * tq + 8) = (v4u){klw_[4], klw_[5], klw_[6], klw_[7]}; } while (0)
    HG_LOAD(0);
    HG_PREP();
    WAITV0_BAR();
    for (int n = 0; n < 32; ++n) {
        if (n + 1 < 32) HG_LOAD(n + 1);
        const LAS unsigned char* vimg = lds + V_OFF + (n & 1) * 16384;
        f32x16 o = (f32x16){};
        bf16x8 xw[2][2];
#pragma unroll
        for (int sb = 0; sb < 2; ++sb) if (sb <= th) {
            f32x16 x = (f32x16){};
#pragma unroll
            for (int sg = 0; sg < 8; ++sg) {
                const bf16x8 ka = *(const LAS bf16x8*)(KE + (32 * sb + r32) * QE_P + 16 * sg + 8 * hi), qbv = *(const LAS bf16x8*)(QE + (32 * th + r32) * QE_P + 16 * sg + 8 * hi);
                x = __builtin_amdgcn_mfma_f32_32x32x16_bf16(ka, qbv, x, 0, 0, 0);
            }
            if (sb == th) {
#pragma unroll
                for (int r = 0; r < 16; ++r) if (crow(r, hi) > r32) x[r] = 0.f;
            }
            xw[sb][0] = accfrag(x, 0); xw[sb][1] = accfrag(x, 1);
        }
#pragma unroll
        for (int db = 0; db < 4; ++db)
#pragma unroll
            for (int sg = 0; sg < 2; ++sg) {
                const LAS bf16* qp = QE + (32 * th + r32) * QE_P + 32 * db + 16 * sg + 4 * hi;
                const u32x2v a0 = *(const LAS u32x2v*)qp, a1 = *(const LAS u32x2v*)(qp + 8);
                const v4u aw = (v4u){a0.x, a0.y, a1.x, a1.y};
                o = __builtin_amdgcn_mfma_f32_32x32x16_bf16(__builtin_bit_cast(bf16x8, aw), accfrag(S[db], sg), o, 0, 0, 0);
            }
#pragma unroll
        for (int sb = 0; sb < 2; ++sb) if (sb <= th) {
#pragma unroll
            for (int sg = 0; sg < 2; ++sg) {
                const LAS unsigned char* vb = vimg + vlo + 4 * hi * 64 + ((4 * sb + 2 * sg) * 4 + eb) * 512;
                const bf16x8 vf = cat8(vtr(vb), vtr(vb + 4 * 512));
                o = __builtin_amdgcn_mfma_f32_32x32x16_bf16(xw[sb][sg], vf, o, 0, 0, 0);
            }
        }
        { bf16* op = OREC + (rowbase + 64 * n + 32 * th) * RW + col0 + 32 * eb + r32;
#pragma unroll
          for (int r = 0; r < 16; r += 2) { const unsigned w = cvtpk(o[r], o[r + 1]); op[(size_t)crow(r, hi) * RW] = (bf16)(w & 0xffffu); op[(size_t)crow(r + 1, hi) * RW] = (bf16)(w >> 16); } }
#pragma unroll
        for (int db = 0; db < 4; ++db) {
#pragma unroll
            for (int g = 0; g < 4; ++g) { const f32x4 gg = *(const LAS f32x4*)(G + 32 * db + 8 * g + 4 * hi);
                S[db][4 * g] *= gg[0]; S[db][4 * g + 1] *= gg[1]; S[db][4 * g + 2] *= gg[2]; S[db][4 * g + 3] *= gg[3]; }
        }
#pragma unroll
        for (int sg = 0; sg < 4; ++sg) {
            const LAS unsigned char* vb = vimg + vlo + ((2 * sg + hi) * 4 + eb) * 512;
            const bf16x8 vf = cat8(vtr(vb), vtr(vb + 4 * 64));
#pragma unroll
            for (int db = 0; db < 4; ++db) {
                const bf16x8 ka = *(const LAS bf16x8*)(KLT + (32 * db + r32) * KLT_P + 16 * sg + 8 * hi);
                S[db] = __builtin_amdgcn_mfma_f32_32x32x16_bf16(ka, vf, S[db], 0, 0, 0);
            }
        }
        LGKM_BAR();
        if (n + 1 < 32) HG_PREP();
        WAITV0_BAR();
    }
#undef HG_LOAD
#undef HG_PREP
    if (th == 0) { float* sp = sout + (size_t)bh * 16384 + 32 * eb + r32;
#pragma unroll
        for (int db = 0; db < 4; ++db)
#pragma unroll
            for (int r = 0; r < 16; ++r) sp[(size_t)(32 * db + crow(r, hi)) * 128] = S[db][r]; }
}
}

namespace dec {
constexpr int PART = 264;
__device__ __forceinline__ void unit(int bs, int h, const bf16* Q, const bf16* K, const bf16* V, const float* ck, const float* cv, const int* ptab, bf16* MIX, float lam, const float* gsub, ldsp_t lds) {
    int tid = threadIdx.x; asm volatile("" : "+v"(tid));
    const int lane = tid & 63, wid = __builtin_amdgcn_readfirstlane(tid >> 6);
    const size_t row = (size_t)MP + bs;
    LAS float* P = (LAS float*)lds;
    const int c4 = 4 * (lane & 31), half = lane >> 5, mymap = (lane >> 4) & 1;
    f32x4 q4; { const u32x2v qw = *(const u32x2v*)(Q + row * AW + h * 128 + c4); q4 = (f32x4){bflo(qw.x), bfhi(qw.x), bflo(qw.y), bfhi(qw.y)}; }
    float mrun = -1e30f, lrun = 0.f; f32x4 o0 = (f32x4){0.f, 0.f, 0.f, 0.f}, o1 = o0;
    const int pid0 = ptab[bs * NPAGES + 2 * wid], pid1 = ptab[bs * NPAGES + 2 * wid + 1];
    const size_t lo_ = (size_t)half * 512 + h * 128 + c4;
    const float* kp0 = ck + (size_t)pid0 * PAGE * 512 + lo_; const float* vp0 = cv + (size_t)pid0 * PAGE * 512 + lo_;
    const float* kp1 = ck + (size_t)pid1 * PAGE * 512 + lo_; const float* vp1 = cv + (size_t)pid1 * PAGE * 512 + lo_;
#define DEC_LOAD(KK, VV, st) do { const size_t so_ = (size_t)(16 * ((st) & 7)) * 512; const float* kq_ = ((st) < 8 ? kp0 : kp1) + so_; const float* vq_ = ((st) < 8 ? vp0 : vp1) + so_; \
        _Pragma("unroll") for (int i = 0; i < 8; ++i) KK[i] = __builtin_nontemporal_load((const f32x4*)(kq_ + (size_t)(2 * i) * 512)); \
        _Pragma("unroll") for (int i = 0; i < 8; ++i) VV[i] = __builtin_nontemporal_load((const f32x4*)(vq_ + (size_t)(2 * i) * 512)); } while (0)
#define DEC_COMPUTE(KK, VV) do { float pr[8]; \
        _Pragma("unroll") for (int i = 0; i < 8; ++i) pr[i] = (KK[i][0] * q4[0] + KK[i][1] * q4[1]) + (KK[i][2] * q4[2] + KK[i][3] * q4[3]); \
        float a4[4], a2[2], s; \
        { const bool up = (lane & 8) != 0; _Pragma("unroll") for (int i = 0; i < 4; ++i) { const float keep = up ? pr[i + 4] : pr[i], send = up ? pr[i] : pr[i + 4]; a4[i] = keep + __shfl_xor(send, 8); } } \
        { const bool up = (lane & 4) != 0; _Pragma("unroll") for (int i = 0; i < 2; ++i) { const float keep = up ? a4[i + 2] : a4[i], send = up ? a4[i] : a4[i + 2]; a2[i] = keep + __shfl_xor(send, 4); } } \
        { const bool up = (lane & 2) != 0; const float keep = up ? a2[1] : a2[0], send = up ? a2[0] : a2[1]; s = keep + __shfl_xor(send, 2); } \
        s += __shfl_xor(s, 1); \
        float mt = s; mt = fmaxf(mt, __shfl_xor(mt, 2)); mt = fmaxf(mt, __shfl_xor(mt, 4)); mt = fmaxf(mt, __shfl_xor(mt, 8)); mt = fmaxf(mt, __shfl_xor(mt, 32)); \
        const float mnew = fmaxf(mrun, mt), al = ex2(mrun - mnew), p = ex2(s - mnew); \
        float psum = p; psum += __shfl_xor(psum, 2); psum += __shfl_xor(psum, 4); psum += __shfl_xor(psum, 8); psum += __shfl_xor(psum, 32); \
        lrun = lrun * al + psum; mrun = mnew; \
        const float al0 = __shfl(al, 0), al1 = __shfl(al, 16); \
        o0 = o0 * al0; o1 = o1 * al1; \
        _Pragma("unroll") for (int i = 0; i < 8; ++i) { const float p0 = __shfl(p, (lane & 32) + 2 * i), p1 = __shfl(p, (lane & 32) + 16 + 2 * i); o0 = o0 + VV[i] * p0; o1 = o1 + VV[i] * p1; } } while (0)
    {
        f32x4 kA[8], vA[8], kB[8], vB[8];
        DEC_LOAD(kA, vA, 0);
        for (int st = 0; st < 16; st += 2) {
            DEC_LOAD(kB, vB, st + 1);
            DEC_COMPUTE(kA, vA);
            if (st + 2 < 16) DEC_LOAD(kA, vA, st + 2);
            DEC_COMPUTE(kB, vB);
        }
    }
#undef DEC_LOAD
#undef DEC_COMPUTE
#pragma unroll
    for (int j = 0; j < 4; ++j) { o0[j] += __shfl_xor(o0[j], 32); o1[j] += __shfl_xor(o1[j], 32); }
    { const float m0 = __shfl(mrun, 0), l0 = __shfl(lrun, 0), m1 = __shfl(mrun, 16), l1 = __shfl(lrun, 16);
      LAS float* pw = P + wid * PART;
      if (lane < 32) { *(LAS f32x4*)(pw + c4) = o0; *(LAS f32x4*)(pw + 128 + c4) = o1; }
      if (lane == 0) { pw[256] = m0; pw[257] = l0; pw[258] = m1; pw[259] = l1; } }
    if (wid == 0) {
        const u32x2v kw = *(const u32x2v*)(K + row * AW + h * 128 + c4);
        float s = (bflo(kw.x) * q4[0] + bfhi(kw.x) * q4[1]) + (bflo(kw.y) * q4[2] + bfhi(kw.y) * q4[3]);
        s += __shfl_xor(s, 1); s += __shfl_xor(s, 2); s += __shfl_xor(s, 4); s += __shfl_xor(s, 8);
        if (lane == 0) P[8 * PART] = s; if (lane == 16) P[8 * PART + 1] = s;
    }
    LGKM_BAR();
    if (wid == 0) {
        float M0 = P[8 * PART], M1 = P[8 * PART + 1]; const float sn0 = M0, sn1 = M1;
#pragma unroll
        for (int w = 0; w < 8; ++w) { M0 = fmaxf(M0, P[w * PART + 256]); M1 = fmaxf(M1, P[w * PART + 258]); }
        const float wn0 = ex2(sn0 - M0), wn1 = ex2(sn1 - M1);
        float L0 = wn0, L1 = wn1; float a[2], bq[2];
        { const bf16* vr = V + row * AW + h * 128; a[0] = wn0 * bf2f(vr[lane]); a[1] = wn0 * bf2f(vr[lane + 64]); bq[0] = wn1 * bf2f(vr[lane]); bq[1] = wn1 * bf2f(vr[lane + 64]); }
#pragma unroll
        for (int w = 0; w < 8; ++w) { const float f0 = ex2(P[w * PART + 256] - M0), f1 = ex2(P[w * PART + 258] - M1);
            L0 += f0 * P[w * PART + 257]; L1 += f1 * P[w * PART + 259];
            a[0] += f0 * P[w * PART + lane]; a[1] += f0 * P[w * PART + lane + 64]; bq[0] += f1 * P[w * PART + 128 + lane]; bq[1] += f1 * P[w * PART + 128 + lane + 64]; }
        const float i0 = 1.0f / L0, i1 = lam / L1;
        const float y0 = a[0] * i0 - bq[0] * i1, y1 = a[1] * i0 - bq[1] * i1;
        float ss = y0 * y0 + y1 * y1;
#pragma unroll
        for (int o = 1; o < 64; o <<= 1) ss += __shfl_xor(ss, o);
        const float rs = (1.0f - LAM_INIT) / sqrtf(ss * (1.0f / 128.0f) + EPS);
        bf16* orow = MIX + row * D + h * 128;
        orow[lane] = (bf16)f2bf(y0 * rs * gsub[lane]); orow[lane + 64] = (bf16)f2bf(y1 * rs * gsub[lane + 64]);
    }
    LGKM_BAR();
}
}

__device__ __forceinline__ void hgrn_step(int bs, int h, const bf16* RQ, const bf16* RK, const bf16* RV, const float* LOGF, const float* S0, float* Sout, bf16* OREC, ldsp_t lds) {
    int tid = threadIdx.x; asm volatile("" : "+v"(tid)); const size_t row = (size_t)MP + bs; const size_t g0 = row * RW + h * 128;
    LAS float* qs = (LAS float*)lds; LAS float* ks = qs + 128; LAS float* fs = qs + 256; LAS float* po = qs + 384;
    if (tid < 128) { qs[tid] = bf2f(RQ[g0 + tid]); ks[tid] = bf2f(RK[g0 + tid]); fs[tid] = fexpn(LOGF[g0 + tid]); }
    const int e = tid & 127, dq = tid >> 7;
    const float v = bf2f(RV[g0 + e]);
    LGKM_BAR();
    const size_t sb = ((size_t)(bs * 4 + h) * 128 + 32 * dq) * 128 + e;
    float acc = 0.f;
#pragma unroll 8
    for (int i = 0; i < 32; ++i) { const int dd = 32 * dq + i; const float sn = fs[dd] * S0[sb + (size_t)i * 128] + ks[dd] * v; Sout[sb + (size_t)i * 128] = sn; acc += qs[dd] * sn; }
    po[dq * 128 + e] = acc;
    LGKM_BAR();
    if (tid < 128) OREC[g0 + tid] = (bf16)f2bf((po[tid] + po[128 + tid]) + (po[256 + tid] + po[384 + tid]));
    LGKM_BAR();
}


template <int MODE, int N, int K, int KC>
__device__ __forceinline__ void samp_item(int item, const bf16* Abf, const float* xs, const float* C4, const float* C5, const float* C6, float* SS1, const bf16* Bt, float* C) {
    int tid = threadIdx.x; asm volatile("" : "+v"(tid));
    const int lane = tid & 63, wid = __builtin_amdgcn_readfirstlane(tid >> 6), r32 = lane & 31, hi = lane >> 5, rb = wid >> 1, cbk = wid & 1;
    constexpr int NCH = N / 64;
    const int nc = item % NCH, kc = item / NCH, n0 = nc * 64 + 32 * cbk, k0 = kc * KC, row = 32 * rb + r32;
    f32x16 acc = (f32x16){};
    float ssp = 0.f, r2 = 0.f;
    if (MODE == 7) r2 = 1.0f / (SS1[row] * (1.0f / D) + EPS);
    const bf16* bp = Bt + (size_t)(n0 + r32) * K + k0 + 8 * hi;
#pragma unroll 4
    for (int s = 0; s < KC / 16; ++s) {
        const int k8 = k0 + 16 * s + 8 * hi;
        bf16x8 a;
        if (MODE == 4) a = *(const bf16x8*)(Abf + (size_t)row * D + k8);
        else {
            f32x4 v0, v1;
            if (MODE == 6) { const float* p = C5 + (size_t)row * FF + k8; v0 = *(const f32x4*)p; v1 = *(const f32x4*)(p + 4);
#pragma unroll
                for (int j = 0; j < 4; ++j) { const float a0 = fmaxf(v0[j], 0.f), a1 = fmaxf(v1[j], 0.f); v0[j] = a0 * a0; v1[j] = a1 * a1; } }
            else { const size_t o = (size_t)row * D + k8; v0 = *(const f32x4*)(xs + o) + *(const f32x4*)(C4 + o); v1 = *(const f32x4*)(xs + o + 4) + *(const f32x4*)(C4 + o + 4);
                if (MODE == 5) ssp += (v0[0] * v0[0] + v0[1] * v0[1]) + (v0[2] * v0[2] + v0[3] * v0[3]) + (v1[0] * v1[0] + v1[1] * v1[1]) + (v1[2] * v1[2] + v1[3] * v1[3]);
                if (MODE == 7) { v0 = v0 + *(const f32x4*)(C6 + o) * r2; v1 = v1 + *(const f32x4*)(C6 + o + 4) * r2; } }
            v4u w; w.x = cvtpk(v0[0], v0[1]); w.y = cvtpk(v0[2], v0[3]); w.z = cvtpk(v1[0], v1[1]); w.w = cvtpk(v1[2], v1[3]); a = __builtin_bit_cast(bf16x8, w);
        }
        const bf16x8 b = *(const bf16x8*)(bp + 16 * s);
        acc = __builtin_amdgcn_mfma_f32_32x32x16_bf16(a, b, acc, 0, 0, 0);
    }
    float* cp = C + (size_t)(32 * rb) * N + n0 + r32;
#pragma unroll
    for (int r = 0; r < 16; ++r) unsafeAtomicAdd(cp + (size_t)crow(r, hi) * N, acc[r]);
    if (MODE == 5 && nc == 0 && cbk == 0) { ssp = swap_sum(ssp); if (hi == 0) unsafeAtomicAdd(SS1 + row, ssp); }
}

constexpr size_t MiB = 1u << 20;
constexpr size_t WS_CTL = 0, CTL_ZERO_BYTES = 1 * MiB;
constexpr size_t WS_WIN = 2 * MiB, WS_WOUT = 9 * MiB, WS_WUP = 11 * MiB, WS_WDN = 19 * MiB, WS_WG = 27 * MiB, WS_WP = 29 * MiB;
constexpr size_t WS_XN = 32 * MiB, WS_PB = 66 * MiB, WS_Q = 76 * MiB, WS_K = 93 * MiB, WS_V = 110 * MiB, WS_RQ = 127 * MiB, WS_RK = 144 * MiB, WS_RV = 161 * MiB, WS_RG = 178 * MiB;
constexpr size_t WS_LOGF = 195 * MiB, WS_OREC = 228 * MiB, WS_MIX = 245 * MiB, WS_X1 = 278 * MiB, WS_A2 = 343 * MiB, WS_A3 = 376 * MiB, WS_PJ = 409 * MiB, WS_H = 442 * MiB;
constexpr size_t WS_SSP1 = 572 * MiB, WS_SSP3 = 574 * MiB;
constexpr size_t WS_X2 = 582 * MiB;
constexpr size_t WS_SC4 = 576 * MiB, WS_SC5 = 577 * MiB, WS_SC6 = 579 * MiB, WS_SC7 = 580 * MiB, WS_SS1S = 581 * MiB, WS_SC_END = WS_SS1S + 4096, WS_END = 648 * MiB;
static_assert(WS_K - WS_Q == 17 * MiB && WS_V - WS_K == 17 * MiB && WS_RQ - WS_V == 17 * MiB && WS_RK - WS_RQ == 17 * MiB && WS_RV - WS_RK == 17 * MiB && WS_RG - WS_RV == 17 * MiB, "EpiIn buffer stride");
static_assert(WS_XN + (size_t)MT * D * 2 <= WS_PB && WS_PB + (size_t)MT * PLE * 2 <= WS_Q && WS_Q + (size_t)MT * AW * 2 <= WS_K && WS_LOGF + (size_t)MT * RW * 4 <= WS_OREC &&
              WS_MIX + (size_t)MT * D * 2 <= WS_X1 && WS_X1 + (size_t)MT * D * 4 <= WS_A2 && WS_PJ + (size_t)MT * D * 2 <= WS_H && WS_H + (size_t)MT * FF * 2 <= WS_SSP1 && WS_SSP1 + (size_t)MT * 64 <= WS_SSP3, "d_ws map");
constexpr int CW_QA = 64, CW_QD = 128;
constexpr int CW_BAR = 4096;
static_assert((CW_BAR + XCD_BAR_WORDS) * 4 <= (int)CTL_ZERO_BYTES, "CTL words inside the memset region");

constexpr int RING_OFF = 0, RING_BYTES = 131072;
constexpr int LDSCTL_OFF = RING_BYTES, MISC_OFF = LDSCTL_OFF + 320;
constexpr int LDS_BYTES = 147456;
constexpr int NWAVES = 8;
constexpr int N_PHASES = 9;
#ifndef DEC_FIRST_FROM
#define DEC_FIRST_FROM 128
#endif

struct Frame {
    LAS unsigned char* lds; volatile LAS unsigned* MISC; gu32* ctl;
    int tid, lane, wave, vcu, G;
};

__device__ __forceinline__ float wave_sum(float v) {
#pragma unroll
    for (int o = 1; o < 64; o <<= 1) v += __shfl_xor(v, o);
    return v;
}
__device__ __forceinline__ void p0_transpose_item(const float* W, int K, int N, bf16* WT, const float* kscale, LAS float* scr, int item, int lane) {
    const int nblk = N / 32, kb = item / nblk, nb = item % nblk, k0 = 64 * kb, n0 = 32 * nb;
#pragma unroll 8
    for (int i = 0; i < 32; ++i) { const int kk = 2 * i + (lane >> 5); float w = W[(size_t)(k0 + kk) * N + n0 + (lane & 31)]; if (kscale) w *= kscale[k0 + kk]; scr[kk * 33 + (lane & 31)] = w; }
    LDS_WAIT(); asm volatile("" ::: "memory");
    const int c = lane & 7;
#pragma unroll
    for (int j = 0; j < 4; ++j) { const int n = (lane >> 3) + 8 * j; const LAS float* s = scr + (8 * c) * 33 + n;
        v4u o; o.x = pk2(s[0 * 33], s[1 * 33]); o.y = pk2(s[2 * 33], s[3 * 33]); o.z = pk2(s[4 * 33], s[5 * 33]); o.w = pk2(s[6 * 33], s[7 * 33]);
        *(GAS v4u*)(WT + (size_t)(n0 + n) * K + k0 + 8 * c) = o; }
    LDS_WAIT(); asm volatile("" ::: "memory");
}
__device__ __forceinline__ void rms_row_to_bf16(const float* xrow, const float* g, bf16* orow, int lane) {
    const f32x4* xr = (const f32x4*)xrow + lane; const f32x4* gr = (const f32x4*)g + lane;
    f32x4 v[4]; float s = 0.f;
#pragma unroll
    for (int j = 0; j < 4; ++j) { v[j] = xr[64 * j]; s += (v[j].x * v[j].x + v[j].y * v[j].y) + (v[j].z * v[j].z + v[j].w * v[j].w); }
    const float r = 1.0f / sqrtf(wave_sum(s) * (1.f / D) + EPS);
    unsigned long long* o8 = (unsigned long long*)orow + lane;
#pragma unroll
    for (int j = 0; j < 4; ++j) { const f32x4 gg = gr[64 * j]; o8[64 * j] = (unsigned long long)pk2(v[j].x * r * gg.x, v[j].y * r * gg.y) | ((unsigned long long)pk2(v[j].z * r * gg.z, v[j].w * r * gg.w) << 32); }
}


struct Args { const float* in[24]; float* out; unsigned char* ws; int ph_lo, ph_hi, li, pad; };

#define x_prompt (args.in[0])
#define x_sample (args.in[1])
#define cache_k (args.in[2])
#define cache_v (args.in[3])
#define state0 (args.in[4])
#define ptab ((const int*)args.in[5])
#define p_prompt (args.in[6])
#define p_sample (args.in[7])
#define w_in (args.in[8])
#define g_subln (args.in[13])
#define hgrn_lb (args.in[14])
#define g_rec (args.in[15])
#define w_out (args.in[16])
#define g_mix (args.in[17])
#define g_ffn (args.in[18])
#define w_up (args.in[19])
#define w_down (args.in[20])
#define w_gate (args.in[21])
#define w_proj (args.in[22])
#define g_final (args.in[23])
#define OUTP (args.out)
#define WSP(T, off) ((T*)(args.ws + (off)))
#define WinT WSP(bf16, WS_WIN)
#define WoutT WSP(bf16, WS_WOUT)
#define WupT WSP(bf16, WS_WUP)
#define WdnT WSP(bf16, WS_WDN)
#define WgT WSP(bf16, WS_WG)
#define WpT WSP(bf16, WS_WP)
#define XN WSP(bf16, WS_XN)
#define PB WSP(bf16, WS_PB)
#define Qb WSP(bf16, WS_Q)
#define Kb WSP(bf16, WS_K)
#define Vb WSP(bf16, WS_V)
#define RQ WSP(bf16, WS_RQ)
#define RK WSP(bf16, WS_RK)
#define RV WSP(bf16, WS_RV)
#define RG WSP(bf16, WS_RG)
#define LOGF WSP(float, WS_LOGF)
#define OREC WSP(bf16, WS_OREC)
#define MIX WSP(bf16, WS_MIX)
#define X1 WSP(float, WS_X1)
#define A2 WSP(bf16, WS_A2)
#define A3 WSP(bf16, WS_A3)
#define PJ WSP(bf16, WS_PJ)
#define HB WSP(bf16, WS_H)
#define SSP1 WSP(float, WS_SSP1)
#define SSP3 WSP(float, WS_SSP3)
#define SC4 WSP(float, WS_SC4)
#define X2 WSP(float, WS_X2)
#define SC5 WSP(float, WS_SC5)
#define SC6 WSP(float, WS_SC6)
#define SC7 WSP(float, WS_SC7)
#define SS1S WSP(float, WS_SS1S)

__global__ void __launch_bounds__(NWAVES * 64, 2) mk_fwd(Args args) {
    extern __shared__ __attribute__((aligned(16))) unsigned char lds_raw[];
    Frame F;
    F.lds = (LAS unsigned char*)lds_raw;
    F.MISC = (volatile LAS unsigned*)(F.lds + MISC_OFF);
    F.tid = threadIdx.x; F.lane = F.tid & 63; F.wave = __builtin_amdgcn_readfirstlane(F.tid >> 6);
    F.G = gridDim.x; { const int bx = blockIdx.x; F.vcu = (F.G % 8 == 0) ? (bx % 8) * (F.G / 8) + bx / 8 : bx; }
    F.ctl = (gu32*)(args.ws + WS_CTL);
    for (int u = F.tid; u < (LDS_BYTES - LDSCTL_OFF) / 4; u += NWAVES * 64) ((LAS unsigned*)(F.lds + LDSCTL_OFF))[u] = 0u;
    __syncthreads();
    if (F.wave == 0) {
        const float a = args.in[9][F.lane] * args.in[10][F.lane], b = args.in[11][F.lane] * args.in[12][F.lane];
        const float lam = fexpn(wave_sum(a)) - fexpn(wave_sum(b)) + LAM_INIT;
        if (F.lane == 0) F.MISC[4] = __float_as_uint(lam);
    }
    XcdBarrier bar; bar.bar = (unsigned*)(F.ctl + CW_BAR); bar.x = 0; bar.st = nullptr;
    if (MK_N_LAUNCHES == 1) bar = xcd_barrier_post((unsigned*)(F.ctl + CW_BAR), F.MISC + 8);
    __syncthreads();
#define GRID_BAR() do { if (MK_N_LAUNCHES == 1) xcd_barrier(bar); } while (0)
    const int lo = args.ph_lo, hi = args.ph_hi;
#ifndef PH_MASK
#define PH_MASK 0x1ff
#endif
#ifndef PROBE_REP
#define PROBE_REP -1
#endif
#ifndef PROBE_MASK
#define PROBE_MASK 0
#endif
#define REPN(k) (((PROBE_REP) == (k) || (((PROBE_MASK) >> ((k) >= 20 ? (k) - 8 : (k))) & 1)) ? 2 : 1)
#define IN(k) ((((PH_MASK) >> (k)) & 1) && lo <= (k) && (k) < hi)
#define BOTH(k) (IN(k) && IN((k) + 1))
    const int gw = F.vcu * NWAVES + F.wave, NGW = F.G * NWAVES;

    if (IN(0)) {
        int tl_ = threadIdx.x; asm volatile("" : "+v"(tl_)); const int lane = tl_ & 63;
        LAS float* scr = (LAS float*)(F.lds + RING_OFF + F.wave * 16384);
        constexpr int I_IN = (D / 64) * (NIN / 32), I_O = (D / 64) * (D / 32), I_UP = (D / 64) * (FF / 32), I_DN = (FF / 64) * (D / 32), I_G = I_O, I_P = (PLE / 64) * (D / 32);
        constexpr int NITEMS = I_IN + I_O + I_UP + I_DN + I_G + I_P;
        _Pragma("unroll") for (int rep_ = 0; rep_ < REPN(0); ++rep_) {
        for (int it = gw; it < NITEMS; it += NGW) {
            int r = it;
            if (r < I_IN) { p0_transpose_item(w_in, D, NIN, WinT, nullptr, scr, r, lane); continue; } r -= I_IN;
            if (r < I_O) { p0_transpose_item(w_out, D, D, WoutT, nullptr, scr, r, lane); continue; } r -= I_O;
            if (r < I_UP) { p0_transpose_item(w_up, D, FF, WupT, g_ffn, scr, r, lane); continue; } r -= I_UP;
            if (r < I_DN) { p0_transpose_item(w_down, FF, D, WdnT, nullptr, scr, r, lane); continue; } r -= I_DN;
            if (r < I_G) { p0_transpose_item(w_gate, D, D, WgT, nullptr, scr, r, lane); continue; } r -= I_G;
            p0_transpose_item(w_proj, PLE, D, WpT, nullptr, scr, r, lane);
        }
        for (int m = gw; m < MT; m += NGW) {
            if (m < MP + MS) {
                const float* xr = m < MP ? x_prompt + (size_t)m * D : x_sample + (size_t)(m - MP) * D;
                rms_row_to_bf16(xr, g_mix, XN + (size_t)m * D, lane);
                const float* pr = m < MP ? p_prompt + (size_t)m * PLE : p_sample + (size_t)(m - MP) * PLE;
                const f32x4 pv = ((const f32x4*)pr)[lane];
                ((unsigned long long*)(PB + (size_t)m * PLE))[lane] = (unsigned long long)pk2(pv.x, pv.y) | ((unsigned long long)pk2(pv.z, pv.w) << 32);
            } else {
                unsigned long long* o8 = (unsigned long long*)(XN + (size_t)m * D) + lane;
#pragma unroll
                for (int j = 0; j < 4; ++j) o8[64 * j] = 0ull;
                ((unsigned long long*)(PB + (size_t)m * PLE))[lane] = 0ull;
            }
        }
        }
        { v4u* z = (v4u*)(args.ws + WS_SC4); const size_t nz = (WS_SC_END - WS_SC4) / 16;
          for (size_t i = (size_t)blockIdx.x * (NWAVES * 64) + tl_; i < nz; i += (size_t)F.G * (NWAVES * 64)) z[i] = (v4u){0u, 0u, 0u, 0u}; }
        if (BOTH(0)) GRID_BAR();
    }

    if (IN(1)) {
        { pg8::Gemm g{XN, WinT, MT, NIN, D}; pg8::StaticOrder S; S.init(MT, NIN, F.G, (int)blockIdx.x);
          pg8::EpiIn E{Qb, LOGF, OUTP, hgrn_lb};
          _Pragma("unroll") for (int rep_ = 0; rep_ < REPN(10); ++rep_) pg8::gemm_phase<pg8::EpiIn, pg8::StaticOrder, true, true>(F.lds + RING_OFF, g, S, E); }
        { pg8::Gemm g{PB, WpT, MT, D, PLE}; pg8::StaticOrder S; S.init(MT, D, F.G, (int)(F.G - 1 - blockIdx.x));
          pg8::EpiBf E{PJ, D};
          _Pragma("unroll") for (int rep_ = 0; rep_ < REPN(11); ++rep_) pg8::gemm_phase<pg8::EpiBf, pg8::StaticOrder, true, true>(F.lds + RING_OFF, g, S, E); }
        if (BOTH(1)) GRID_BAR();
    }

    if (IN(2)) {
        const float lam = __uint_as_float(F.MISC[4]);
#ifndef SKIP_DEC
        if ((int)blockIdx.x >= DEC_FIRST_FROM) for (;;) {
            if (F.tid == 0) F.MISC[1] = __hip_atomic_fetch_add(F.ctl + CW_QD, 1u, RLX_AGENT);
            LGKM_BAR();
            const int idx = (int)F.MISC[1];
            if (idx >= 512) break;
            dec::unit(idx >> 2, idx & 3, Qb, Kb, Vb, cache_k, cache_v, ptab, MIX, lam, g_subln, F.lds + RING_OFF);
        }
#endif
#ifndef SKIP_HG
        _Pragma("unroll") for (int rep_ = 0; rep_ < REPN(20); ++rep_) if (blockIdx.x < 32) hg::unit((int)blockIdx.x, RQ, RK, RV, LOGF, OREC, OUTP + OUT_SP, F.lds + RING_OFF);
#endif
#ifndef SKIP_ATT
        _Pragma("unroll") for (int rep_ = 0; rep_ < REPN(21); ++rep_) for (;;) {
            if (F.tid == 0) F.MISC[0] = __hip_atomic_fetch_add(F.ctl + CW_QA + 256 * rep_, 1u, RLX_AGENT);
            LGKM_BAR();
            const int idx = (int)F.MISC[0];
            if (idx >= 512) break;
            const int qblk = 15 - (idx >> 5), bh = idx & 31;
            att::unit(bh >> 2, bh & 3, qblk, Qb, Kb, Vb, MIX, lam, g_subln, F.lds + RING_OFF);
        }
#endif
#ifndef SKIP_DEC
        _Pragma("unroll") for (int rep_ = 0; rep_ < REPN(22); ++rep_) for (;;) {
            if (F.tid == 0) F.MISC[1] = __hip_atomic_fetch_add(F.ctl + CW_QD + 256 * rep_, 1u, RLX_AGENT);
            LGKM_BAR();
            const int idx = (int)F.MISC[1];
            if (idx >= 512) break;
            dec::unit(idx >> 2, idx & 3, Qb, Kb, Vb, cache_k, cache_v, ptab, MIX, lam, g_subln, F.lds + RING_OFF);
        }
#endif
        _Pragma("unroll") for (int rep_ = 0; rep_ < REPN(23); ++rep_) for (int it = F.vcu; it < 512; it += F.G) hgrn_step(it >> 2, it & 3, RQ, RK, RV, LOGF, state0, OUTP + OUT_SS, OREC, F.lds + RING_OFF);
        if (BOTH(2)) GRID_BAR();
    }

    if (IN(3)) {
        int tl_ = threadIdx.x; asm volatile("" : "+v"(tl_)); const int lane = tl_ & 63;
        _Pragma("unroll") for (int rep_ = 0; rep_ < REPN(3); ++rep_) for (int m = gw; m < MP + MS; m += NGW) {
            const v4u ow = ((const v4u*)(OREC + (size_t)m * RW))[lane]; const v4u gw4 = ((const v4u*)(RG + (size_t)m * RW))[lane];
            float o[8] = {bflo(ow.x), bfhi(ow.x), bflo(ow.y), bfhi(ow.y), bflo(ow.z), bfhi(ow.z), bflo(ow.w), bfhi(ow.w)};
            const float gt[8] = {bflo(gw4.x), bfhi(gw4.x), bflo(gw4.y), bfhi(gw4.y), bflo(gw4.z), bfhi(gw4.z), bflo(gw4.w), bfhi(gw4.w)};
            float s = 0.f;
#pragma unroll
            for (int j = 0; j < 8; ++j) s += o[j] * o[j];
            const float r = 1.0f / sqrtf(wave_sum(s) * (1.f / RW) + EPS);
            const f32x4 g0 = ((const f32x4*)g_rec)[2 * lane], g1 = ((const f32x4*)g_rec)[2 * lane + 1];
            v4u w; w.x = pk2(o[0] * r * g0.x * gt[0], o[1] * r * g0.y * gt[1]); w.y = pk2(o[2] * r * g0.z * gt[2], o[3] * r * g0.w * gt[3]);
            w.z = pk2(o[4] * r * g1.x * gt[4], o[5] * r * g1.y * gt[5]); w.w = pk2(o[6] * r * g1.z * gt[6], o[7] * r * g1.w * gt[7]);
            ((v4u*)(MIX + (size_t)m * D + AW))[lane] = w;
        }
        if (BOTH(3)) GRID_BAR();
    }

    if (IN(4)) {
        pg8::Gemm g{MIX, WoutT, MP, D, D}; pg8::StaticOrder S; S.init(MP, D, F.G, (int)blockIdx.x);
        pg8::EpiOut E{x_prompt, x_sample, X1, A2, SSP1};
        _Pragma("unroll") for (int rep_ = 0; rep_ < REPN(4); ++rep_) pg8::gemm_phase<pg8::EpiOut, pg8::StaticOrder, true, true>(F.lds + RING_OFF, g, S, E);
        for (int it = blockIdx.x; it < 256; it += F.G) samp_item<4, D, D, 64>(it, MIX + (size_t)MP * D, nullptr, nullptr, nullptr, nullptr, nullptr, WoutT, SC4);
        if (BOTH(4)) GRID_BAR();
    }
    if (IN(5)) {
        pg8::Gemm g{A2, WupT, MP, FF, D}; pg8::StaticOrder S; S.init(MP, FF, F.G, (int)blockIdx.x);
        pg8::EpiUp E{HB, FF};
        _Pragma("unroll") for (int rep_ = 0; rep_ < REPN(5); ++rep_) pg8::gemm_phase<pg8::EpiUp, pg8::StaticOrder, true, true>(F.lds + RING_OFF, g, S, E);
        for (int it = blockIdx.x; it < 256; it += F.G) samp_item<5, FF, D, 256>(it, nullptr, x_sample, SC4, nullptr, nullptr, SS1S, WupT, SC5);
        if (BOTH(5)) GRID_BAR();
    }
    if (IN(6)) {
        pg8::Gemm g{HB, WdnT, MP, D, FF}; pg8::StaticOrder S; S.init(MP, D, F.G, (int)blockIdx.x);
        pg8::EpiDown E{X1, X2, A3, SSP1};
        _Pragma("unroll") for (int rep_ = 0; rep_ < REPN(6); ++rep_) pg8::gemm_phase<pg8::EpiDown, pg8::StaticOrder, true, true>(F.lds + RING_OFF, g, S, E);
        for (int it = blockIdx.x; it < 256; it += F.G) samp_item<6, D, FF, 256>(it, nullptr, nullptr, nullptr, SC5, nullptr, nullptr, WdnT, SC6);
        if (BOTH(6)) GRID_BAR();
    }
    if (IN(7)) {
        pg8::Gemm g{A3, WgT, MP, D, D}; pg8::StaticOrder S; S.init(MP, D, F.G, (int)blockIdx.x);
        pg8::EpiGate E{X2, PJ, X1, SSP3};
        _Pragma("unroll") for (int rep_ = 0; rep_ < REPN(7); ++rep_) pg8::gemm_phase<pg8::EpiGate, pg8::StaticOrder, true, true>(F.lds + RING_OFF, g, S, E);
        for (int it = blockIdx.x; it < 256; it += F.G) samp_item<7, D, D, 64>(it, nullptr, x_sample, SC4, nullptr, SC6, SS1S, WgT, SC7);
        if (BOTH(7)) GRID_BAR();
    }
    if (IN(8)) {
        int tl_ = threadIdx.x; asm volatile("" : "+v"(tl_)); const int lane = tl_ & 63;
        _Pragma("unroll") for (int rep_ = 0; rep_ < REPN(8); ++rep_) for (int m = gw; m < MP; m += NGW) {
            float* yr = OUTP + OUT_YP + (size_t)m * D; const f32x4* x4 = (const f32x4*)(X1 + (size_t)m * D) + lane;
            const f32x4* sp = (const f32x4*)(SSP3 + (size_t)m * 16);
            const f32x4 ps = (sp[0] + sp[1]) + (sp[2] + sp[3]);
            const float r = 1.0f / sqrtf(((ps.x + ps.y) + (ps.z + ps.w)) * (1.f / D) + EPS);
            f32x4* y4 = (f32x4*)yr + lane; const f32x4* g4 = (const f32x4*)g_final + lane;
#pragma unroll
            for (int j = 0; j < 4; ++j) { const f32x4 v = x4[64 * j], gg = g4[64 * j]; y4[64 * j] = v * r * gg; }
        }
        for (int sr = NGW - 1 - gw; sr < MS; sr += NGW) {
            const float r2 = 1.0f / (SS1S[sr] * (1.0f / D) + EPS);
            const f32x4* xs4 = (const f32x4*)(x_sample + (size_t)sr * D) + lane; const f32x4* c4 = (const f32x4*)(SC4 + (size_t)sr * D) + lane;
            const f32x4* c6 = (const f32x4*)(SC6 + (size_t)sr * D) + lane; const f32x4* c7 = (const f32x4*)(SC7 + (size_t)sr * D) + lane;
            const u32x2v* pj = (const u32x2v*)(PJ + (size_t)(MP + sr) * D) + lane;
            f32x4 v[4]; float s = 0.f;
#pragma unroll
            for (int j = 0; j < 4; ++j) { const f32x4 x2 = xs4[64 * j] + c4[64 * j] + c6[64 * j] * r2, gt = c7[64 * j]; const u32x2v pw = pj[64 * j];
                v[j].x = x2.x + pg8::sigmoidf_(gt.x) * bflo(pw.x); v[j].y = x2.y + pg8::sigmoidf_(gt.y) * bfhi(pw.x); v[j].z = x2.z + pg8::sigmoidf_(gt.z) * bflo(pw.y); v[j].w = x2.w + pg8::sigmoidf_(gt.w) * bfhi(pw.y);
                s += (v[j].x * v[j].x + v[j].y * v[j].y) + (v[j].z * v[j].z + v[j].w * v[j].w); }
            const float r = 1.0f / sqrtf(wave_sum(s) * (1.f / D) + EPS);
            f32x4* y4 = (f32x4*)(OUTP + OUT_YS + (size_t)sr * D) + lane; const f32x4* g4 = (const f32x4*)g_final + lane;
#pragma unroll
            for (int j = 0; j < 4; ++j) y4[64 * j] = v[j] * r * g4[64 * j];
        }
    }
#undef IN
#undef BOTH
#undef GRID_BAR
}

#undef x_prompt
#undef x_sample
#undef cache_k
#undef cache_v
#undef state0
#undef ptab
#undef p_prompt
#undef p_sample
#undef w_in
#undef g_subln
#undef hgrn_lb
#undef g_rec
#undef w_out
#undef g_mix
#undef g_ffn
#undef w_up
#undef w_down
#undef w_gate
#undef w_proj
#undef g_final
#undef OUTP
#undef WSP
#undef WinT
#undef WoutT
#undef WupT
#undef WdnT
#undef WgT
#undef WpT
#undef XN
#undef PB
#undef Qb
#undef Kb
#undef Vb
#undef RQ
#undef RK
#undef RV
#undef RG
#undef LOGF
#undef OREC
#undef MIX
#undef X1
#undef A2
#undef A3
#undef PJ
#undef HB
#undef SSP1
#undef SSP3
#undef SC4
#undef X2
#undef SC5
#undef SC6
#undef SC7
#undef SS1S
extern "C" void kernel_launch(void* const* d_in, const int* in_sizes, int n_in, void* d_out, int out_size, void* d_ws, size_t ws_size, hipStream_t stream) {
    static int grid = 0;
    if (grid == 0) {
        if (n_in != 24 || in_sizes[0] != MP * D || (size_t)out_size != OUT_END || ws_size < WS_END) {
            fprintf(stderr, "kernel_launch: unexpected shapes: n_in %d, in0 %d, out %d, ws %zu; nothing launched\n", n_in, n_in > 0 ? in_sizes[0] : -1, out_size, ws_size); grid = -1; return; }
        int dev = 0, cus = 0, per_cu = 0;
        if (hipGetDevice(&dev) != hipSuccess || hipDeviceGetAttribute(&cus, hipDeviceAttributeMultiprocessorCount, dev) != hipSuccess) { grid = -1; return; }
        if (hipFuncSetAttribute((const void*)mk_fwd, hipFuncAttributeMaxDynamicSharedMemorySize, LDS_BYTES) != hipSuccess) { fprintf(stderr, "kernel_launch: hipFuncSetAttribute failed\n"); grid = -1; return; }
        if (hipOccupancyMaxActiveBlocksPerMultiprocessor(&per_cu, (const void*)mk_fwd, NWAVES * 64, LDS_BYTES) != hipSuccess || per_cu < 1) {
            fprintf(stderr, "kernel_launch: occupancy query reports %d workgroups per CU; nothing launched\n", per_cu); (void)hipGetLastError(); grid = -1; return; }
        (void)hipGetLastError();
        grid = cus;
    }
    if (grid < 0) return;
    if (hipMemsetAsync((char*)d_ws + WS_CTL, 0, CTL_ZERO_BYTES, stream) != hipSuccess) return;
    Args a{};
    for (int i = 0; i < 24; ++i) a.in[i] = (const float*)d_in[i];
    a.out = (float*)d_out; a.ws = (unsigned char*)d_ws;
    if (MK_N_LAUNCHES == 1) {
        a.ph_lo = 0; a.ph_hi = N_PHASES; a.li = 0;
        hipLaunchKernelGGL(mk_fwd, dim3(grid), dim3(NWAVES * 64), LDS_BYTES, stream, a);
    } else {
        for (int li = 0; li < N_PHASES; ++li) { a.ph_lo = li; a.ph_hi = li + 1; a.li = li; hipLaunchKernelGGL(mk_fwd, dim3(grid), dim3(NWAVES * 64), LDS_BYTES, stream, a); }
    }
}
```

```cpp
#include <hip/hip_runtime.h>
#include <hip/hip_bf16.h>
#include <cstdio>
#include <cstdint>
#include <cmath>

#ifndef MK_N_LAUNCHES
#define MK_N_LAUNCHES 1
#endif

constexpr int D = 1024, NB = 8, SEQ = 2048, MP = NB * SEQ, MS = 128, MT = 16640  ;
constexpr int NIN = 3584, FF = 4096, PLE = 256, AW = 512, RW = 512, NPAGES = 16, PAGE = 128;
constexpr float EPS = 1e-6f;
constexpr float LOG2E = 1.4426950408889634f;
constexpr float QSCALE = 0.125f * LOG2E;
constexpr float LAM_INIT = 0.2f;
constexpr size_t OUT_YP = 0, OUT_YS = OUT_YP + (size_t)MP * D, OUT_KP = OUT_YS + (size_t)MS * D, OUT_VP = OUT_KP + (size_t)MP * AW, OUT_SP = OUT_VP + (size_t)MP * AW,
                 OUT_KS = OUT_SP + (size_t)NB * 4 * 128 * 128, OUT_VS = OUT_KS + (size_t)MS * AW, OUT_SS = OUT_VS + (size_t)MS * AW, OUT_END = OUT_SS + (size_t)MS * 4 * 128 * 128;

namespace pg8 {
#define PG8_LAS __attribute__((address_space(3)))
typedef unsigned short bf16_t;
typedef short bf16x8 __attribute__((ext_vector_type(8)));
typedef float f32x4 __attribute__((ext_vector_type(4)));
typedef unsigned u32x4 __attribute__((ext_vector_type(4)));
typedef unsigned u32x2 __attribute__((ext_vector_type(2)));
constexpr int BM = 256, BK = 64, HALF = 128, HTB = HALF * BK * 2  , STAGE_BYTES = 8 * HTB, NXCD = 8, WGM = 8;

__host__ __device__ __forceinline__ int lds_byte(int r, int c) { const int st = (r >> 4) * 2 + (c >> 5), rr = r & 15, cc = c & 31, ob = rr * 64 + cc * 2; return st * 1024 + (ob ^ (((ob >> 9) & 1) << 5)); }
__host__ __device__ __forceinline__ void stage_rc(int b, int& R, int& C) { const int st = b / 1024, sb = b % 1024, swz = sb ^ (((sb >> 9) & 1) << 5); R = (st >> 1) * 16 + swz / 64; C = (st & 1) * 32 + (swz % 64) / 2; }
__host__ __device__ __forceinline__ int perm32(int rho) { const int n = rho >> 4, i = rho & 15; return 8 * (i >> 2) + 4 * n + (i & 3); }

struct Unit { int pm, pn; };
struct Gemm { const bf16_t* A; const bf16_t* Bt; int M, N, K; };

struct StaticOrder {
    int nM, nN, nwg, G, c;
    __host__ __device__ void init(int M, int N, int G_, int c_) { nM = M / BM; nN = N / BM; nwg = nM * nN; G = G_; c = c_; }
    __host__ __device__ bool next(int i, Unit& u) const {
        const long L = (long)i * G + c; if (L >= nwg) return false;
        int wgid = (int)L; { const int q = nwg / NXCD, r = nwg % NXCD, xcd = wgid % NXCD, off = wgid / NXCD; wgid = (xcd < r ? xcd * (q + 1) : r * (q + 1) + (xcd - r) * q) + off; }
        const int nig = WGM * nN, gid = wgid / nig, fm = gid * WGM, gsz = (nM - fm) < WGM ? (nM - fm) : WGM;
        u.pm = fm + ((wgid % nig) % gsz); u.pn = (wgid % nig) / gsz; return true;
    }
    __device__ __forceinline__ void a_ready(const Unit&) const {}
    __device__ __forceinline__ void done(const Unit&) const {}
};

__device__ __forceinline__ unsigned cvt_pk_bf16(float lo, float hi) { unsigned r; asm volatile("v_cvt_pk_bf16_f32 %0, %1, %2" : "=v"(r) : "v"(lo), "v"(hi)); return r; }
__device__ __forceinline__ u32x4 pack8(const f32x4 v0, const f32x4 v1) { u32x4 w; w.x = cvt_pk_bf16(v0[0], v0[1]); w.y = cvt_pk_bf16(v0[2], v0[3]); w.z = cvt_pk_bf16(v1[0], v1[1]); w.w = cvt_pk_bf16(v1[2], v1[3]); return w; }
__device__ __forceinline__ float fexp(float x) { return __builtin_amdgcn_exp2f(x * 1.4426950408889634f); }
__device__ __forceinline__ float frcp(float x) { return __builtin_amdgcn_rcpf(x); }
__device__ __forceinline__ float sigmoidf_(float x) { return frcp(1.0f + fexp(-x)); }
__device__ __forceinline__ float siluf_(float x) { return x * sigmoidf_(x); }
__device__ __forceinline__ f32x4 map4_silu(f32x4 v) { return (f32x4){siluf_(v[0]), siluf_(v[1]), siluf_(v[2]), siluf_(v[3])}; }

struct EpiIn {
    static constexpr bool PERM = true, AFTER_DRAIN = false;
    bf16_t* Q0; float* LOGF; float* out; const float* hlb;
    static constexpr size_t BUFSTRIDE = (size_t)17 * 1024 * 1024 / 2;
    __device__ __forceinline__ void operator()(const f32x4 (&acc)[2][2][4][2], const Unit& u, int wr, int wc, int fr, int fq) const {
        const int type = u.pn >> 1;
        const int cb = (u.pn & 1) * 256 + wc * 32 + 8 * fq;
        const int row0 = u.pm * BM + wr * 64 + fr;
        const bool prow = u.pm < 64;
        if (type == 0 || type == 3 || type == 5 || type == 6) {
            bf16_t* base = Q0 + (size_t)type * BUFSTRIDE;
#pragma unroll
            for (int ai = 0; ai < 2; ++ai)
#pragma unroll
                for (int m = 0; m < 4; ++m) { bf16_t* rowp = base + (size_t)(row0 + ai * HALF + m * 16) * 512 + cb;
#pragma unroll
                    for (int bj = 0; bj < 2; ++bj) { f32x4 v0 = acc[ai][bj][m][0], v1 = acc[ai][bj][m][1];
                        if (type == 0) { v0 = v0 * QSCALE; v1 = v1 * QSCALE; }
                        else if (type != 5) { v0 = map4_silu(v0); v1 = map4_silu(v1); }
                        *(u32x4*)(rowp + bj * HALF) = pack8(v0, v1); } }
        } else if (type == 1 || type == 2) {
            bf16_t* base = Q0 + (size_t)type * BUFSTRIDE;
            float* ob = out + (type == 1 ? (prow ? OUT_KP : OUT_KS) : (prow ? OUT_VP : OUT_VS));
#pragma unroll
            for (int ai = 0; ai < 2; ++ai)
#pragma unroll
                for (int m = 0; m < 4; ++m) { const int row = row0 + ai * HALF + m * 16; bf16_t* rowp = base + (size_t)row * 512 + cb;
                    const bool ok = prow || ai == 0; float* orow = ob + (size_t)(prow ? row : row - MP) * 512 + cb;
#pragma unroll
                    for (int bj = 0; bj < 2; ++bj) { const f32x4 v0 = acc[ai][bj][m][0], v1 = acc[ai][bj][m][1];
                        *(u32x4*)(rowp + bj * HALF) = pack8(v0, v1);
                        if (ok) { *(f32x4*)(orow + bj * HALF) = v0; *(f32x4*)(orow + bj * HALF + 4) = v1; } } }
        } else {
#pragma unroll
            for (int bj = 0; bj < 2; ++bj) {
                f32x4 lb[2];
#pragma unroll
                for (int n = 0; n < 2; ++n) { const f32x4 l0 = *(const f32x4*)(hlb + cb + bj * HALF + 4 * n), l1 = *(const f32x4*)(hlb + 512 + cb + bj * HALF + 4 * n);
#pragma unroll
                    for (int j = 0; j < 4; ++j) lb[n][j] = frcp(1.0f + fexp(l1[j] - l0[j])); }
#pragma unroll
                for (int ai = 0; ai < 2; ++ai)
#pragma unroll
                    for (int m = 0; m < 4; ++m) { const size_t ro = (size_t)(row0 + ai * HALF + m * 16) * 512 + cb + bj * HALF; f32x4 lf[2], kk[2];
#pragma unroll
                        for (int n = 0; n < 2; ++n)
#pragma unroll
                            for (int j = 0; j < 4; ++j) { const float x = acc[ai][bj][m][n][j], e = fexp(-x), sg = frcp(1.0f + e), l = lb[n][j];
                                const float f = l + (1.0f - l) * sg; lf[n][j] = __builtin_amdgcn_logf(f) * 0.6931471805599453f; kk[n][j] = (1.0f - l) * (e * sg); }
                        *(f32x4*)(LOGF + ro) = lf[0]; *(f32x4*)(LOGF + ro + 4) = lf[1];
                        *(u32x4*)(Q0 + 4 * BUFSTRIDE + ro) = pack8(kk[0], kk[1]); }
            }
        }
    }
};

struct EpiBf {
    static constexpr bool PERM = true, AFTER_DRAIN = false;
    bf16_t* O; int ldc;
    __device__ __forceinline__ void operator()(const f32x4 (&acc)[2][2][4][2], const Unit& u, int wr, int wc, int fr, int fq) const {
        const int row0 = u.pm * BM + wr * 64 + fr, col0 = u.pn * BM + wc * 32 + 8 * fq;
#pragma unroll
        for (int ai = 0; ai < 2; ++ai)
#pragma unroll
            for (int m = 0; m < 4; ++m) { bf16_t* rowp = O + (size_t)(row0 + ai * HALF + m * 16) * ldc + col0;
#pragma unroll
                for (int bj = 0; bj < 2; ++bj) *(u32x4*)(rowp + bj * HALF) = pack8(acc[ai][bj][m][0], acc[ai][bj][m][1]); }
    }
};
struct EpiUp {
    static constexpr bool PERM = true, AFTER_DRAIN = false;
    bf16_t* O; int ldc;
    __device__ __forceinline__ void operator()(const f32x4 (&acc)[2][2][4][2], const Unit& u, int wr, int wc, int fr, int fq) const {
        const int row0 = u.pm * BM + wr * 64 + fr, col0 = u.pn * BM + wc * 32 + 8 * fq;
#pragma unroll
        for (int ai = 0; ai < 2; ++ai)
#pragma unroll
            for (int m = 0; m < 4; ++m) { bf16_t* rowp = O + (size_t)(row0 + ai * HALF + m * 16) * ldc + col0;
#pragma unroll
                for (int bj = 0; bj < 2; ++bj) { f32x4 v0 = acc[ai][bj][m][0], v1 = acc[ai][bj][m][1];
#pragma unroll
                    for (int j = 0; j < 4; ++j) { const float a = fmaxf(v0[j], 0.f), b = fmaxf(v1[j], 0.f); v0[j] = a * a; v1[j] = b * b; }
                    *(u32x4*)(rowp + bj * HALF) = pack8(v0, v1); } }
    }
};
struct EpiOut {
    static constexpr bool PERM = true, AFTER_DRAIN = false;
    const float* xp; const float* xs; float* X1; bf16_t* A2; float* SSP;
    __device__ __forceinline__ void operator()(const f32x4 (&acc)[2][2][4][2], const Unit& u, int wr, int wc, int fr, int fq) const {
        const int row0 = u.pm * BM + wr * 64 + fr, col0 = u.pn * BM + wc * 32 + 8 * fq; const bool prow = u.pm < 64;
#pragma unroll
        for (int ai = 0; ai < 2; ++ai) { if (!prow && ai == 1) break;
#pragma unroll
            for (int m = 0; m < 4; ++m) { const int row = row0 + ai * HALF + m * 16; const float* xr = (prow ? xp + (size_t)row * D : xs + (size_t)(row - MP) * D) + col0;
                float s = 0.f;
#pragma unroll
                for (int bj = 0; bj < 2; ++bj) { const f32x4 a0 = *(const f32x4*)(xr + bj * HALF), a1 = *(const f32x4*)(xr + bj * HALF + 4);
                    const f32x4 v0 = a0 + acc[ai][bj][m][0], v1 = a1 + acc[ai][bj][m][1];
                    s += (v0[0] * v0[0] + v0[1] * v0[1]) + (v0[2] * v0[2] + v0[3] * v0[3]) + (v1[0] * v1[0] + v1[1] * v1[1]) + (v1[2] * v1[2] + v1[3] * v1[3]);
                    float* o = X1 + (size_t)row * D + col0 + bj * HALF; *(f32x4*)o = v0; *(f32x4*)(o + 4) = v1;
                    *(u32x4*)(A2 + (size_t)row * D + col0 + bj * HALF) = pack8(v0, v1); }
                s += __shfl_xor(s, 16); s += __shfl_xor(s, 32);
                if (fq == 0) SSP[(size_t)row * 16 + u.pn * 4 + wc] = s; } }
    }
};
struct EpiDown {
    static constexpr bool PERM = true, AFTER_DRAIN = false;
    const float* X1; float* X2; bf16_t* A3; const float* SSP;
    __device__ __forceinline__ void operator()(const f32x4 (&acc)[2][2][4][2], const Unit& u, int wr, int wc, int fr, int fq) const {
        const int row0 = u.pm * BM + wr * 64 + fr, col0 = u.pn * BM + wc * 32 + 8 * fq; const bool prow = u.pm < 64;
#pragma unroll
        for (int ai = 0; ai < 2; ++ai) { if (!prow && ai == 1) break;
#pragma unroll
            for (int m = 0; m < 4; ++m) { const int row = row0 + ai * HALF + m * 16;
                const f32x4 p0 = *(const f32x4*)(SSP + (size_t)row * 16), p1 = *(const f32x4*)(SSP + (size_t)row * 16 + 4), p2 = *(const f32x4*)(SSP + (size_t)row * 16 + 8), p3 = *(const f32x4*)(SSP + (size_t)row * 16 + 12);
                const f32x4 ps = (p0 + p1) + (p2 + p3); const float ss = (ps[0] + ps[1]) + (ps[2] + ps[3]);
                const float r2 = frcp(ss * (1.0f / D) + EPS);
#pragma unroll
                for (int bj = 0; bj < 2; ++bj) { const float* xi = X1 + (size_t)row * D + col0 + bj * HALF; float* o = X2 + (size_t)row * D + col0 + bj * HALF;
                    const f32x4 v0 = *(const f32x4*)xi + acc[ai][bj][m][0] * r2, v1 = *(const f32x4*)(xi + 4) + acc[ai][bj][m][1] * r2;
                    *(f32x4*)o = v0; *(f32x4*)(o + 4) = v1;
                    *(u32x4*)(A3 + (size_t)row * D + col0 + bj * HALF) = pack8(v0, v1); } } }
    }
};
struct EpiGate {
    static constexpr bool PERM = true, AFTER_DRAIN = false;
    const float* X1; const bf16_t* PJ; float* out; float* SSP;
    __device__ __forceinline__ void operator()(const f32x4 (&acc)[2][2][4][2], const Unit& u, int wr, int wc, int fr, int fq) const {
        const int row0 = u.pm * BM + wr * 64 + fr, col0 = u.pn * BM + wc * 32 + 8 * fq; const bool prow = u.pm < 64;
#pragma unroll
        for (int ai = 0; ai < 2; ++ai) { if (!prow && ai == 1) break;
#pragma unroll
            for (int m = 0; m < 4; ++m) { const int row = row0 + ai * HALF + m * 16; float* orow = out + (size_t)row * D + col0;
                float s = 0.f;
#pragma unroll
                for (int bj = 0; bj < 2; ++bj) { const float* xr = X1 + (size_t)row * D + col0 + bj * HALF; const f32x4 a0 = *(const f32x4*)xr, a1 = *(const f32x4*)(xr + 4);
                    const u32x4 pj = *(const u32x4*)(PJ + (size_t)row * D + col0 + bj * HALF);
                    f32x4 v0, v1;
#pragma unroll
                    for (int j = 0; j < 4; ++j) { const unsigned w0 = pj[j >> 1], w1 = pj[2 + (j >> 1)];
                        const float pa = __uint_as_float((j & 1) ? (w0 & 0xffff0000u) : (w0 << 16)), pb = __uint_as_float((j & 1) ? (w1 & 0xffff0000u) : (w1 << 16));
                        v0[j] = a0[j] + sigmoidf_(acc[ai][bj][m][0][j]) * pa; v1[j] = a1[j] + sigmoidf_(acc[ai][bj][m][1][j]) * pb; }
                    s += (v0[0] * v0[0] + v0[1] * v0[1]) + (v0[2] * v0[2] + v0[3] * v0[3]) + (v1[0] * v1[0] + v1[1] * v1[1]) + (v1[2] * v1[2] + v1[3] * v1[3]);
                    *(f32x4*)(orow + bj * HALF) = v0; *(f32x4*)(orow + bj * HALF + 4) = v1; }
                s += __shfl_xor(s, 16); s += __shfl_xor(s, 32);
                if (fq == 0) SSP[(size_t)row * 16 + u.pn * 4 + wc] = s; } }
    }
};

template <class Epi, class Sched, bool ALIGN_EPI = false, bool SP2 = false>
__device__ __forceinline__ void gemm_phase(PG8_LAS unsigned char* lds, const Gemm g, const Sched& S, const Epi& E) {
    const int tid = threadIdx.x, wid = __builtin_amdgcn_readfirstlane(tid >> 6), lane = tid & 63, wr = wid >> 2, wc = wid & 3, fr = lane & 15, fq = lane >> 4;
    const int K = g.K, nt = K / BK;
    unsigned voffA[2], voffB[2];
#pragma unroll
    for (int i = 0; i < 2; ++i) { int R, C; stage_rc(tid * 16 + i * 8192, R, C); const int Rb = Epi::PERM ? ((R & ~31) + perm32(R & 31)) : R;
        voffA[i] = (unsigned)(R * K + C) * 2u; voffB[i] = (unsigned)(Rb * K + C) * 2u; }
    const size_t kstep = (size_t)(BK * 2);
    const size_t hstep = (size_t)HALF * K * 2;
    const size_t tstep = 2 * hstep;
    const unsigned ldsw = (unsigned)wid * 1024u;
    const int aoff = lds_byte(wr * 64 + fr, fq * 8), boff = lds_byte(wc * 32 + fr, fq * 8);
#define PG8_SA(b, h) (((b) * 2 + (h)) * HTB)
#define PG8_SB(b, h) ((4 + (b) * 2 + (h)) * HTB)
#define PG8_STAGE(bufoff, gbase, voff) do { _Pragma("unroll") for (int _i = 0; _i < 2; ++_i) \
        __builtin_amdgcn_global_load_lds((const unsigned*)((const char*)(gbase) + (voff)[_i]), (PG8_LAS unsigned*)(lds + (bufoff) + ldsw + _i * 8192), 16, 0, 0); } while (0)
#define PG8_LDA(dst, b, h) do { _Pragma("unroll") for (int m = 0; m < 4; ++m) _Pragma("unroll") for (int k = 0; k < 2; ++k) dst[m][k] = *(const PG8_LAS bf16x8*)(lds + PG8_SA(b, h) + aoff + m * 2048 + k * 1024); } while (0)
#define PG8_LDB(dst, b, h) do { _Pragma("unroll") for (int n = 0; n < 2; ++n) _Pragma("unroll") for (int k = 0; k < 2; ++k) dst[n][k] = *(const PG8_LAS bf16x8*)(lds + PG8_SB(b, h) + boff + n * 2048 + k * 1024); } while (0)
#define PG8_MMA(ai, bj, At, Bt) do { __builtin_amdgcn_s_setprio(1); _Pragma("unroll") for (int m = 0; m < 4; ++m) _Pragma("unroll") for (int n = 0; n < 2; ++n) _Pragma("unroll") for (int k = 0; k < 2; ++k) \
        acc[ai][bj][m][n] = __builtin_amdgcn_mfma_f32_16x16x32_bf16(Bt[n][k], At[m][k], acc[ai][bj][m][n], 0, 0, 0); __builtin_amdgcn_s_setprio(0); } while (0)
#define PG8_WAIT_V(n) asm volatile("s_waitcnt vmcnt(" #n ")" ::: "memory")
#define PG8_WAIT_L(n) asm volatile("s_waitcnt lgkmcnt(" #n ")" ::: "memory")
#define PG8_BAR __builtin_amdgcn_s_barrier()
#define PG8_SCHED __builtin_amdgcn_sched_barrier(0)
    Unit cur, nxt; int ui = 0;
    if (!S.next(0, cur)) return;
    f32x4 acc[2][2][4][2];
#pragma unroll
    for (int a = 0; a < 2; ++a)
#pragma unroll
        for (int b = 0; b < 2; ++b)
#pragma unroll
            for (int m = 0; m < 4; ++m)
#pragma unroll
                for (int n = 0; n < 2; ++n) acc[a][b][m][n] = (f32x4){0.f, 0.f, 0.f, 0.f};
    bf16x8 At[4][2], B0[2][2], B1[2][2];
    const char* cA = (const char*)g.A + (size_t)cur.pm * tstep; const char* cB = (const char*)g.Bt + (size_t)cur.pn * tstep;
    S.a_ready(cur);
    if constexpr (SP2) {
        PG8_STAGE(PG8_SB(0, 0), cB, voffB); PG8_STAGE(PG8_SB(0, 1), cB + hstep, voffB); PG8_STAGE(PG8_SA(0, 0), cA, voffA); PG8_STAGE(PG8_SA(0, 1), cA + hstep, voffA);
        if (wr == 1) PG8_BAR;
        PG8_WAIT_V(2); PG8_BAR;
        PG8_STAGE(PG8_SB(1, 0), cB + kstep, voffB); PG8_STAGE(PG8_SA(1, 0), cA + kstep, voffA); PG8_STAGE(PG8_SB(1, 1), cB + hstep + kstep, voffB);
        PG8_WAIT_V(6); PG8_BAR;
    } else {
        PG8_STAGE(PG8_SB(0, 0), cB, voffB); PG8_STAGE(PG8_SA(0, 0), cA, voffA); PG8_STAGE(PG8_SB(0, 1), cB + hstep, voffB); PG8_STAGE(PG8_SA(0, 1), cA + hstep, voffA);
        if (wr == 1) PG8_BAR;
        PG8_WAIT_V(4); PG8_BAR;
        PG8_STAGE(PG8_SB(1, 0), cB + kstep, voffB); PG8_STAGE(PG8_SA(1, 0), cA + kstep, voffA); PG8_STAGE(PG8_SB(1, 1), cB + hstep + kstep, voffB);
        PG8_WAIT_V(6); PG8_BAR;
    }
    for (;;) {
        const bool has_next = S.next(ui + 1, nxt);
        const char* nA = has_next ? (const char*)g.A + (size_t)nxt.pm * tstep : cA; const char* nB = has_next ? (const char*)g.Bt + (size_t)nxt.pn * tstep : cB;
        for (int t = 0; t < nt; t += 2) {
            const bool last = (t == nt - 2);
            const char* a1 = cA + (size_t)(t + 1) * kstep;
            const char* a2 = last ? nA : cA + (size_t)(t + 2) * kstep; const char* b2 = last ? nB : cB + (size_t)(t + 2) * kstep;
            const char* a3 = a2 + kstep; const char* b3 = b2 + kstep;
            if (last && has_next) S.a_ready(nxt);
            if constexpr (SP2) {
            PG8_LDB(B0, 0, 0); PG8_LDB(B1, 0, 1); PG8_SCHED; PG8_LDA(At, 0, 0); PG8_STAGE(PG8_SA(1, 1), a1 + hstep, voffA);
            PG8_WAIT_V(8); PG8_WAIT_L(0); PG8_BAR; PG8_MMA(0, 0, At, B0); PG8_MMA(0, 1, At, B1); PG8_BAR; PG8_SCHED;
            PG8_LDA(At, 0, 1); PG8_STAGE(PG8_SB(0, 0), b2, voffB); PG8_STAGE(PG8_SB(0, 1), b2 + hstep, voffB); PG8_STAGE(PG8_SA(0, 0), a2, voffA);
            PG8_WAIT_V(8); PG8_WAIT_L(0); PG8_BAR; PG8_MMA(1, 0, At, B0); PG8_MMA(1, 1, At, B1); PG8_BAR; PG8_SCHED;
            PG8_LDB(B0, 1, 0); PG8_LDB(B1, 1, 1); PG8_SCHED; PG8_LDA(At, 1, 0); PG8_STAGE(PG8_SA(0, 1), a2 + hstep, voffA);
            PG8_WAIT_V(8); PG8_WAIT_L(0); PG8_BAR; PG8_MMA(0, 0, At, B0); PG8_MMA(0, 1, At, B1); PG8_BAR; PG8_SCHED;
            PG8_LDA(At, 1, 1); PG8_STAGE(PG8_SB(1, 0), b3, voffB); PG8_STAGE(PG8_SB(1, 1), b3 + hstep, voffB); PG8_STAGE(PG8_SA(1, 0), a3, voffA);
            PG8_WAIT_V(8); PG8_WAIT_L(0); PG8_BAR; PG8_MMA(1, 0, At, B0); PG8_MMA(1, 1, At, B1); PG8_BAR; PG8_SCHED;
            } else {
            PG8_LDB(B0, 0, 0); PG8_SCHED; PG8_LDA(At, 0, 0); PG8_STAGE(PG8_SA(1, 1), a1 + hstep, voffA);
            PG8_WAIT_L(8); PG8_BAR; PG8_WAIT_L(0); PG8_MMA(0, 0, At, B0); PG8_BAR; PG8_SCHED;
            PG8_LDB(B1, 0, 1); PG8_STAGE(PG8_SB(0, 0), b2, voffB);
            PG8_BAR; PG8_WAIT_L(0); PG8_MMA(0, 1, At, B1); PG8_BAR;
            PG8_LDA(At, 0, 1); PG8_STAGE(PG8_SA(0, 0), a2, voffA);
            PG8_BAR; PG8_WAIT_L(0); PG8_MMA(1, 0, At, B0); PG8_BAR; PG8_SCHED;
            PG8_STAGE(PG8_SB(0, 1), b2 + hstep, voffB);
            PG8_WAIT_V(6); PG8_BAR; PG8_MMA(1, 1, At, B1); PG8_BAR;
            PG8_LDB(B0, 1, 0); PG8_SCHED; PG8_LDA(At, 1, 0); PG8_STAGE(PG8_SA(0, 1), a2 + hstep, voffA);
            PG8_WAIT_L(8); PG8_BAR; PG8_WAIT_L(0); PG8_MMA(0, 0, At, B0); PG8_BAR; PG8_SCHED;
            PG8_LDB(B1, 1, 1); PG8_STAGE(PG8_SB(1, 0), b3, voffB);
            PG8_BAR; PG8_WAIT_L(0); PG8_MMA(0, 1, At, B1); PG8_BAR;
            PG8_LDA(At, 1, 1); PG8_STAGE(PG8_SA(1, 0), a3, voffA);
            PG8_BAR; PG8_WAIT_L(0); PG8_MMA(1, 0, At, B0); PG8_BAR; PG8_SCHED;
            PG8_STAGE(PG8_SB(1, 1), b3 + hstep, voffB);
            PG8_WAIT_V(6); PG8_BAR; PG8_MMA(1, 1, At, B1); PG8_BAR;
            }
        }
        if constexpr (ALIGN_EPI) { if (wr == 0) PG8_BAR; }
        if constexpr (!Epi::AFTER_DRAIN) { E(acc, cur, wr, wc, fr, fq); S.done(cur); }
        if (!has_next) break;
#pragma unroll
        for (int a = 0; a < 2; ++a)
#pragma unroll
            for (int b = 0; b < 2; ++b)
#pragma unroll
                for (int m = 0; m < 4; ++m)
#pragma unroll
                    for (int n = 0; n < 2; ++n) acc[a][b][m][n] = (f32x4){0.f, 0.f, 0.f, 0.f};
        cur = nxt; cA = nA; cB = nB; ++ui;
        if constexpr (ALIGN_EPI) { if (wr == 1) PG8_BAR; }
    }
    PG8_WAIT_V(0);
    if constexpr (!ALIGN_EPI) { if (wr == 0) PG8_BAR; }
    PG8_BAR;
    if constexpr (Epi::AFTER_DRAIN) { E.fused(acc, cur, wr, wc, fr, fq, lds, wid, lane); S.done(cur); }
#undef PG8_SA
#undef PG8_SB
#undef PG8_STAGE
#undef PG8_LDA
#undef PG8_LDB
#undef PG8_MMA
#undef PG8_WAIT_V
#undef PG8_WAIT_L
#undef PG8_BAR
#undef PG8_SCHED
}
}
#define GAS __attribute__((address_space(1)))
#define LAS __attribute__((address_space(3)))
typedef unsigned short bf16;
typedef unsigned v4u __attribute__((ext_vector_type(4)));
typedef float f32x4 __attribute__((ext_vector_type(4)));
typedef short bf16x8 __attribute__((ext_vector_type(8)));
typedef GAS unsigned gu32;
typedef GAS unsigned long long gu64;
#define RLX_AGENT __ATOMIC_RELAXED, __HIP_MEMORY_SCOPE_AGENT
#define LDS_WAIT() asm volatile("s_waitcnt lgkmcnt(0)" ::: "memory")
#define VM_WAIT() asm volatile("s_waitcnt vmcnt(0)" ::: "memory")
__device__ __forceinline__ unsigned long long rt() { return __builtin_amdgcn_s_memrealtime(); }
__device__ __forceinline__ unsigned f2bf(float f) { unsigned u = __builtin_bit_cast(unsigned, f); return (u + 0x7fffu + ((u >> 16) & 1u)) >> 16; }
__device__ __forceinline__ unsigned pk2(float lo, float hi) { return f2bf(lo) | (f2bf(hi) << 16); }

#define XB_TMO      128
#define XB_XCNT(j)  (256  + 64 * (j))
#define XB_XSUB(j)  (1280 + 64 * (j))
#define XB_XGEN(j)  (2304 + 64 * (j))
#define XB_TOP      3328
#define XB_TOPGEN   3392
#define XCD_BAR_WORDS 3456
#define XB_SPIN_CAP (1u << 18)

__device__ __forceinline__ unsigned xb_ld(unsigned* p)              { return __hip_atomic_load(p, __ATOMIC_RELAXED, __HIP_MEMORY_SCOPE_AGENT); }
__device__ __forceinline__ unsigned xb_add(unsigned* p, unsigned v) { return __hip_atomic_fetch_add(p, v, __ATOMIC_RELAXED, __HIP_MEMORY_SCOPE_AGENT); }
__device__ __forceinline__ unsigned xb_xcc_id() { return (unsigned)__builtin_amdgcn_s_getreg((3 << 11) | 20) & 0xFu; }
#define XB_SPIN(cond, bar) do { unsigned _sp = 0; while (cond) { __builtin_amdgcn_s_sleep(1); \
    if ((++_sp & 255u) == 0u) { if (xb_ld(&(bar)[XB_TMO])) break; if (_sp > XB_SPIN_CAP) { atomicAdd(&(bar)[XB_TMO], 1u); break; } } } } while (0)

struct XcdBarrier {
    unsigned* bar; unsigned x;
    volatile LAS unsigned* st;
};

__device__ __forceinline__ XcdBarrier xcd_barrier_post(unsigned* bar, volatile LAS unsigned* st) {
    XcdBarrier b; b.bar = bar; b.x = xb_xcc_id(); b.st = st;
    if (threadIdx.x == 0) (void)xb_add(&bar[XB_XCNT(b.x)], 1u);
    return b;
}
__device__ __forceinline__ void xcd_barrier_complete(unsigned* bar, unsigned x, unsigned& nloc, unsigned& nx) {
    const unsigned G = gridDim.x * gridDim.y * gridDim.z;
    unsigned sum, cnt, mine, sp = 0u;
    for (;;) {
        sum = 0u; cnt = 0u; mine = 0u;
#pragma unroll
        for (unsigned j = 0; j < 16; ++j) { const unsigned c = xb_ld(&bar[XB_XCNT(j)]); sum += c; cnt += (c > 0u) ? 1u : 0u; mine = (j == x) ? c : mine; }
        if (sum == G) break;
        __builtin_amdgcn_s_sleep(1);
        if ((++sp & 255u) == 0u) { if (xb_ld(&bar[XB_TMO])) break; if (sp > XB_SPIN_CAP) { atomicAdd(&bar[XB_TMO], 1u); break; } }
    }
    nloc = mine > 0u ? mine : 1u; nx = cnt > 0u ? cnt : 1u;
}

__device__ __forceinline__ void xcd_barrier(const XcdBarrier& b) {
    asm volatile("s_waitcnt vmcnt(0)" ::: "memory");
    __syncthreads();
    if (threadIdx.x == 0) {
        unsigned* bar = b.bar;
        __builtin_amdgcn_s_waitcnt(0);
        unsigned nloc = b.st[0], nx = b.st[1];
        if (nloc == 0u) { xcd_barrier_complete(bar, b.x, nloc, nx); b.st[0] = nloc; b.st[1] = nx; }
        const unsigned old = xb_add(&bar[XB_XSUB(b.x)], 1u);
        const unsigned gen = old / nloc;
        if (old + 1u == (gen + 1u) * nloc) {
            __builtin_amdgcn_fence(__ATOMIC_RELEASE, "agent");
            asm volatile("s_waitcnt vmcnt(0)" ::: "memory");
            const unsigned og = xb_add(&bar[XB_TOP], 1u);
            const unsigned tg = og / nx;
            if (og + 1u == (tg + 1u) * nx) xb_add(&bar[XB_TOPGEN], 1u);
            else XB_SPIN(xb_ld(&bar[XB_TOPGEN]) == tg, bar);
            __builtin_amdgcn_fence(__ATOMIC_ACQUIRE, "agent");
            xb_add(&bar[XB_XGEN(b.x)], 1u);
            asm volatile("s_waitcnt vmcnt(0)" ::: "memory");
        } else {
            XB_SPIN(xb_ld(&bar[XB_XGEN(b.x)]) == gen, bar);
            __builtin_amdgcn_fence(__ATOMIC_ACQUIRE, "agent");
            asm volatile("s_waitcnt vmcnt(0)" ::: "memory");
        }
    }
    __syncthreads();
}

typedef float f32x16 __attribute__((ext_vector_type(16)));
typedef short s16x4 __attribute__((ext_vector_type(4)));
typedef unsigned u32x2v __attribute__((ext_vector_type(2)));
typedef LAS unsigned char* ldsp_t;
#define WAITV0_BAR() asm volatile("s_waitcnt vmcnt(0) lgkmcnt(0)\n\ts_barrier" ::: "memory")
#define LGKM_BAR() asm volatile("s_waitcnt lgkmcnt(0)\n\ts_barrier" ::: "memory")
__device__ __forceinline__ int crow(int r, int hi) { return (r & 3) + 8 * (r >> 2) + 4 * hi; }
__device__ __forceinline__ unsigned cvtpk(float lo, float hi) { unsigned r; asm volatile("v_cvt_pk_bf16_f32 %0, %1, %2" : "=v"(r) : "v"(lo), "v"(hi)); return r; }
__device__ __forceinline__ float bf2f(unsigned short b) { return __uint_as_float((unsigned)b << 16); }
__device__ __forceinline__ float bflo(unsigned w) { return __uint_as_float(w << 16); }
__device__ __forceinline__ float bfhi(unsigned w) { return __uint_as_float(w & 0xffff0000u); }
__device__ __forceinline__ float ex2(float x) { return __builtin_amdgcn_exp2f(x); }
__device__ __forceinline__ float fexpn(float x) { return __builtin_amdgcn_exp2f(x * LOG2E); }
__device__ __forceinline__ float swap_max(float v) { auto rr = __builtin_amdgcn_permlane32_swap(__float_as_uint(v), __float_as_uint(v), false, false); return fmaxf(__uint_as_float(rr[0]), __uint_as_float(rr[1])); }
__device__ __forceinline__ float swap_sum(float v) { auto rr = __builtin_amdgcn_permlane32_swap(__float_as_uint(v), __float_as_uint(v), false, false); return __uint_as_float(rr[0]) + __uint_as_float(rr[1]); }
__device__ __forceinline__ s16x4 vtr(LAS const unsigned char* p) { return __builtin_bit_cast(s16x4, __builtin_amdgcn_ds_read_tr16_b64_v4i16((LAS s16x4*)p)); }
__device__ __forceinline__ bf16x8 cat8(s16x4 a, s16x4 b) { return (bf16x8){a[0], a[1], a[2], a[3], b[0], b[1], b[2], b[3]}; }
__device__ __forceinline__ bf16x8 accfrag(const f32x16& x, int s) {
    v4u w; w.x = cvtpk(x[8 * s + 0], x[8 * s + 1]); w.y = cvtpk(x[8 * s + 2], x[8 * s + 3]); w.z = cvtpk(x[8 * s + 4], x[8 * s + 5]); w.w = cvtpk(x[8 * s + 6], x[8 * s + 7]);
    return __builtin_bit_cast(bf16x8, w);
}
#define DMA16(gsrc, ldsdst) __builtin_amdgcn_global_load_lds((const unsigned*)(gsrc), (LAS unsigned*)(ldsdst), 16, 0, 0)
__device__ __forceinline__ void dma_vimg(const bf16* src, int pitch, ldsp_t img, int wid, int lane) {
    const int sub = lane >> 5, row = (lane & 31) >> 2, ch = lane & 3;
#pragma unroll
    for (int j = 0; j < 2; ++j) DMA16(src + (size_t)(8 * wid + row) * pitch + 32 * (2 * j + sub) + 8 * ch, img + (wid * 4 + 2 * j) * 512);
}
__device__ __forceinline__ int vtr_lane_off(int lane) { return ((lane >> 4) & 1) * 32 + (lane & 3) * 8 + ((lane & 15) >> 2) * 64; }

namespace att {
constexpr int BUFB = 32768, KIMG = 16384, XOFF = 65536;
__device__ __forceinline__ void unit(int b, int h, int qblk, const bf16* Q, const bf16* K, const bf16* V, bf16* MIX, float lam, const float* gsub, ldsp_t lds) {
    int tid = threadIdx.x; asm volatile("" : "+v"(tid));
    const int lane = tid & 63, wid = __builtin_amdgcn_readfirstlane(tid >> 6), r32 = lane & 31, hi = lane >> 5, mp = wid >> 2, qb = wid & 3;
    const int q0 = qblk * 128, NT = 2 * (qblk + 1);
    const size_t rowbase = (size_t)b * SEQ;
    const int qg = q0 + 32 * qb + r32;
    bf16x8 qr[4];
    { const bf16* qp = Q + (rowbase + qg) * AW + h * 128 + mp * 64 + hi * 8;
#pragma unroll
      for (int d0 = 0; d0 < 4; ++d0) qr[d0] = *(const bf16x8*)(qp + 16 * d0); }
    const bf16* ksrc = K + (rowbase + lane) * AW + h * 128 + mp * 64 + 2 * (wid & 3) * 8;
    const bf16* vsrc = V + rowbase * AW + h * 128;
    const int kdst = mp * 8192 + 2 * (wid & 3) * 1024;
#define ATT_DMA(t, buf) do { const bf16* ks_ = ksrc + (size_t)(t) * 64 * AW; DMA16(ks_, lds + (buf) * BUFB + kdst); DMA16(ks_ + 8, lds + (buf) * BUFB + kdst + 1024); \
        dma_vimg(vsrc + (size_t)(t) * 64 * AW, AW, lds + (buf) * BUFB + KIMG, wid, lane); } while (0)
    f32x16 o[4];
#pragma unroll
    for (int i = 0; i < 4; ++i) o[i] = (f32x16){};
    float mrun = -1e30f, lsum = 0.f;
    const int vlo = vtr_lane_off(lane) + 4 * hi * 64;
    ATT_DMA(0, 0);
    WAITV0_BAR();
    for (int t = 0; t < NT; ++t) {
        const int buf = t & 1;
        if (t + 1 < NT) ATT_DMA(t + 1, buf ^ 1);
        if (64 * t <= q0 + 32 * qb + 31) {
            const LAS unsigned char* kb = lds + buf * BUFB + mp * 8192 + hi * 1024 + r32 * 16;
            f32x16 p0 = (f32x16){}, p1 = (f32x16){};
#pragma unroll
            for (int d0 = 0; d0 < 4; ++d0) {
                const bf16x8 k0 = *(const LAS bf16x8*)(kb + d0 * 2048), k1 = *(const LAS bf16x8*)(kb + d0 * 2048 + 512);
                p0 = __builtin_amdgcn_mfma_f32_32x32x16_bf16(k0, qr[d0], p0, 0, 0, 0);
                p1 = __builtin_amdgcn_mfma_f32_32x32x16_bf16(k1, qr[d0], p1, 0, 0, 0);
            }
            if (64 * t + 63 > q0 + 32 * qb) {
#pragma unroll
                for (int r = 0; r < 16; ++r) { const int kv = 64 * t + crow(r, hi); if (kv > qg) p0[r] = -1e30f; if (kv + 32 > qg) p1[r] = -1e30f; }
            }
            float mt = fmaxf(p0[0], p1[0]);
#pragma unroll
            for (int r = 1; r < 16; ++r) mt = fmaxf(mt, fmaxf(p0[r], p1[r]));
            mt = swap_max(mt);
            const float mnew = fmaxf(mrun, mt);
            if (__any(mnew > mrun)) {
                const float al = ex2(mrun - mnew); lsum *= al;
#pragma unroll
                for (int i = 0; i < 4; ++i)
#pragma unroll
                    for (int r = 0; r < 16; ++r) o[i][r] *= al;
            }
            mrun = mnew;
            float ps = 0.f;
#pragma unroll
            for (int r = 0; r < 16; ++r) { p0[r] = ex2(p0[r] - mnew); p1[r] = ex2(p1[r] - mnew); ps += p0[r] + p1[r]; }
            lsum += ps;
            bf16x8 pw[4]; pw[0] = accfrag(p0, 0); pw[1] = accfrag(p0, 1); pw[2] = accfrag(p1, 0); pw[3] = accfrag(p1, 1);
            const LAS unsigned char* vb = lds + buf * BUFB + KIMG + vlo;
#pragma unroll
            for (int s = 0; s < 4; ++s)
#pragma unroll
                for (int db = 0; db < 4; ++db) {
                    const bf16x8 vf = cat8(vtr(vb + ((2 * s) * 4 + db) * 512), vtr(vb + ((2 * s + 1) * 4 + db) * 512));
                    o[db] = __builtin_amdgcn_mfma_f32_32x32x16_bf16(vf, pw[s], o[db], 0, 0, 0);
                }
        }
        WAITV0_BAR();
    }
#undef ATT_DMA
    const float inv = 1.0f / swap_sum(lsum);
    LAS float* X = (LAS float*)(lds + XOFF);
    if (mp == 1) { const float sc = lam * inv;
#pragma unroll
        for (int db = 0; db < 4; ++db)
#pragma unroll
            for (int r = 0; r < 16; ++r) X[(qb * 64 + db * 16 + r) * 64 + lane] = o[db][r] * sc; }
    LGKM_BAR();
    if (mp == 0) {
        float ss = 0.f;
#pragma unroll
        for (int db = 0; db < 4; ++db)
#pragma unroll
            for (int r = 0; r < 16; ++r) { const float a = o[db][r] * inv - X[(qb * 64 + db * 16 + r) * 64 + lane]; o[db][r] = a; ss += a * a; }
        ss = swap_sum(ss);
        const float rs = (1.0f - LAM_INIT) / sqrtf(ss * (1.0f / 128.0f) + EPS);
        bf16* orow = MIX + (rowbase + qg) * D + h * 128;
#pragma unroll
        for (int db = 0; db < 4; ++db)
#pragma unroll
            for (int g = 0; g < 4; ++g) { const int d = 32 * db + 8 * g + 4 * hi; const f32x4 gg = *(const f32x4*)(gsub + d);
                u32x2v w; w.x = cvtpk(o[db][4 * g] * rs * gg[0], o[db][4 * g + 1] * rs * gg[1]); w.y = cvtpk(o[db][4 * g + 2] * rs * gg[2], o[db][4 * g + 3] * rs * gg[3]);
                *(u32x2v*)(orow + d) = w; }
    }
}
}

namespace hg {
constexpr int QE_OFF = 0, QE_P = 136  , KE_OFF = 17408, KLT_OFF = 34816, KLT_P = 72, V_OFF = 53248, G_OFF = 86016, QT_OFF = 86528, LDS_END = 88576;
__device__ __forceinline__ void unit(int bh, const bf16* RQ, const bf16* RK, const bf16* RV, const float* LOGF, bf16* OREC, float* sout, ldsp_t lds) {
    int tid = threadIdx.x; asm volatile("" : "+v"(tid));
    const int lane = tid & 63, wid = __builtin_amdgcn_readfirstlane(tid >> 6), r32 = lane & 31, hi = lane >> 5, th = wid >> 2, eb = wid & 3;
    const int b = bh >> 2, h = bh & 3;
    const size_t rowbase = (size_t)b * SEQ; const int col0 = h * 128;
    const int d = tid & 127, tq = tid >> 7;
    LAS bf16* QE = (LAS bf16*)(lds + QE_OFF); LAS bf16* KE = (LAS bf16*)(lds + KE_OFF); LAS bf16* KLT = (LAS bf16*)(lds + KLT_OFF);
    LAS float* G = (LAS float*)(lds + G_OFF); LAS float* QT = (LAS float*)(lds + QT_OFF);
    float lf[16]; unsigned short rq[16], rk[16];
    f32x16 S[4];
#pragma unroll
    for (int i = 0; i < 4; ++i) S[i] = (f32x16){};
    const int vlo = vtr_lane_off(lane);
#define HG_LOAD(n) do { const size_t g0_ = (rowbase + 64 * (n) + 16 * tq) * RW + col0 + d; _Pragma("unroll") for (int i = 0; i < 16; ++i) { lf[i] = LOGF[g0_ + (size_t)i * RW]; rq[i] = RQ[g0_ + (size_t)i * RW]; rk[i] = RK[g0_ + (size_t)i * RW]; } \
        dma_vimg(RV + (rowbase + 64 * (n)) * RW + col0, RW, lds + V_OFF + ((n) & 1) * 16384, wid, lane); } while (0)
#define HG_PREP() do { float cs_[16]; float c_ = 0.f; _Pragma("unroll") for (int i = 0; i < 16; ++i) { c_ += lf[i]; cs_[i] = c_; } \
        QT[tq * 128 + d] = c_; LGKM_BAR(); \
        float off_ = 0.f, tot_ = 0.f; _Pragma("unroll") for (int q = 0; q < 4; ++q) { const float v_ = QT[q * 128 + d]; tot_ += v_; if (q < tq) off_ += v_; } \
        if (tq == 0) G[d] = fexpn(tot_); \
        unsigned klw_[8]; \
        _Pragma("unroll") for (int i = 0; i < 16; i += 2) { \
            const float b0_ = cs_[i] + off_, b1_ = cs_[i + 1] + off_; const float q0_ = bf2f(rq[i]), q1_ = bf2f(rq[i + 1]), k0_ = bf2f(rk[i]), k1_ = bf2f(rk[i + 1]); \
            const unsigned qe_ = cvtpk(q0_ * fexpn(b0_), q1_ * fexpn(b1_)), ke_ = cvtpk(k0_ * fexpn(-b0_), k1_ * fexpn(-b1_)); \
            klw_[i >> 1] = cvtpk(k0_ * fexpn(tot_ - b0_), k1_ * fexpn(tot_ - b1_)); \
            QE[(16 * tq + i) * QE_P + d] = (bf16)(qe_ & 0xffffu); QE[(16 * tq + i + 1) * QE_P + d] = (bf16)(qe_ >> 16); \
            KE[(16 * tq + i) * QE_P + d] = (bf16)(ke_ & 0xffffu); KE[(16 * tq + i + 1) * QE_P + d] = (bf16)(ke_ >> 16); } \
        *(LAS v4u*)(KLT + d * KLT_P + 16 * tq) = (v4u){klw_[0], klw_[1], klw_[2], klw_[3]}; *(LAS v4u*)(KLT + d * KLT_P + 16 * tq + 8) = (v4u){klw_[4], klw_[5], klw_[6], klw_[7]}; } while (0)
    HG_LOAD(0);
    HG_PREP();
    WAITV0_BAR();
    for (int n = 0; n < 32; ++n) {
        if (n + 1 < 32) HG_LOAD(n + 1);
        const LAS unsigned char* vimg = lds + V_OFF + (n & 1) * 16384;
        f32x16 o = (f32x16){};
        bf16x8 xw[2][2];
#pragma unroll
        for (int sb = 0; sb < 2; ++sb) if (sb <= th) {
            f32x16 x = (f32x16){};
#pragma unroll
            for (int sg = 0; sg < 8; ++sg) {
                const bf16x8 ka = *(const LAS bf16x8*)(KE + (32 * sb + r32) * QE_P + 16 * sg + 8 * hi), qbv = *(const LAS bf16x8*)(QE + (32 * th + r32) * QE_P + 16 * sg + 8 * hi);
                x = __builtin_amdgcn_mfma_f32_32x32x16_bf16(ka, qbv, x, 0, 0, 0);
            }
            if (sb == th) {
#pragma unroll
                for (int r = 0; r < 16; ++r) if (crow(r, hi) > r32) x[r] = 0.f;
            }
            xw[sb][0] = accfrag(x, 0); xw[sb][1] = accfrag(x, 1);
        }
#pragma unroll
        for (int db = 0; db < 4; ++db)
#pragma unroll
            for (int sg = 0; sg < 2; ++sg) {
                const LAS bf16* qp = QE + (32 * th + r32) * QE_P + 32 * db + 16 * sg + 4 * hi;
                const u32x2v a0 = *(const LAS u32x2v*)qp, a1 = *(const LAS u32x2v*)(qp + 8);
                const v4u aw = (v4u){a0.x, a0.y, a1.x, a1.y};
                o = __builtin_amdgcn_mfma_f32_32x32x16_bf16(__builtin_bit_cast(bf16x8, aw), accfrag(S[db], sg), o, 0, 0, 0);
            }
#pragma unroll
        for (int sb = 0; sb < 2; ++sb) if (sb <= th) {
#pragma unroll
            for (int sg = 0; sg < 2; ++sg) {
                const LAS unsigned char* vb = vimg + vlo + 4 * hi * 64 + ((4 * sb + 2 * sg) * 4 + eb) * 512;
                const bf16x8 vf = cat8(vtr(vb), vtr(vb + 4 * 512));
                o = __builtin_amdgcn_mfma_f32_32x32x16_bf16(xw[sb][sg], vf, o, 0, 0, 0);
            }
        }
        { bf16* op = OREC + (rowbase + 64 * n + 32 * th) * RW + col0 + 32 * eb + r32;
#pragma unroll
          for (int r = 0; r < 16; r += 2) { const unsigned w = cvtpk(o[r], o[r + 1]); op[(size_t)crow(r, hi) * RW] = (bf16)(w & 0xffffu); op[(size_t)crow(r + 1, hi) * RW] = (bf16)(w >> 16); } }
#pragma unroll
        for (int db = 0; db < 4; ++db) {
#pragma unroll
            for (int g = 0; g < 4; ++g) { const f32x4 gg = *(const LAS f32x4*)(G + 32 * db + 8 * g + 4 * hi);
                S[db][4 * g] *= gg[0]; S[db][4 * g + 1] *= gg[1]; S[db][4 * g + 2] *= gg[2]; S[db][4 * g + 3] *= gg[3]; }
        }
#pragma unroll
        for (int sg = 0; sg < 4; ++sg) {
            const LAS unsigned char* vb = vimg + vlo + ((2 * sg + hi) * 4 + eb) * 512;
            const bf16x8 vf = cat8(vtr(vb), vtr(vb + 4 * 64));
#pragma unroll
            for (int db = 0; db < 4; ++db) {
                const bf16x8 ka = *(const LAS bf16x8*)(KLT + (32 * db + r32) * KLT_P + 16 * sg + 8 * hi);
                S[db] = __builtin_amdgcn_mfma_f32_32x32x16_bf16(ka, vf, S[db], 0, 0, 0);
            }
        }
        LGKM_BAR();
        if (n + 1 < 32) HG_PREP();
        WAITV0_BAR();
    }
#undef HG_LOAD
#undef HG_PREP
    if (th == 0) { float* sp = sout + (size_t)bh * 16384 + 32 * eb + r32;
#pragma unroll
        for (int db = 0; db < 4; ++db)
#pragma unroll
            for (int r = 0; r < 16; ++r) sp[(size_t)(32 * db + crow(r, hi)) * 128] = S[db][r]; }
}
}

namespace dec {
constexpr int PART = 264;
__device__ __forceinline__ void unit(int bs, int h, const bf16* Q, const bf16* K, const bf16* V, const float* ck, const float* cv, const int* ptab, bf16* MIX, float lam, const float* gsub, ldsp_t lds) {
    int tid = threadIdx.x; asm volatile("" : "+v"(tid));
    const int lane = tid & 63, wid = __builtin_amdgcn_readfirstlane(tid >> 6);
    const size_t row = (size_t)MP + bs;
    LAS float* P = (LAS float*)lds;
    const int c4 = 4 * (lane & 31), half = lane >> 5, mymap = (lane >> 4) & 1;
    f32x4 q4; { const u32x2v qw = *(const u32x2v*)(Q + row * AW + h * 128 + c4); q4 = (f32x4){bflo(qw.x), bfhi(qw.x), bflo(qw.y), bfhi(qw.y)}; }
    float mrun = -1e30f, lrun = 0.f; f32x4 o0 = (f32x4){0.f, 0.f, 0.f, 0.f}, o1 = o0;
    const int pid0 = ptab[bs * NPAGES + 2 * wid], pid1 = ptab[bs * NPAGES + 2 * wid + 1];
    const size_t lo_ = (size_t)half * 512 + h * 128 + c4;
    const float* kp0 = ck + (size_t)pid0 * PAGE * 512 + lo_; const float* vp0 = cv + (size_t)pid0 * PAGE * 512 + lo_;
    const float* kp1 = ck + (size_t)pid1 * PAGE * 512 + lo_; const float* vp1 = cv + (size_t)pid1 * PAGE * 512 + lo_;
#define DEC_LOAD(KK, VV, st) do { const size_t so_ = (size_t)(16 * ((st) & 7)) * 512; const float* kq_ = ((st) < 8 ? kp0 : kp1) + so_; const float* vq_ = ((st) < 8 ? vp0 : vp1) + so_; \
        _Pragma("unroll") for (int i = 0; i < 8; ++i) KK[i] = __builtin_nontemporal_load((const f32x4*)(kq_ + (size_t)(2 * i) * 512)); \
        _Pragma("unroll") for (int i = 0; i < 8; ++i) VV[i] = __builtin_nontemporal_load((const f32x4*)(vq_ + (size_t)(2 * i) * 512)); } while (0)
#define DEC_COMPUTE(KK, VV) do { float pr[8]; \
        _Pragma("unroll") for (int i = 0; i < 8; ++i) pr[i] = (KK[i][0] * q4[0] + KK[i][1] * q4[1]) + (KK[i][2] * q4[2] + KK[i][3] * q4[3]); \
        float a4[4], a2[2], s; \
        { const bool up = (lane & 8) != 0; _Pragma("unroll") for (int i = 0; i < 4; ++i) { const float keep = up ? pr[i + 4] : pr[i], send = up ? pr[i] : pr[i + 4]; a4[i] = keep + __shfl_xor(send, 8); } } \
        { const bool up = (lane & 4) != 0; _Pragma("unroll") for (int i = 0; i < 2; ++i) { const float keep = up ? a4[i + 2] : a4[i], send = up ? a4[i] : a4[i + 2]; a2[i] = keep + __shfl_xor(send, 4); } } \
        { const bool up = (lane & 2) != 0; const float keep = up ? a2[1] : a2[0], send = up ? a2[0] : a2[1]; s = keep + __shfl_xor(send, 2); } \
        s += __shfl_xor(s, 1); \
        float mt = s; mt = fmaxf(mt, __shfl_xor(mt, 2)); mt = fmaxf(mt, __shfl_xor(mt, 4)); mt = fmaxf(mt, __shfl_xor(mt, 8)); mt = fmaxf(mt, __shfl_xor(mt, 32)); \
        const float mnew = fmaxf(mrun, mt), al = ex2(mrun - mnew), p = ex2(s - mnew); \
        float psum = p; psum += __shfl_xor(psum, 2); psum += __shfl_xor(psum, 4); psum += __shfl_xor(psum, 8); psum += __shfl_xor(psum, 32); \
        lrun = lrun * al + psum; mrun = mnew; \
        const float al0 = __shfl(al, 0), al1 = __shfl(al, 16); \
        o0 = o0 * al0; o1 = o1 * al1; \
        _Pragma("unroll") for (int i = 0; i < 8; ++i) { const float p0 = __shfl(p, (lane & 32) + 2 * i), p1 = __shfl(p, (lane & 32) + 16 + 2 * i); o0 = o0 + VV[i] * p0; o1 = o1 + VV[i] * p1; } } while (0)
    {
        f32x4 kA[8], vA[8], kB[8], vB[8];
        DEC_LOAD(kA, vA, 0);
        for (int st = 0; st < 16; st += 2) {
            DEC_LOAD(kB, vB, st + 1);
            DEC_COMPUTE(kA, vA);
            if (st + 2 < 16) DEC_LOAD(kA, vA, st + 2);
            DEC_COMPUTE(kB, vB);
        }
    }
#undef DEC_LOAD
#undef DEC_COMPUTE
#pragma unroll
    for (int j = 0; j < 4; ++j) { o0[j] += __shfl_xor(o0[j], 32); o1[j] += __shfl_xor(o1[j], 32); }
    { const float m0 = __shfl(mrun, 0), l0 = __shfl(lrun, 0), m1 = __shfl(mrun, 16), l1 = __shfl(lrun, 16);
      LAS float* pw = P + wid * PART;
      if (lane < 32) { *(LAS f32x4*)(pw + c4) = o0; *(LAS f32x4*)(pw + 128 + c4) = o1; }
      if (lane == 0) { pw[256] = m0; pw[257] = l0; pw[258] = m1; pw[259] = l1; } }
    if (wid == 0) {
        const u32x2v kw = *(const u32x2v*)(K + row * AW + h * 128 + c4);
        float s = (bflo(kw.x) * q4[0] + bfhi(kw.x) * q4[1]) + (bflo(kw.y) * q4[2] + bfhi(kw.y) * q4[3]);
        s += __shfl_xor(s, 1); s += __shfl_xor(s, 2); s += __shfl_xor(s, 4); s += __shfl_xor(s, 8);
        if (lane == 0) P[8 * PART] = s; if (lane == 16) P[8 * PART + 1] = s;
    }
    LGKM_BAR();
    if (wid == 0) {
        float M0 = P[8 * PART], M1 = P[8 * PART + 1]; const float sn0 = M0, sn1 = M1;
#pragma unroll
        for (int w = 0; w < 8; ++w) { M0 = fmaxf(M0, P[w * PART + 256]); M1 = fmaxf(M1, P[w * PART + 258]); }
        const float wn0 = ex2(sn0 - M0), wn1 = ex2(sn1 - M1);
        float L0 = wn0, L1 = wn1; float a[2], bq[2];
        { const bf16* vr = V + row * AW + h * 128; a[0] = wn0 * bf2f(vr[lane]); a[1] = wn0 * bf2f(vr[lane + 64]); bq[0] = wn1 * bf2f(vr[lane]); bq[1] = wn1 * bf2f(vr[lane + 64]); }
#pragma unroll
        for (int w = 0; w < 8; ++w) { const float f0 = ex2(P[w * PART + 256] - M0), f1 = ex2(P[w * PART + 258] - M1);
            L0 += f0 * P[w * PART + 257]; L1 += f1 * P[w * PART + 259];
            a[0] += f0 * P[w * PART + lane]; a[1] += f0 * P[w * PART + lane + 64]; bq[0] += f1 * P[w * PART + 128 + lane]; bq[1] += f1 * P[w * PART + 128 + lane + 64]; }
        const float i0 = 1.0f / L0, i1 = lam / L1;
        const float y0 = a[0] * i0 - bq[0] * i1, y1 = a[1] * i0 - bq[1] * i1;
        float ss = y0 * y0 + y1 * y1;
#pragma unroll
        for (int o = 1; o < 64; o <<= 1) ss += __shfl_xor(ss, o);
        const float rs = (1.0f - LAM_INIT) / sqrtf(ss * (1.0f / 128.0f) + EPS);
        bf16* orow = MIX + row * D + h * 128;
        orow[lane] = (bf16)f2bf(y0 * rs * gsub[lane]); orow[lane + 64] = (bf16)f2bf(y1 * rs * gsub[lane + 64]);
    }
    LGKM_BAR();
}
}

__device__ __forceinline__ void hgrn_step(int bs, int h, const bf16* RQ, const bf16* RK, const bf16* RV, const float* LOGF, const float* S0, float* Sout, bf16* OREC, ldsp_t lds) {
    int tid = threadIdx.x; asm volatile("" : "+v"(tid)); const size_t row = (size_t)MP + bs; const size_t g0 = row * RW + h * 128;
    LAS float* qs = (LAS float*)lds; LAS float* ks = qs + 128; LAS float* fs = qs + 256; LAS float* po = qs + 384;
    if (tid < 128) { qs[tid] = bf2f(RQ[g0 + tid]); ks[tid] = bf2f(RK[g0 + tid]); fs[tid] = fexpn(LOGF[g0 + tid]); }
    const int e = tid & 127, dq = tid >> 7;
    const float v = bf2f(RV[g0 + e]);
    LGKM_BAR();
    const size_t sb = ((size_t)(bs * 4 + h) * 128 + 32 * dq) * 128 + e;
    float acc = 0.f;
#pragma unroll 8
    for (int i = 0; i < 32; ++i) { const int dd = 32 * dq + i; const float sn = fs[dd] * S0[sb + (size_t)i * 128] + ks[dd] * v; Sout[sb + (size_t)i * 128] = sn; acc += qs[dd] * sn; }
    po[dq * 128 + e] = acc;
    LGKM_BAR();
    if (tid < 128) OREC[g0 + tid] = (bf16)f2bf((po[tid] + po[128 + tid]) + (po[256 + tid] + po[384 + tid]));
    LGKM_BAR();
}


template <int MODE, int N, int K, int KC>
__device__ __forceinline__ void samp_item(int item, const bf16* Abf, const float* xs, const float* C4, const float* C5, const float* C6, float* SS1, const bf16* Bt, float* C) {
    int tid = threadIdx.x; asm volatile("" : "+v"(tid));
    const int lane = tid & 63, wid = __builtin_amdgcn_readfirstlane(tid >> 6), r32 = lane & 31, hi = lane >> 5, rb = wid >> 1, cbk = wid & 1;
    constexpr int NCH = N / 64;
    const int nc = item % NCH, kc = item / NCH, n0 = nc * 64 + 32 * cbk, k0 = kc * KC, row = 32 * rb + r32;
    f32x16 acc = (f32x16){};
    float ssp = 0.f, r2 = 0.f;
    if (MODE == 7) r2 = 1.0f / (SS1[row] * (1.0f / D) + EPS);
    const bf16* bp = Bt + (size_t)(n0 + r32) * K + k0 + 8 * hi;
#pragma unroll 4
    for (int s = 0; s < KC / 16; ++s) {
        const int k8 = k0 + 16 * s + 8 * hi;
        bf16x8 a;
        if (MODE == 4) a = *(const bf16x8*)(Abf + (size_t)row * D + k8);
        else {
            f32x4 v0, v1;
            if (MODE == 6) { const float* p = C5 + (size_t)row * FF + k8; v0 = *(const f32x4*)p; v1 = *(const f32x4*)(p + 4);
#pragma unroll
                for (int j = 0; j < 4; ++j) { const float a0 = fmaxf(v0[j], 0.f), a1 = fmaxf(v1[j], 0.f); v0[j] = a0 * a0; v1[j] = a1 * a1; } }
            else { const size_t o = (size_t)row * D + k8; v0 = *(const f32x4*)(xs + o) + *(const f32x4*)(C4 + o); v1 = *(const f32x4*)(xs + o + 4) + *(const f32x4*)(C4 + o + 4);
                if (MODE == 5) ssp += (v0[0] * v0[0] + v0[1] * v0[1]) + (v0[2] * v0[2] + v0[3] * v0[3]) + (v1[0] * v1[0] + v1[1] * v1[1]) + (v1[2] * v1[2] + v1[3] * v1[3]);
                if (MODE == 7) { v0 = v0 + *(const f32x4*)(C6 + o) * r2; v1 = v1 + *(const f32x4*)(C6 + o + 4) * r2; } }
            v4u w; w.x = cvtpk(v0[0], v0[1]); w.y = cvtpk(v0[2], v0[3]); w.z = cvtpk(v1[0], v1[1]); w.w = cvtpk(v1[2], v1[3]); a = __builtin_bit_cast(bf16x8, w);
        }
        const bf16x8 b = *(const bf16x8*)(bp + 16 * s);
        acc = __builtin_amdgcn_mfma_f32_32x32x16_bf16(a, b, acc, 0, 0, 0);
    }
    float* cp = C + (size_t)(32 * rb) * N + n0 + r32;
#pragma unroll
    for (int r = 0; r < 16; ++r) unsafeAtomicAdd(cp + (size_t)crow(r, hi) * N, acc[r]);
    if (MODE == 5 && nc == 0 && cbk == 0) { ssp = swap_sum(ssp); if (hi == 0) unsafeAtomicAdd(SS1 + row, ssp); }
}

constexpr size_t MiB = 1u << 20;
constexpr size_t WS_CTL = 0, CTL_ZERO_BYTES = 1 * MiB;
constexpr size_t WS_WIN = 2 * MiB, WS_WOUT = 9 * MiB, WS_WUP = 11 * MiB, WS_WDN = 19 * MiB, WS_WG = 27 * MiB, WS_WP = 29 * MiB;
constexpr size_t WS_XN = 32 * MiB, WS_PB = 66 * MiB, WS_Q = 76 * MiB, WS_K = 93 * MiB, WS_V = 110 * MiB, WS_RQ = 127 * MiB, WS_RK = 144 * MiB, WS_RV = 161 * MiB, WS_RG = 178 * MiB;
constexpr size_t WS_LOGF = 195 * MiB, WS_OREC = 228 * MiB, WS_MIX = 245 * MiB, WS_X1 = 278 * MiB, WS_A2 = 343 * MiB, WS_A3 = 376 * MiB, WS_PJ = 409 * MiB, WS_H = 442 * MiB;
constexpr size_t WS_SSP1 = 572 * MiB, WS_SSP3 = 574 * MiB;
constexpr size_t WS_X2 = 582 * MiB;
constexpr size_t WS_SC4 = 576 * MiB, WS_SC5 = 577 * MiB, WS_SC6 = 579 * MiB, WS_SC7 = 580 * MiB, WS_SS1S = 581 * MiB, WS_SC_END = WS_SS1S + 4096, WS_END = 648 * MiB;
static_assert(WS_K - WS_Q == 17 * MiB && WS_V - WS_K == 17 * MiB && WS_RQ - WS_V == 17 * MiB && WS_RK - WS_RQ == 17 * MiB && WS_RV - WS_RK == 17 * MiB && WS_RG - WS_RV == 17 * MiB, "EpiIn buffer stride");
static_assert(WS_XN + (size_t)MT * D * 2 <= WS_PB && WS_PB + (size_t)MT * PLE * 2 <= WS_Q && WS_Q + (size_t)MT * AW * 2 <= WS_K && WS_LOGF + (size_t)MT * RW * 4 <= WS_OREC &&
              WS_MIX + (size_t)MT * D * 2 <= WS_X1 && WS_X1 + (size_t)MT * D * 4 <= WS_A2 && WS_PJ + (size_t)MT * D * 2 <= WS_H && WS_H + (size_t)MT * FF * 2 <= WS_SSP1 && WS_SSP1 + (size_t)MT * 64 <= WS_SSP3, "d_ws map");
constexpr int CW_QA = 64, CW_QD = 128;
constexpr int CW_BAR = 4096;
static_assert((CW_BAR + XCD_BAR_WORDS) * 4 <= (int)CTL_ZERO_BYTES, "CTL words inside the memset region");

constexpr int RING_OFF = 0, RING_BYTES = 131072;
constexpr int LDSCTL_OFF = RING_BYTES, MISC_OFF = LDSCTL_OFF + 320;
constexpr int LDS_BYTES = 147456;
constexpr int NWAVES = 8;
constexpr int N_PHASES = 9;
#ifndef DEC_FIRST_FROM
#define DEC_FIRST_FROM 128
#endif

struct Frame {
    LAS unsigned char* lds; volatile LAS unsigned* MISC; gu32* ctl;
    int tid, lane, wave, vcu, G;
};

__device__ __forceinline__ float wave_sum(float v) {
#pragma unroll
    for (int o = 1; o < 64; o <<= 1) v += __shfl_xor(v, o);
    return v;
}
__device__ __forceinline__ void p0_transpose_item(const float* W, int K, int N, bf16* WT, const float* kscale, LAS float* scr, int item, int lane) {
    const int nblk = N / 32, kb = item / nblk, nb = item % nblk, k0 = 64 * kb, n0 = 32 * nb;
    float wv[32];
#pragma unroll
    for (int i = 0; i < 32; ++i) wv[i] = __builtin_nontemporal_load(W + (size_t)(k0 + 2 * i + (lane >> 5)) * N + n0 + (lane & 31));
    if (kscale) {
#pragma unroll
        for (int i = 0; i < 32; ++i) wv[i] *= kscale[k0 + 2 * i + (lane >> 5)]; }
#pragma unroll
    for (int i = 0; i < 32; ++i) scr[(2 * i + (lane >> 5)) * 33 + (lane & 31)] = wv[i];
    LDS_WAIT(); asm volatile("" ::: "memory");
    const int c = lane & 7;
#pragma unroll
    for (int j = 0; j < 4; ++j) { const int n = (lane >> 3) + 8 * j; const LAS float* s = scr + (8 * c) * 33 + n;
        v4u o; o.x = pk2(s[0 * 33], s[1 * 33]); o.y = pk2(s[2 * 33], s[3 * 33]); o.z = pk2(s[4 * 33], s[5 * 33]); o.w = pk2(s[6 * 33], s[7 * 33]);
        *(GAS v4u*)(WT + (size_t)(n0 + n) * K + k0 + 8 * c) = o; }
    LDS_WAIT(); asm volatile("" ::: "memory");
}
__device__ __forceinline__ void rms_row_to_bf16(const float* xrow, const float* g, bf16* orow, int lane) {
    const f32x4* xr = (const f32x4*)xrow + lane; const f32x4* gr = (const f32x4*)g + lane;
    f32x4 v[4]; float s = 0.f;
#pragma unroll
    for (int j = 0; j < 4; ++j) { v[j] = xr[64 * j]; s += (v[j].x * v[j].x + v[j].y * v[j].y) + (v[j].z * v[j].z + v[j].w * v[j].w); }
    const float r = 1.0f / sqrtf(wave_sum(s) * (1.f / D) + EPS);
    unsigned long long* o8 = (unsigned long long*)orow + lane;
#pragma unroll
    for (int j = 0; j < 4; ++j) { const f32x4 gg = gr[64 * j]; o8[64 * j] = (unsigned long long)pk2(v[j].x * r * gg.x, v[j].y * r * gg.y) | ((unsigned long long)pk2(v[j].z * r * gg.z, v[j].w * r * gg.w) << 32); }
}


struct Args { const float* in[24]; float* out; unsigned char* ws; int ph_lo, ph_hi, li, pad; };

#define x_prompt (args.in[0])
#define x_sample (args.in[1])
#define cache_k (args.in[2])
#define cache_v (args.in[3])
#define state0 (args.in[4])
#define ptab ((const int*)args.in[5])
#define p_prompt (args.in[6])
#define p_sample (args.in[7])
#define w_in (args.in[8])
#define g_subln (args.in[13])
#define hgrn_lb (args.in[14])
#define g_rec (args.in[15])
#define w_out (args.in[16])
#define g_mix (args.in[17])
#define g_ffn (args.in[18])
#define w_up (args.in[19])
#define w_down (args.in[20])
#define w_gate (args.in[21])
#define w_proj (args.in[22])
#define g_final (args.in[23])
#define OUTP (args.out)
#define WSP(T, off) ((T*)(args.ws + (off)))
#define WinT WSP(bf16, WS_WIN)
#define WoutT WSP(bf16, WS_WOUT)
#define WupT WSP(bf16, WS_WUP)
#define WdnT WSP(bf16, WS_WDN)
#define WgT WSP(bf16, WS_WG)
#define WpT WSP(bf16, WS_WP)
#define XN WSP(bf16, WS_XN)
#define PB WSP(bf16, WS_PB)
#define Qb WSP(bf16, WS_Q)
#define Kb WSP(bf16, WS_K)
#define Vb WSP(bf16, WS_V)
#define RQ WSP(bf16, WS_RQ)
#define RK WSP(bf16, WS_RK)
#define RV WSP(bf16, WS_RV)
#define RG WSP(bf16, WS_RG)
#define LOGF WSP(float, WS_LOGF)
#define OREC WSP(bf16, WS_OREC)
#define MIX WSP(bf16, WS_MIX)
#define X1 WSP(float, WS_X1)
#define A2 WSP(bf16, WS_A2)
#define A3 WSP(bf16, WS_A3)
#define PJ WSP(bf16, WS_PJ)
#define HB WSP(bf16, WS_H)
#define SSP1 WSP(float, WS_SSP1)
#define SSP3 WSP(float, WS_SSP3)
#define SC4 WSP(float, WS_SC4)
#define X2 WSP(float, WS_X2)
#define SC5 WSP(float, WS_SC5)
#define SC6 WSP(float, WS_SC6)
#define SC7 WSP(float, WS_SC7)
#define SS1S WSP(float, WS_SS1S)

__global__ void __launch_bounds__(NWAVES * 64, 2) mk_fwd(Args args) {
    extern __shared__ __attribute__((aligned(16))) unsigned char lds_raw[];
    Frame F;
    F.lds = (LAS unsigned char*)lds_raw;
    F.MISC = (volatile LAS unsigned*)(F.lds + MISC_OFF);
    F.tid = threadIdx.x; F.lane = F.tid & 63; F.wave = __builtin_amdgcn_readfirstlane(F.tid >> 6);
    F.G = gridDim.x; { const int bx = blockIdx.x; F.vcu = (F.G % 8 == 0) ? (bx % 8) * (F.G / 8) + bx / 8 : bx; }
    F.ctl = (gu32*)(args.ws + WS_CTL);
    for (int u = F.tid; u < (LDS_BYTES - LDSCTL_OFF) / 4; u += NWAVES * 64) ((LAS unsigned*)(F.lds + LDSCTL_OFF))[u] = 0u;
    __syncthreads();
    if (F.wave == 0) {
        const float a = args.in[9][F.lane] * args.in[10][F.lane], b = args.in[11][F.lane] * args.in[12][F.lane];
        const float lam = fexpn(wave_sum(a)) - fexpn(wave_sum(b)) + LAM_INIT;
        if (F.lane == 0) F.MISC[4] = __float_as_uint(lam);
    }
    XcdBarrier bar; bar.bar = (unsigned*)(F.ctl + CW_BAR); bar.x = 0; bar.st = nullptr;
    if (MK_N_LAUNCHES == 1) bar = xcd_barrier_post((unsigned*)(F.ctl + CW_BAR), F.MISC + 8);
    __syncthreads();
#define GRID_BAR() do { if (MK_N_LAUNCHES == 1) xcd_barrier(bar); } while (0)
    const int lo = args.ph_lo, hi = args.ph_hi;
#ifndef PH_MASK
#define PH_MASK 0x1ff
#endif
#ifndef PROBE_REP
#define PROBE_REP -1
#endif
#ifndef PROBE_MASK
#define PROBE_MASK 0
#endif
#define REPN(k) (((PROBE_REP) == (k) || (((PROBE_MASK) >> ((k) >= 20 ? (k) - 8 : (k))) & 1)) ? 2 : 1)
#define IN(k) ((((PH_MASK) >> (k)) & 1) && lo <= (k) && (k) < hi)
#define BOTH(k) (IN(k) && IN((k) + 1))
    const int gw = F.vcu * NWAVES + F.wave, NGW = F.G * NWAVES;

    if (IN(0)) {
        int tl_ = threadIdx.x; asm volatile("" : "+v"(tl_)); const int lane = tl_ & 63;
        LAS float* scr = (LAS float*)(F.lds + RING_OFF + F.wave * 16384);
        constexpr int I_IN = (D / 64) * (NIN / 32), I_O = (D / 64) * (D / 32), I_UP = (D / 64) * (FF / 32), I_DN = (FF / 64) * (D / 32), I_G = I_O, I_P = (PLE / 64) * (D / 32);
        constexpr int NITEMS = I_IN + I_O + I_UP + I_DN + I_G + I_P;
        _Pragma("unroll") for (int rep_ = 0; rep_ < REPN(0); ++rep_) {
        for (int it = gw; it < NITEMS; it += NGW) {
            int r = it;
            if (r < I_IN) { p0_transpose_item(w_in, D, NIN, WinT, nullptr, scr, r, lane); continue; } r -= I_IN;
            if (r < I_O) { p0_transpose_item(w_out, D, D, WoutT, nullptr, scr, r, lane); continue; } r -= I_O;
            if (r < I_UP) { p0_transpose_item(w_up, D, FF, WupT, g_ffn, scr, r, lane); continue; } r -= I_UP;
            if (r < I_DN) { p0_transpose_item(w_down, FF, D, WdnT, nullptr, scr, r, lane); continue; } r -= I_DN;
            if (r < I_G) { p0_transpose_item(w_gate, D, D, WgT, nullptr, scr, r, lane); continue; } r -= I_G;
            p0_transpose_item(w_proj, PLE, D, WpT, nullptr, scr, r, lane);
        }
        for (int m = gw; m < MT; m += NGW) {
            if (m < MP + MS) {
                const float* xr = m < MP ? x_prompt + (size_t)m * D : x_sample + (size_t)(m - MP) * D;
                const float* pr = m < MP ? p_prompt + (size_t)m * PLE : p_sample + (size_t)(m - MP) * PLE;
                const f32x4 pv = __builtin_nontemporal_load((const f32x4*)pr + lane);
                rms_row_to_bf16(xr, g_mix, XN + (size_t)m * D, lane);
                ((unsigned long long*)(PB + (size_t)m * PLE))[lane] = (unsigned long long)pk2(pv.x, pv.y) | ((unsigned long long)pk2(pv.z, pv.w) << 32);
            } else {
                unsigned long long* o8 = (unsigned long long*)(XN + (size_t)m * D) + lane;
#pragma unroll
                for (int j = 0; j < 4; ++j) o8[64 * j] = 0ull;
                ((unsigned long long*)(PB + (size_t)m * PLE))[lane] = 0ull;
            }
        }
        }
        { v4u* z = (v4u*)(args.ws + WS_SC4); const size_t nz = (WS_SC_END - WS_SC4) / 16;
          for (size_t i = (size_t)blockIdx.x * (NWAVES * 64) + tl_; i < nz; i += (size_t)F.G * (NWAVES * 64)) z[i] = (v4u){0u, 0u, 0u, 0u}; }
        if (BOTH(0)) GRID_BAR();
    }

    if (IN(1)) {
        { pg8::Gemm g{XN, WinT, MT, NIN, D}; pg8::StaticOrder S; S.init(MT, NIN, F.G, (int)blockIdx.x);
          pg8::EpiIn E{Qb, LOGF, OUTP, hgrn_lb};
          _Pragma("unroll") for (int rep_ = 0; rep_ < REPN(10); ++rep_) pg8::gemm_phase<pg8::EpiIn, pg8::StaticOrder, true, true>(F.lds + RING_OFF, g, S, E); }
        { pg8::Gemm g{PB, WpT, MT, D, PLE}; pg8::StaticOrder S; S.init(MT, D, F.G, (int)(F.G - 1 - blockIdx.x));
          pg8::EpiBf E{PJ, D};
          _Pragma("unroll") for (int rep_ = 0; rep_ < REPN(11); ++rep_) pg8::gemm_phase<pg8::EpiBf, pg8::StaticOrder, true, true>(F.lds + RING_OFF, g, S, E); }
        if (BOTH(1)) GRID_BAR();
    }

    if (IN(2)) {
        const float lam = __uint_as_float(F.MISC[4]);
#ifndef SKIP_DEC
        if ((int)blockIdx.x >= DEC_FIRST_FROM) for (;;) {
            if (F.tid == 0) F.MISC[1] = __hip_atomic_fetch_add(F.ctl + CW_QD, 1u, RLX_AGENT);
            LGKM_BAR();
            const int idx = (int)F.MISC[1];
            if (idx >= 512) break;
            dec::unit(idx >> 2, idx & 3, Qb, Kb, Vb, cache_k, cache_v, ptab, MIX, lam, g_subln, F.lds + RING_OFF);
        }
#endif
#ifndef SKIP_HG
        _Pragma("unroll") for (int rep_ = 0; rep_ < REPN(20); ++rep_) if (blockIdx.x < 32) hg::unit((int)blockIdx.x, RQ, RK, RV, LOGF, OREC, OUTP + OUT_SP, F.lds + RING_OFF);
#endif
#ifndef SKIP_ATT
        _Pragma("unroll") for (int rep_ = 0; rep_ < REPN(21); ++rep_) for (;;) {
            if (F.tid == 0) F.MISC[0] = __hip_atomic_fetch_add(F.ctl + CW_QA + 256 * rep_, 1u, RLX_AGENT);
            LGKM_BAR();
            const int idx = (int)F.MISC[0];
            if (idx >= 512) break;
            const int qblk = 15 - (idx >> 5), bh = idx & 31;
            att::unit(bh >> 2, bh & 3, qblk, Qb, Kb, Vb, MIX, lam, g_subln, F.lds + RING_OFF);
        }
#endif
#ifndef SKIP_DEC
        _Pragma("unroll") for (int rep_ = 0; rep_ < REPN(22); ++rep_) for (;;) {
            if (F.tid == 0) F.MISC[1] = __hip_atomic_fetch_add(F.ctl + CW_QD + 256 * rep_, 1u, RLX_AGENT);
            LGKM_BAR();
            const int idx = (int)F.MISC[1];
            if (idx >= 512) break;
            dec::unit(idx >> 2, idx & 3, Qb, Kb, Vb, cache_k, cache_v, ptab, MIX, lam, g_subln, F.lds + RING_OFF);
        }
#endif
        _Pragma("unroll") for (int rep_ = 0; rep_ < REPN(23); ++rep_) for (int it = F.vcu; it < 512; it += F.G) hgrn_step(it >> 2, it & 3, RQ, RK, RV, LOGF, state0, OUTP + OUT_SS, OREC, F.lds + RING_OFF);
        if (BOTH(2)) GRID_BAR();
    }

    if (IN(3)) {
        int tl_ = threadIdx.x; asm volatile("" : "+v"(tl_)); const int lane = tl_ & 63;
        _Pragma("unroll") for (int rep_ = 0; rep_ < REPN(3); ++rep_) for (int m = gw; m < MP + MS; m += NGW) {
            const v4u ow = ((const v4u*)(OREC + (size_t)m * RW))[lane]; const v4u gw4 = ((const v4u*)(RG + (size_t)m * RW))[lane];
            float o[8] = {bflo(ow.x), bfhi(ow.x), bflo(ow.y), bfhi(ow.y), bflo(ow.z), bfhi(ow.z), bflo(ow.w), bfhi(ow.w)};
            const float gt[8] = {bflo(gw4.x), bfhi(gw4.x), bflo(gw4.y), bfhi(gw4.y), bflo(gw4.z), bfhi(gw4.z), bflo(gw4.w), bfhi(gw4.w)};
            float s = 0.f;
#pragma unroll
            for (int j = 0; j < 8; ++j) s += o[j] * o[j];
            const float r = 1.0f / sqrtf(wave_sum(s) * (1.f / RW) + EPS);
            const f32x4 g0 = ((const f32x4*)g_rec)[2 * lane], g1 = ((const f32x4*)g_rec)[2 * lane + 1];
            v4u w; w.x = pk2(o[0] * r * g0.x * gt[0], o[1] * r * g0.y * gt[1]); w.y = pk2(o[2] * r * g0.z * gt[2], o[3] * r * g0.w * gt[3]);
            w.z = pk2(o[4] * r * g1.x * gt[4], o[5] * r * g1.y * gt[5]); w.w = pk2(o[6] * r * g1.z * gt[6], o[7] * r * g1.w * gt[7]);
            ((v4u*)(MIX + (size_t)m * D + AW))[lane] = w;
        }
        if (BOTH(3)) GRID_BAR();
    }

    if (IN(4)) {
        pg8::Gemm g{MIX, WoutT, MP, D, D}; pg8::StaticOrder S; S.init(MP, D, F.G, (int)blockIdx.x);
        pg8::EpiOut E{x_prompt, x_sample, X1, A2, SSP1};
        _Pragma("unroll") for (int rep_ = 0; rep_ < REPN(4); ++rep_) pg8::gemm_phase<pg8::EpiOut, pg8::StaticOrder, true, true>(F.lds + RING_OFF, g, S, E);
        for (int it = blockIdx.x; it < 256; it += F.G) samp_item<4, D, D, 64>(it, MIX + (size_t)MP * D, nullptr, nullptr, nullptr, nullptr, nullptr, WoutT, SC4);
        if (BOTH(4)) GRID_BAR();
    }
    if (IN(5)) {
        pg8::Gemm g{A2, WupT, MP, FF, D}; pg8::StaticOrder S; S.init(MP, FF, F.G, (int)blockIdx.x);
        pg8::EpiUp E{HB, FF};
        _Pragma("unroll") for (int rep_ = 0; rep_ < REPN(5); ++rep_) pg8::gemm_phase<pg8::EpiUp, pg8::StaticOrder, true, true>(F.lds + RING_OFF, g, S, E);
        for (int it = blockIdx.x; it < 256; it += F.G) samp_item<5, FF, D, 256>(it, nullptr, x_sample, SC4, nullptr, nullptr, SS1S, WupT, SC5);
        if (BOTH(5)) GRID_BAR();
    }
    if (IN(6)) {
        pg8::Gemm g{HB, WdnT, MP, D, FF}; pg8::StaticOrder S; S.init(MP, D, F.G, (int)blockIdx.x);
        pg8::EpiDown E{X1, X2, A3, SSP1};
        _Pragma("unroll") for (int rep_ = 0; rep_ < REPN(6); ++rep_) pg8::gemm_phase<pg8::EpiDown, pg8::StaticOrder, true, true>(F.lds + RING_OFF, g, S, E);
        for (int it = blockIdx.x; it < 256; it += F.G) samp_item<6, D, FF, 256>(it, nullptr, nullptr, nullptr, SC5, nullptr, nullptr, WdnT, SC6);
        if (BOTH(6)) GRID_BAR();
    }
    if (IN(7)) {
        pg8::Gemm g{A3, WgT, MP, D, D}; pg8::StaticOrder S; S.init(MP, D, F.G, (int)blockIdx.x);
        pg8::EpiGate E{X2, PJ, X1, SSP3};
        _Pragma("unroll") for (int rep_ = 0; rep_ < REPN(7); ++rep_) pg8::gemm_phase<pg8::EpiGate, pg8::StaticOrder, true, true>(F.lds + RING_OFF, g, S, E);
        for (int it = blockIdx.x; it < 256; it += F.G) samp_item<7, D, D, 64>(it, nullptr, x_sample, SC4, nullptr, SC6, SS1S, WgT, SC7);
        if (BOTH(7)) GRID_BAR();
    }
    if (IN(8)) {
        int tl_ = threadIdx.x; asm volatile("" : "+v"(tl_)); const int lane = tl_ & 63;
        _Pragma("unroll") for (int rep_ = 0; rep_ < REPN(8); ++rep_) for (int m = gw; m < MP; m += NGW) {
            float* yr = OUTP + OUT_YP + (size_t)m * D; const f32x4* x4 = (const f32x4*)(X1 + (size_t)m * D) + lane;
            const f32x4* sp = (const f32x4*)(SSP3 + (size_t)m * 16);
            const f32x4 ps = (sp[0] + sp[1]) + (sp[2] + sp[3]);
            const float r = 1.0f / sqrtf(((ps.x + ps.y) + (ps.z + ps.w)) * (1.f / D) + EPS);
            f32x4* y4 = (f32x4*)yr + lane; const f32x4* g4 = (const f32x4*)g_final + lane;
#pragma unroll
            for (int j = 0; j < 4; ++j) { const f32x4 v = x4[64 * j], gg = g4[64 * j]; y4[64 * j] = v * r * gg; }
        }
        for (int sr = NGW - 1 - gw; sr < MS; sr += NGW) {
            const float r2 = 1.0f / (SS1S[sr] * (1.0f / D) + EPS);
            const f32x4* xs4 = (const f32x4*)(x_sample + (size_t)sr * D) + lane; const f32x4* c4 = (const f32x4*)(SC4 + (size_t)sr * D) + lane;
            const f32x4* c6 = (const f32x4*)(SC6 + (size_t)sr * D) + lane; const f32x4* c7 = (const f32x4*)(SC7 + (size_t)sr * D) + lane;
            const u32x2v* pj = (const u32x2v*)(PJ + (size_t)(MP + sr) * D) + lane;
            f32x4 v[4]; float s = 0.f;
#pragma unroll
            for (int j = 0; j < 4; ++j) { const f32x4 x2 = xs4[64 * j] + c4[64 * j] + c6[64 * j] * r2, gt = c7[64 * j]; const u32x2v pw = pj[64 * j];
                v[j].x = x2.x + pg8::sigmoidf_(gt.x) * bflo(pw.x); v[j].y = x2.y + pg8::sigmoidf_(gt.y) * bfhi(pw.x); v[j].z = x2.z + pg8::sigmoidf_(gt.z) * bflo(pw.y); v[j].w = x2.w + pg8::sigmoidf_(gt.w) * bfhi(pw.y);
                s += (v[j].x * v[j].x + v[j].y * v[j].y) + (v[j].z * v[j].z + v[j].w * v[j].w); }
            const float r = 1.0f / sqrtf(wave_sum(s) * (1.f / D) + EPS);
            f32x4* y4 = (f32x4*)(OUTP + OUT_YS + (size_t)sr * D) + lane; const f32x4* g4 = (const f32x4*)g_final + lane;
#pragma unroll
            for (int j = 0; j < 4; ++j) y4[64 * j] = v[j] * r * g4[64 * j];
        }
    }
#undef IN
#undef BOTH
#undef GRID_BAR
}

#undef x_prompt
#undef x_sample
#undef cache_k
#undef cache_v
#undef state0
#undef ptab
#undef p_prompt
#undef p_sample
#undef w_in
#undef g_subln
#undef hgrn_lb
#undef g_rec
#undef w_out
#undef g_mix
#undef g_ffn
#undef w_up
#undef w_down
#undef w_gate
#undef w_proj
#undef g_final
#undef OUTP
#undef WSP
#undef WinT
#undef WoutT
#undef WupT
#undef WdnT
#undef WgT
#undef WpT
#undef XN
#undef PB
#undef Qb
#undef Kb
#undef Vb
#undef RQ
#undef RK
#undef RV
#undef RG
#undef LOGF
#undef OREC
#undef MIX
#undef X1
#undef A2
#undef A3
#undef PJ
#undef HB
#undef SSP1
#undef SSP3
#undef SC4
#undef X2
#undef SC5
#undef SC6
#undef SC7
#undef SS1S
extern "C" void kernel_launch(void* const* d_in, const int* in_sizes, int n_in, void* d_out, int out_size, void* d_ws, size_t ws_size, hipStream_t stream) {
    static int grid = 0;
    if (grid == 0) {
        if (n_in != 24 || in_sizes[0] != MP * D || (size_t)out_size != OUT_END || ws_size < WS_END) {
            fprintf(stderr, "kernel_launch: unexpected shapes: n_in %d, in0 %d, out %d, ws %zu; nothing launched\n", n_in, n_in > 0 ? in_sizes[0] : -1, out_size, ws_size); grid = -1; return; }
        int dev = 0, cus = 0, per_cu = 0;
        if (hipGetDevice(&dev) != hipSuccess || hipDeviceGetAttribute(&cus, hipDeviceAttributeMultiprocessorCount, dev) != hipSuccess) { grid = -1; return; }
        if (hipFuncSetAttribute((const void*)mk_fwd, hipFuncAttributeMaxDynamicSharedMemorySize, LDS_BYTES) != hipSuccess) { fprintf(stderr, "kernel_launch: hipFuncSetAttribute failed\n"); grid = -1; return; }
        if (hipOccupancyMaxActiveBlocksPerMultiprocessor(&per_cu, (const void*)mk_fwd, NWAVES * 64, LDS_BYTES) != hipSuccess || per_cu < 1) {
            fprintf(stderr, "kernel_launch: occupancy query reports %d workgroups per CU; nothing launched\n", per_cu); (void)hipGetLastError(); grid = -1; return; }
        (void)hipGetLastError();
        grid = cus;
    }
    if (grid < 0) return;
    if (hipMemsetAsync((char*)d_ws + WS_CTL, 0, CTL_ZERO_BYTES, stream) != hipSuccess) return;
    Args a{};
    for (int i = 0; i < 24; ++i) a.in[i] = (const float*)d_in[i];
    a.out = (float*)d_out; a.ws = (unsigned char*)d_ws;
    if (MK_N_LAUNCHES == 1) {
        a.ph_lo = 0; a.ph_hi = N_PHASES; a.li = 0;
        hipLaunchKernelGGL(mk_fwd, dim3(grid), dim3(NWAVES * 64), LDS_BYTES, stream, a);
    } else {
        for (int li = 0; li < N_PHASES; ++li) { a.ph_lo = li; a.ph_hi = li + 1; a.li = li; hipLaunchKernelGGL(mk_fwd, dim3(grid), dim3(NWAVES * 64), LDS_BYTES, stream, a); }
    }
}
```

```cpp
#include <hip/hip_runtime.h>
#include <hip/hip_bf16.h>
#include <cstdio>
#include <cstdint>
#include <cmath>

#ifndef MK_N_LAUNCHES
#define MK_N_LAUNCHES 1
#endif

constexpr int D = 1024, NB = 8, SEQ = 2048, MP = NB * SEQ, MS = 128, MT = 16640  ;
constexpr int NIN = 3584, FF = 4096, PLE = 256, AW = 512, RW = 512, NPAGES = 16, PAGE = 128;
constexpr float EPS = 1e-6f;
constexpr float LOG2E = 1.4426950408889634f;
constexpr float QSCALE = 0.125f * LOG2E;
constexpr float LAM_INIT = 0.2f;
constexpr size_t OUT_YP = 0, OUT_YS = OUT_YP + (size_t)MP * D, OUT_KP = OUT_YS + (size_t)MS * D, OUT_VP = OUT_KP + (size_t)MP * AW, OUT_SP = OUT_VP + (size_t)MP * AW,
                 OUT_KS = OUT_SP + (size_t)NB * 4 * 128 * 128, OUT_VS = OUT_KS + (size_t)MS * AW, OUT_SS = OUT_VS + (size_t)MS * AW, OUT_END = OUT_SS + (size_t)MS * 4 * 128 * 128;

namespace pg8 {
#define PG8_LAS __attribute__((address_space(3)))
typedef unsigned short bf16_t;
typedef short bf16x8 __attribute__((ext_vector_type(8)));
typedef float f32x4 __attribute__((ext_vector_type(4)));
typedef unsigned u32x4 __attribute__((ext_vector_type(4)));
typedef unsigned u32x2 __attribute__((ext_vector_type(2)));
constexpr int BM = 256, BK = 64, HALF = 128, HTB = HALF * BK * 2  , STAGE_BYTES = 8 * HTB, NXCD = 8, WGM = 8;

__host__ __device__ __forceinline__ int lds_byte(int r, int c) { const int st = (r >> 4) * 2 + (c >> 5), rr = r & 15, cc = c & 31, ob = rr * 64 + cc * 2; return st * 1024 + (ob ^ (((ob >> 9) & 1) << 5)); }
__host__ __device__ __forceinline__ void stage_rc(int b, int& R, int& C) { const int st = b / 1024, sb = b % 1024, swz = sb ^ (((sb >> 9) & 1) << 5); R = (st >> 1) * 16 + swz / 64; C = (st & 1) * 32 + (swz % 64) / 2; }
__host__ __device__ __forceinline__ int perm32(int rho) { const int n = rho >> 4, i = rho & 15; return 8 * (i >> 2) + 4 * n + (i & 3); }

struct Unit { int pm, pn; };
struct Gemm { const bf16_t* A; const bf16_t* Bt; int M, N, K; };

struct StaticOrder {
    int nM, nN, nwg, G, c;
    __host__ __device__ void init(int M, int N, int G_, int c_) { nM = M / BM; nN = N / BM; nwg = nM * nN; G = G_; c = c_; }
    __host__ __device__ bool next(int i, Unit& u) const {
        const long L = (long)i * G + c; if (L >= nwg) return false;
        int wgid = (int)L; { const int q = nwg / NXCD, r = nwg % NXCD, xcd = wgid % NXCD, off = wgid / NXCD; wgid = (xcd < r ? xcd * (q + 1) : r * (q + 1) + (xcd - r) * q) + off; }
        const int nig = WGM * nN, gid = wgid / nig, fm = gid * WGM, gsz = (nM - fm) < WGM ? (nM - fm) : WGM;
        u.pm = fm + ((wgid % nig) % gsz); u.pn = (wgid % nig) / gsz; return true;
    }
    __device__ __forceinline__ void a_ready(const Unit&) const {}
    __device__ __forceinline__ void done(const Unit&) const {}
};

__device__ __forceinline__ unsigned cvt_pk_bf16(float lo, float hi) { unsigned r; asm volatile("v_cvt_pk_bf16_f32 %0, %1, %2" : "=v"(r) : "v"(lo), "v"(hi)); return r; }
__device__ __forceinline__ u32x4 pack8(const f32x4 v0, const f32x4 v1) { u32x4 w; w.x = cvt_pk_bf16(v0[0], v0[1]); w.y = cvt_pk_bf16(v0[2], v0[3]); w.z = cvt_pk_bf16(v1[0], v1[1]); w.w = cvt_pk_bf16(v1[2], v1[3]); return w; }
__device__ __forceinline__ float fexp(float x) { return __builtin_amdgcn_exp2f(x * 1.4426950408889634f); }
__device__ __forceinline__ float frcp(float x) { return __builtin_amdgcn_rcpf(x); }
__device__ __forceinline__ float sigmoidf_(float x) { return frcp(1.0f + fexp(-x)); }
__device__ __forceinline__ float siluf_(float x) { return x * sigmoidf_(x); }
__device__ __forceinline__ f32x4 map4_silu(f32x4 v) { return (f32x4){siluf_(v[0]), siluf_(v[1]), siluf_(v[2]), siluf_(v[3])}; }

struct EpiIn {
    static constexpr bool PERM = true, AFTER_DRAIN = false;
    bf16_t* Q0; float* LOGF; float* out; const float* hlb;
    static constexpr size_t BUFSTRIDE = (size_t)17 * 1024 * 1024 / 2;
    __device__ __forceinline__ void operator()(const f32x4 (&acc)[2][2][4][2], const Unit& u, int wr, int wc, int fr, int fq) const {
        const int type = u.pn >> 1;
        const int cb = (u.pn & 1) * 256 + wc * 32 + 8 * fq;
        const int row0 = u.pm * BM + wr * 64 + fr;
        const bool prow = u.pm < 64;
        if (type == 0 || type == 3 || type == 5 || type == 6) {
            bf16_t* base = Q0 + (size_t)type * BUFSTRIDE;
#pragma unroll
            for (int ai = 0; ai < 2; ++ai)
#pragma unroll
                for (int m = 0; m < 4; ++m) { bf16_t* rowp = base + (size_t)(row0 + ai * HALF + m * 16) * 512 + cb;
#pragma unroll
                    for (int bj = 0; bj < 2; ++bj) { f32x4 v0 = acc[ai][bj][m][0], v1 = acc[ai][bj][m][1];
                        if (type == 0) { v0 = v0 * QSCALE; v1 = v1 * QSCALE; }
                        else if (type != 5) { v0 = map4_silu(v0); v1 = map4_silu(v1); }
                        *(u32x4*)(rowp + bj * HALF) = pack8(v0, v1); } }
        } else if (type == 1 || type == 2) {
            bf16_t* base = Q0 + (size_t)type * BUFSTRIDE;
            float* ob = out + (type == 1 ? (prow ? OUT_KP : OUT_KS) : (prow ? OUT_VP : OUT_VS));
#pragma unroll
            for (int ai = 0; ai < 2; ++ai)
#pragma unroll
                for (int m = 0; m < 4; ++m) { const int row = row0 + ai * HALF + m * 16; bf16_t* rowp = base + (size_t)row * 512 + cb;
                    const bool ok = prow || ai == 0; float* orow = ob + (size_t)(prow ? row : row - MP) * 512 + cb;
#pragma unroll
                    for (int bj = 0; bj < 2; ++bj) { const f32x4 v0 = acc[ai][bj][m][0], v1 = acc[ai][bj][m][1];
                        *(u32x4*)(rowp + bj * HALF) = pack8(v0, v1);
                        if (ok) { *(f32x4*)(orow + bj * HALF) = v0; *(f32x4*)(orow + bj * HALF + 4) = v1; } } }
        } else {
#pragma unroll
            for (int bj = 0; bj < 2; ++bj) {
                f32x4 lb[2];
#pragma unroll
                for (int n = 0; n < 2; ++n) { const f32x4 l0 = *(const f32x4*)(hlb + cb + bj * HALF + 4 * n), l1 = *(const f32x4*)(hlb + 512 + cb + bj * HALF + 4 * n);
#pragma unroll
                    for (int j = 0; j < 4; ++j) lb[n][j] = frcp(1.0f + fexp(l1[j] - l0[j])); }
#pragma unroll
                for (int ai = 0; ai < 2; ++ai)
#pragma unroll
                    for (int m = 0; m < 4; ++m) { const size_t ro = (size_t)(row0 + ai * HALF + m * 16) * 512 + cb + bj * HALF; f32x4 lf[2], kk[2];
#pragma unroll
                        for (int n = 0; n < 2; ++n)
#pragma unroll
                            for (int j = 0; j < 4; ++j) { const float x = acc[ai][bj][m][n][j], e = fexp(-x), sg = frcp(1.0f + e), l = lb[n][j];
                                const float f = l + (1.0f - l) * sg; lf[n][j] = __builtin_amdgcn_logf(f) * 0.6931471805599453f; kk[n][j] = (1.0f - l) * (e * sg); }
                        *(f32x4*)(LOGF + ro) = lf[0]; *(f32x4*)(LOGF + ro + 4) = lf[1];
                        *(u32x4*)(Q0 + 4 * BUFSTRIDE + ro) = pack8(kk[0], kk[1]); }
            }
        }
    }
};

struct EpiBf {
    static constexpr bool PERM = true, AFTER_DRAIN = false;
    bf16_t* O; int ldc;
    __device__ __forceinline__ void operator()(const f32x4 (&acc)[2][2][4][2], const Unit& u, int wr, int wc, int fr, int fq) const {
        const int row0 = u.pm * BM + wr * 64 + fr, col0 = u.pn * BM + wc * 32 + 8 * fq;
#pragma unroll
        for (int ai = 0; ai < 2; ++ai)
#pragma unroll
            for (int m = 0; m < 4; ++m) { bf16_t* rowp = O + (size_t)(row0 + ai * HALF + m * 16) * ldc + col0;
#pragma unroll
                for (int bj = 0; bj < 2; ++bj) *(u32x4*)(rowp + bj * HALF) = pack8(acc[ai][bj][m][0], acc[ai][bj][m][1]); }
    }
};
struct EpiUp {
    static constexpr bool PERM = true, AFTER_DRAIN = false;
    bf16_t* O; int ldc;
    __device__ __forceinline__ void operator()(const f32x4 (&acc)[2][2][4][2], const Unit& u, int wr, int wc, int fr, int fq) const {
        const int row0 = u.pm * BM + wr * 64 + fr, col0 = u.pn * BM + wc * 32 + 8 * fq;
#pragma unroll
        for (int ai = 0; ai < 2; ++ai)
#pragma unroll
            for (int m = 0; m < 4; ++m) { bf16_t* rowp = O + (size_t)(row0 + ai * HALF + m * 16) * ldc + col0;
#pragma unroll
                for (int bj = 0; bj < 2; ++bj) { f32x4 v0 = acc[ai][bj][m][0], v1 = acc[ai][bj][m][1];
#pragma unroll
                    for (int j = 0; j < 4; ++j) { const float a = fmaxf(v0[j], 0.f), b = fmaxf(v1[j], 0.f); v0[j] = a * a; v1[j] = b * b; }
                    *(u32x4*)(rowp + bj * HALF) = pack8(v0, v1); } }
    }
};
struct EpiOut {
    static constexpr bool PERM = true, AFTER_DRAIN = false;
    const float* xp; const float* xs; float* X1; bf16_t* A2; float* SSP;
    __device__ __forceinline__ void operator()(const f32x4 (&acc)[2][2][4][2], const Unit& u, int wr, int wc, int fr, int fq) const {
        const int row0 = u.pm * BM + wr * 64 + fr, col0 = u.pn * BM + wc * 32 + 8 * fq; const bool prow = u.pm < 64;
#pragma unroll
        for (int ai = 0; ai < 2; ++ai) { if (!prow && ai == 1) break;
#pragma unroll
            for (int m = 0; m < 4; ++m) { const int row = row0 + ai * HALF + m * 16; const float* xr = (prow ? xp + (size_t)row * D : xs + (size_t)(row - MP) * D) + col0;
                float s = 0.f;
#pragma unroll
                for (int bj = 0; bj < 2; ++bj) { const f32x4 a0 = *(const f32x4*)(xr + bj * HALF), a1 = *(const f32x4*)(xr + bj * HALF + 4);
                    const f32x4 v0 = a0 + acc[ai][bj][m][0], v1 = a1 + acc[ai][bj][m][1];
                    s += (v0[0] * v0[0] + v0[1] * v0[1]) + (v0[2] * v0[2] + v0[3] * v0[3]) + (v1[0] * v1[0] + v1[1] * v1[1]) + (v1[2] * v1[2] + v1[3] * v1[3]);
                    float* o = X1 + (size_t)row * D + col0 + bj * HALF; *(f32x4*)o = v0; *(f32x4*)(o + 4) = v1;
                    *(u32x4*)(A2 + (size_t)row * D + col0 + bj * HALF) = pack8(v0, v1); }
                s += __shfl_xor(s, 16); s += __shfl_xor(s, 32);
                if (fq == 0) SSP[(size_t)row * 16 + u.pn * 4 + wc] = s; } }
    }
};
struct EpiDown {
    static constexpr bool PERM = true, AFTER_DRAIN = false;
    const float* X1; float* X2; bf16_t* A3; const float* SSP;
    __device__ __forceinline__ void operator()(const f32x4 (&acc)[2][2][4][2], const Unit& u, int wr, int wc, int fr, int fq) const {
        const int row0 = u.pm * BM + wr * 64 + fr, col0 = u.pn * BM + wc * 32 + 8 * fq; const bool prow = u.pm < 64;
#pragma unroll
        for (int ai = 0; ai < 2; ++ai) { if (!prow && ai == 1) break;
#pragma unroll
            for (int m = 0; m < 4; ++m) { const int row = row0 + ai * HALF + m * 16;
                const f32x4 p0 = *(const f32x4*)(SSP + (size_t)row * 16), p1 = *(const f32x4*)(SSP + (size_t)row * 16 + 4), p2 = *(const f32x4*)(SSP + (size_t)row * 16 + 8), p3 = *(const f32x4*)(SSP + (size_t)row * 16 + 12);
                const f32x4 ps = (p0 + p1) + (p2 + p3); const float ss = (ps[0] + ps[1]) + (ps[2] + ps[3]);
                const float r2 = frcp(ss * (1.0f / D) + EPS);
#pragma unroll
                for (int bj = 0; bj < 2; ++bj) { const float* xi = X1 + (size_t)row * D + col0 + bj * HALF; float* o = X2 + (size_t)row * D + col0 + bj * HALF;
                    const f32x4 v0 = *(const f32x4*)xi + acc[ai][bj][m][0] * r2, v1 = *(const f32x4*)(xi + 4) + acc[ai][bj][m][1] * r2;
                    *(f32x4*)o = v0; *(f32x4*)(o + 4) = v1;
                    *(u32x4*)(A3 + (size_t)row * D + col0 + bj * HALF) = pack8(v0, v1); } } }
    }
};
struct EpiGate {
    static constexpr bool PERM = true, AFTER_DRAIN = false;
    const float* X1; const bf16_t* PJ; float* out; float* SSP;
    __device__ __forceinline__ void operator()(const f32x4 (&acc)[2][2][4][2], const Unit& u, int wr, int wc, int fr, int fq) const {
        const int row0 = u.pm * BM + wr * 64 + fr, col0 = u.pn * BM + wc * 32 + 8 * fq; const bool prow = u.pm < 64;
#pragma unroll
        for (int ai = 0; ai < 2; ++ai) { if (!prow && ai == 1) break;
#pragma unroll
            for (int m = 0; m < 4; ++m) { const int row = row0 + ai * HALF + m * 16; float* orow = out + (size_t)row * D + col0;
                float s = 0.f;
#pragma unroll
                for (int bj = 0; bj < 2; ++bj) { const float* xr = X1 + (size_t)row * D + col0 + bj * HALF; const f32x4 a0 = *(const f32x4*)xr, a1 = *(const f32x4*)(xr + 4);
                    const u32x4 pj = *(const u32x4*)(PJ + (size_t)row * D + col0 + bj * HALF);
                    f32x4 v0, v1;
#pragma unroll
                    for (int j = 0; j < 4; ++j) { const unsigned w0 = pj[j >> 1], w1 = pj[2 + (j >> 1)];
                        const float pa = __uint_as_float((j & 1) ? (w0 & 0xffff0000u) : (w0 << 16)), pb = __uint_as_float((j & 1) ? (w1 & 0xffff0000u) : (w1 << 16));
                        v0[j] = a0[j] + sigmoidf_(acc[ai][bj][m][0][j]) * pa; v1[j] = a1[j] + sigmoidf_(acc[ai][bj][m][1][j]) * pb; }
                    s += (v0[0] * v0[0] + v0[1] * v0[1]) + (v0[2] * v0[2] + v0[3] * v0[3]) + (v1[0] * v1[0] + v1[1] * v1[1]) + (v1[2] * v1[2] + v1[3] * v1[3]);
                    *(f32x4*)(orow + bj * HALF) = v0; *(f32x4*)(orow + bj * HALF + 4) = v1; }
                s += __shfl_xor(s, 16); s += __shfl_xor(s, 32);
                if (fq == 0) SSP[(size_t)row * 16 + u.pn * 4 + wc] = s; } }
    }
};

template <class Epi, class Sched, bool ALIGN_EPI = false, bool SP2 = false>
__device__ __forceinline__ void gemm_phase(PG8_LAS unsigned char* lds, const Gemm g, const Sched& S, const Epi& E) {
    const int tid = threadIdx.x, wid = __builtin_amdgcn_readfirstlane(tid >> 6), lane = tid & 63, wr = wid >> 2, wc = wid & 3, fr = lane & 15, fq = lane >> 4;
    const int K = g.K, nt = K / BK;
    unsigned voffA[2], voffB[2];
#pragma unroll
    for (int i = 0; i < 2; ++i) { int R, C; stage_rc(tid * 16 + i * 8192, R, C); const int Rb = Epi::PERM ? ((R & ~31) + perm32(R & 31)) : R;
        voffA[i] = (unsigned)(R * K + C) * 2u; voffB[i] = (unsigned)(Rb * K + C) * 2u; }
    const size_t kstep = (size_t)(BK * 2);
    const size_t hstep = (size_t)HALF * K * 2;
    const size_t tstep = 2 * hstep;
    const unsigned ldsw = (unsigned)wid * 1024u;
    const int aoff = lds_byte(wr * 64 + fr, fq * 8), boff = lds_byte(wc * 32 + fr, fq * 8);
#define PG8_SA(b, h) (((b) * 2 + (h)) * HTB)
#define PG8_SB(b, h) ((4 + (b) * 2 + (h)) * HTB)
#define PG8_STAGE(bufoff, gbase, voff) do { _Pragma("unroll") for (int _i = 0; _i < 2; ++_i) \
        __builtin_amdgcn_global_load_lds((const unsigned*)((const char*)(gbase) + (voff)[_i]), (PG8_LAS unsigned*)(lds + (bufoff) + ldsw + _i * 8192), 16, 0, 0); } while (0)
#define PG8_LDA(dst, b, h) do { _Pragma("unroll") for (int m = 0; m < 4; ++m) _Pragma("unroll") for (int k = 0; k < 2; ++k) dst[m][k] = *(const PG8_LAS bf16x8*)(lds + PG8_SA(b, h) + aoff + m * 2048 + k * 1024); } while (0)
#define PG8_LDB(dst, b, h) do { _Pragma("unroll") for (int n = 0; n < 2; ++n) _Pragma("unroll") for (int k = 0; k < 2; ++k) dst[n][k] = *(const PG8_LAS bf16x8*)(lds + PG8_SB(b, h) + boff + n * 2048 + k * 1024); } while (0)
#define PG8_MMA(ai, bj, At, Bt) do { __builtin_amdgcn_s_setprio(1); _Pragma("unroll") for (int m = 0; m < 4; ++m) _Pragma("unroll") for (int n = 0; n < 2; ++n) _Pragma("unroll") for (int k = 0; k < 2; ++k) \
        acc[ai][bj][m][n] = __builtin_amdgcn_mfma_f32_16x16x32_bf16(Bt[n][k], At[m][k], acc[ai][bj][m][n], 0, 0, 0); __builtin_amdgcn_s_setprio(0); } while (0)
#define PG8_WAIT_V(n) asm volatile("s_waitcnt vmcnt(" #n ")" ::: "memory")
#define PG8_WAIT_L(n) asm volatile("s_waitcnt lgkmcnt(" #n ")" ::: "memory")
#define PG8_BAR __builtin_amdgcn_s_barrier()
#define PG8_SCHED __builtin_amdgcn_sched_barrier(0)
    Unit cur, nxt; int ui = 0;
    if (!S.next(0, cur)) return;
    f32x4 acc[2][2][4][2];
#pragma unroll
    for (int a = 0; a < 2; ++a)
#pragma unroll
        for (int b = 0; b < 2; ++b)
#pragma unroll
            for (int m = 0; m < 4; ++m)
#pragma unroll
                for (int n = 0; n < 2; ++n) acc[a][b][m][n] = (f32x4){0.f, 0.f, 0.f, 0.f};
    bf16x8 At[4][2], B0[2][2], B1[2][2];
    const char* cA = (const char*)g.A + (size_t)cur.pm * tstep; const char* cB = (const char*)g.Bt + (size_t)cur.pn * tstep;
    S.a_ready(cur);
    if constexpr (SP2) {
        PG8_STAGE(PG8_SB(0, 0), cB, voffB); PG8_STAGE(PG8_SB(0, 1), cB + hstep, voffB); PG8_STAGE(PG8_SA(0, 0), cA, voffA); PG8_STAGE(PG8_SA(0, 1), cA + hstep, voffA);
        if (wr == 1) PG8_BAR;
        PG8_WAIT_V(2); PG8_BAR;
        PG8_STAGE(PG8_SB(1, 0), cB + kstep, voffB); PG8_STAGE(PG8_SA(1, 0), cA + kstep, voffA); PG8_STAGE(PG8_SB(1, 1), cB + hstep + kstep, voffB);
        PG8_WAIT_V(6); PG8_BAR;
    } else {
        PG8_STAGE(PG8_SB(0, 0), cB, voffB); PG8_STAGE(PG8_SA(0, 0), cA, voffA); PG8_STAGE(PG8_SB(0, 1), cB + hstep, voffB); PG8_STAGE(PG8_SA(0, 1), cA + hstep, voffA);
        if (wr == 1) PG8_BAR;
        PG8_WAIT_V(4); PG8_BAR;
        PG8_STAGE(PG8_SB(1, 0), cB + kstep, voffB); PG8_STAGE(PG8_SA(1, 0), cA + kstep, voffA); PG8_STAGE(PG8_SB(1, 1), cB + hstep + kstep, voffB);
        PG8_WAIT_V(6); PG8_BAR;
    }
    for (;;) {
        const bool has_next = S.next(ui + 1, nxt);
        const char* nA = has_next ? (const char*)g.A + (size_t)nxt.pm * tstep : cA; const char* nB = has_next ? (const char*)g.Bt + (size_t)nxt.pn * tstep : cB;
        for (int t = 0; t < nt; t += 2) {
            const bool last = (t == nt - 2);
            const char* a1 = cA + (size_t)(t + 1) * kstep;
            const char* a2 = last ? nA : cA + (size_t)(t + 2) * kstep; const char* b2 = last ? nB : cB + (size_t)(t + 2) * kstep;
            const char* a3 = a2 + kstep; const char* b3 = b2 + kstep;
            if (last && has_next) S.a_ready(nxt);
            if constexpr (SP2) {
            PG8_LDB(B0, 0, 0); PG8_LDB(B1, 0, 1); PG8_SCHED; PG8_LDA(At, 0, 0); PG8_STAGE(PG8_SA(1, 1), a1 + hstep, voffA);
            PG8_WAIT_V(8); PG8_WAIT_L(0); PG8_BAR; PG8_MMA(0, 0, At, B0); PG8_MMA(0, 1, At, B1); PG8_BAR; PG8_SCHED;
            PG8_LDA(At, 0, 1); PG8_STAGE(PG8_SB(0, 0), b2, voffB); PG8_STAGE(PG8_SB(0, 1), b2 + hstep, voffB); PG8_STAGE(PG8_SA(0, 0), a2, voffA);
            PG8_WAIT_V(8); PG8_WAIT_L(0); PG8_BAR; PG8_MMA(1, 0, At, B0); PG8_MMA(1, 1, At, B1); PG8_BAR; PG8_SCHED;
            PG8_LDB(B0, 1, 0); PG8_LDB(B1, 1, 1); PG8_SCHED; PG8_LDA(At, 1, 0); PG8_STAGE(PG8_SA(0, 1), a2 + hstep, voffA);
            PG8_WAIT_V(8); PG8_WAIT_L(0); PG8_BAR; PG8_MMA(0, 0, At, B0); PG8_MMA(0, 1, At, B1); PG8_BAR; PG8_SCHED;
            PG8_LDA(At, 1, 1); PG8_STAGE(PG8_SB(1, 0), b3, voffB); PG8_STAGE(PG8_SB(1, 1), b3 + hstep, voffB); PG8_STAGE(PG8_SA(1, 0), a3, voffA);
            PG8_WAIT_V(8); PG8_WAIT_L(0); PG8_BAR; PG8_MMA(1, 0, At, B0); PG8_MMA(1, 1, At, B1); PG8_BAR; PG8_SCHED;
            } else {
            PG8_LDB(B0, 0, 0); PG8_SCHED; PG8_LDA(At, 0, 0); PG8_STAGE(PG8_SA(1, 1), a1 + hstep, voffA);
            PG8_WAIT_L(8); PG8_BAR; PG8_WAIT_L(0); PG8_MMA(0, 0, At, B0); PG8_BAR; PG8_SCHED;
            PG8_LDB(B1, 0, 1); PG8_STAGE(PG8_SB(0, 0), b2, voffB);
            PG8_BAR; PG8_WAIT_L(0); PG8_MMA(0, 1, At, B1); PG8_BAR;
            PG8_LDA(At, 0, 1); PG8_STAGE(PG8_SA(0, 0), a2, voffA);
            PG8_BAR; PG8_WAIT_L(0); PG8_MMA(1, 0, At, B0); PG8_BAR; PG8_SCHED;
            PG8_STAGE(PG8_SB(0, 1), b2 + hstep, voffB);
            PG8_WAIT_V(6); PG8_BAR; PG8_MMA(1, 1, At, B1); PG8_BAR;
            PG8_LDB(B0, 1, 0); PG8_SCHED; PG8_LDA(At, 1, 0); PG8_STAGE(PG8_SA(0, 1), a2 + hstep, voffA);
            PG8_WAIT_L(8); PG8_BAR; PG8_WAIT_L(0); PG8_MMA(0, 0, At, B0); PG8_BAR; PG8_SCHED;
            PG8_LDB(B1, 1, 1); PG8_STAGE(PG8_SB(1, 0), b3, voffB);
            PG8_BAR; PG8_WAIT_L(0); PG8_MMA(0, 1, At, B1); PG8_BAR;
            PG8_LDA(At, 1, 1); PG8_STAGE(PG8_SA(1, 0), a3, voffA);
            PG8_BAR; PG8_WAIT_L(0); PG8_MMA(1, 0, At, B0); PG8_BAR; PG8_SCHED;
            PG8_STAGE(PG8_SB(1, 1), b3 + hstep, voffB);
            PG8_WAIT_V(6); PG8_BAR; PG8_MMA(1, 1, At, B1); PG8_BAR;
            }
        }
        if constexpr (ALIGN_EPI) { if (wr == 0) PG8_BAR; }
        if constexpr (!Epi::AFTER_DRAIN) { E(acc, cur, wr, wc, fr, fq); S.done(cur); }
        if (!has_next) break;
#pragma unroll
        for (int a = 0; a < 2; ++a)
#pragma unroll
            for (int b = 0; b < 2; ++b)
#pragma unroll
                for (int m = 0; m < 4; ++m)
#pragma unroll
                    for (int n = 0; n < 2; ++n) acc[a][b][m][n] = (f32x4){0.f, 0.f, 0.f, 0.f};
        cur = nxt; cA = nA; cB = nB; ++ui;
        if constexpr (ALIGN_EPI) { if (wr == 1) PG8_BAR; }
    }
    PG8_WAIT_V(0);
    if constexpr (!ALIGN_EPI) { if (wr == 0) PG8_BAR; }
    PG8_BAR;
    if constexpr (Epi::AFTER_DRAIN) { E.fused(acc, cur, wr, wc, fr, fq, lds, wid, lane); S.done(cur); }
#undef PG8_SA
#undef PG8_SB
#undef PG8_STAGE
#undef PG8_LDA
#undef PG8_LDB
#undef PG8_MMA
#undef PG8_WAIT_V
#undef PG8_WAIT_L
#undef PG8_BAR
#undef PG8_SCHED
}
}
#define GAS __attribute__((address_space(1)))
#define LAS __attribute__((address_space(3)))
typedef unsigned short bf16;
typedef unsigned v4u __attribute__((ext_vector_type(4)));
typedef float f32x4 __attribute__((ext_vector_type(4)));
typedef short bf16x8 __attribute__((ext_vector_type(8)));
typedef GAS unsigned gu32;
typedef GAS unsigned long long gu64;
#define RLX_AGENT __ATOMIC_RELAXED, __HIP_MEMORY_SCOPE_AGENT
#define LDS_WAIT() asm volatile("s_waitcnt lgkmcnt(0)" ::: "memory")
#define VM_WAIT() asm volatile("s_waitcnt vmcnt(0)" ::: "memory")
__device__ __forceinline__ unsigned long long rt() { return __builtin_amdgcn_s_memrealtime(); }
__device__ __forceinline__ unsigned f2bf(float f) { unsigned u = __builtin_bit_cast(unsigned, f); return (u + 0x7fffu + ((u >> 16) & 1u)) >> 16; }
__device__ __forceinline__ unsigned pk2(float lo, float hi) { return f2bf(lo) | (f2bf(hi) << 16); }

#define XB_TMO      128
#define XB_XCNT(j)  (256  + 64 * (j))
#define XB_XSUB(j)  (1280 + 64 * (j))
#define XB_XGEN(j)  (2304 + 64 * (j))
#define XB_TOP      3328
#define XB_TOPGEN   3392
#define XCD_BAR_WORDS 3456
#define XB_SPIN_CAP (1u << 18)

__device__ __forceinline__ unsigned xb_ld(unsigned* p)              { return __hip_atomic_load(p, __ATOMIC_RELAXED, __HIP_MEMORY_SCOPE_AGENT); }
__device__ __forceinline__ unsigned xb_add(unsigned* p, unsigned v) { return __hip_atomic_fetch_add(p, v, __ATOMIC_RELAXED, __HIP_MEMORY_SCOPE_AGENT); }
__device__ __forceinline__ unsigned xb_xcc_id() { return (unsigned)__builtin_amdgcn_s_getreg((3 << 11) | 20) & 0xFu; }
#define XB_SPIN(cond, bar) do { unsigned _sp = 0; while (cond) { __builtin_amdgcn_s_sleep(1); \
    if ((++_sp & 255u) == 0u) { if (xb_ld(&(bar)[XB_TMO])) break; if (_sp > XB_SPIN_CAP) { atomicAdd(&(bar)[XB_TMO], 1u); break; } } } } while (0)

struct XcdBarrier {
    unsigned* bar; unsigned x;
    volatile LAS unsigned* st;
};

__device__ __forceinline__ XcdBarrier xcd_barrier_post(unsigned* bar, volatile LAS unsigned* st) {
    XcdBarrier b; b.bar = bar; b.x = xb_xcc_id(); b.st = st;
    if (threadIdx.x == 0) (void)xb_add(&bar[XB_XCNT(b.x)], 1u);
    return b;
}
__device__ __forceinline__ void xcd_barrier_complete(unsigned* bar, unsigned x, unsigned& nloc, unsigned& nx) {
    const unsigned G = gridDim.x * gridDim.y * gridDim.z;
    unsigned sum, cnt, mine, sp = 0u;
    for (;;) {
        sum = 0u; cnt = 0u; mine = 0u;
#pragma unroll
        for (unsigned j = 0; j < 16; ++j) { const unsigned c = xb_ld(&bar[XB_XCNT(j)]); sum += c; cnt += (c > 0u) ? 1u : 0u; mine = (j == x) ? c : mine; }
        if (sum == G) break;
        __builtin_amdgcn_s_sleep(1);
        if ((++sp & 255u) == 0u) { if (xb_ld(&bar[XB_TMO])) break; if (sp > XB_SPIN_CAP) { atomicAdd(&bar[XB_TMO], 1u); break; } }
    }
    nloc = mine > 0u ? mine : 1u; nx = cnt > 0u ? cnt : 1u;
}

__device__ __forceinline__ void xcd_barrier(const XcdBarrier& b) {
    asm volatile("s_waitcnt vmcnt(0)" ::: "memory");
    __syncthreads();
    if (threadIdx.x == 0) {
        unsigned* bar = b.bar;
        __builtin_amdgcn_s_waitcnt(0);
        unsigned nloc = b.st[0], nx = b.st[1];
        if (nloc == 0u) { xcd_barrier_complete(bar, b.x, nloc, nx); b.st[0] = nloc; b.st[1] = nx; }
        const unsigned old = xb_add(&bar[XB_XSUB(b.x)], 1u);
        const unsigned gen = old / nloc;
        if (old + 1u == (gen + 1u) * nloc) {
            __builtin_amdgcn_fence(__ATOMIC_RELEASE, "agent");
            asm volatile("s_waitcnt vmcnt(0)" ::: "memory");
            const unsigned og = xb_add(&bar[XB_TOP], 1u);
            const unsigned tg = og / nx;
            if (og + 1u == (tg + 1u) * nx) xb_add(&bar[XB_TOPGEN], 1u);
            else XB_SPIN(xb_ld(&bar[XB_TOPGEN]) == tg, bar);
            __builtin_amdgcn_fence(__ATOMIC_ACQUIRE, "agent");
            xb_add(&bar[XB_XGEN(b.x)], 1u);
            asm volatile("s_waitcnt vmcnt(0)" ::: "memory");
        } else {
            XB_SPIN(xb_ld(&bar[XB_XGEN(b.x)]) == gen, bar);
            __builtin_amdgcn_fence(__ATOMIC_ACQUIRE, "agent");
            asm volatile("s_waitcnt vmcnt(0)" ::: "memory");
        }
    }
    __syncthreads();
}

typedef float f32x16 __attribute__((ext_vector_type(16)));
typedef short s16x4 __attribute__((ext_vector_type(4)));
typedef unsigned u32x2v __attribute__((ext_vector_type(2)));
typedef LAS unsigned char* ldsp_t;
#define WAITV0_BAR() asm volatile("s_waitcnt vmcnt(0) lgkmcnt(0)\n\ts_barrier" ::: "memory")
#define LGKM_BAR() asm volatile("s_waitcnt lgkmcnt(0)\n\ts_barrier" ::: "memory")
__device__ __forceinline__ int crow(int r, int hi) { return (r & 3) + 8 * (r >> 2) + 4 * hi; }
__device__ __forceinline__ unsigned cvtpk(float lo, float hi) { unsigned r; asm volatile("v_cvt_pk_bf16_f32 %0, %1, %2" : "=v"(r) : "v"(lo), "v"(hi)); return r; }
__device__ __forceinline__ float bf2f(unsigned short b) { return __uint_as_float((unsigned)b << 16); }
__device__ __forceinline__ float bflo(unsigned w) { return __uint_as_float(w << 16); }
__device__ __forceinline__ float bfhi(unsigned w) { return __uint_as_float(w & 0xffff0000u); }
__device__ __forceinline__ float ex2(float x) { return __builtin_amdgcn_exp2f(x); }
__device__ __forceinline__ float fexpn(float x) { return __builtin_amdgcn_exp2f(x * LOG2E); }
__device__ __forceinline__ float swap_max(float v) { auto rr = __builtin_amdgcn_permlane32_swap(__float_as_uint(v), __float_as_uint(v), false, false); return fmaxf(__uint_as_float(rr[0]), __uint_as_float(rr[1])); }
__device__ __forceinline__ float swap_sum(float v) { auto rr = __builtin_amdgcn_permlane32_swap(__float_as_uint(v), __float_as_uint(v), false, false); return __uint_as_float(rr[0]) + __uint_as_float(rr[1]); }
__device__ __forceinline__ s16x4 vtr(LAS const unsigned char* p) { return __builtin_bit_cast(s16x4, __builtin_amdgcn_ds_read_tr16_b64_v4i16((LAS s16x4*)p)); }
__device__ __forceinline__ bf16x8 cat8(s16x4 a, s16x4 b) { return (bf16x8){a[0], a[1], a[2], a[3], b[0], b[1], b[2], b[3]}; }
__device__ __forceinline__ bf16x8 accfrag(const f32x16& x, int s) {
    v4u w; w.x = cvtpk(x[8 * s + 0], x[8 * s + 1]); w.y = cvtpk(x[8 * s + 2], x[8 * s + 3]); w.z = cvtpk(x[8 * s + 4], x[8 * s + 5]); w.w = cvtpk(x[8 * s + 6], x[8 * s + 7]);
    return __builtin_bit_cast(bf16x8, w);
}
#define DMA16(gsrc, ldsdst) __builtin_amdgcn_global_load_lds((const unsigned*)(gsrc), (LAS unsigned*)(ldsdst), 16, 0, 0)
__device__ __forceinline__ void dma_vimg(const bf16* src, int pitch, ldsp_t img, int wid, int lane) {
    const int sub = lane >> 5, row = (lane & 31) >> 2, ch = lane & 3;
#pragma unroll
    for (int j = 0; j < 2; ++j) DMA16(src + (size_t)(8 * wid + row) * pitch + 32 * (2 * j + sub) + 8 * ch, img + (wid * 4 + 2 * j) * 512);
}
__device__ __forceinline__ int vtr_lane_off(int lane) { return ((lane >> 4) & 1) * 32 + (lane & 3) * 8 + ((lane & 15) >> 2) * 64; }

namespace att {
constexpr int BUFB = 32768, KIMG = 16384, XOFF = 65536;
__device__ __forceinline__ void unit(int b, int h, int qblk, const bf16* Q, const bf16* K, const bf16* V, bf16* MIX, float lam, const float* gsub, ldsp_t lds) {
    int tid = threadIdx.x; asm volatile("" : "+v"(tid));
    const int lane = tid & 63, wid = __builtin_amdgcn_readfirstlane(tid >> 6), r32 = lane & 31, hi = lane >> 5, mp = wid >> 2, qb = wid & 3;
    const int q0 = qblk * 128, NT = 2 * (qblk + 1);
    const size_t rowbase = (size_t)b * SEQ;
    const int qg = q0 + 32 * qb + r32;
    bf16x8 qr[4];
    { const bf16* qp = Q + (rowbase + qg) * AW + h * 128 + mp * 64 + hi * 8;
#pragma unroll
      for (int d0 = 0; d0 < 4; ++d0) qr[d0] = *(const bf16x8*)(qp + 16 * d0); }
    const bf16* ksrc = K + (rowbase + lane) * AW + h * 128 + mp * 64 + 2 * (wid & 3) * 8;
    const bf16* vsrc = V + rowbase * AW + h * 128;
    const int kdst = mp * 8192 + 2 * (wid & 3) * 1024;
#define ATT_DMA(t, buf) do { const bf16* ks_ = ksrc + (size_t)(t) * 64 * AW; DMA16(ks_, lds + (buf) * BUFB + kdst); DMA16(ks_ + 8, lds + (buf) * BUFB + kdst + 1024); \
        dma_vimg(vsrc + (size_t)(t) * 64 * AW, AW, lds + (buf) * BUFB + KIMG, wid, lane); } while (0)
    f32x16 o[4];
#pragma unroll
    for (int i = 0; i < 4; ++i) o[i] = (f32x16){};
    float mrun = -1e30f, lsum = 0.f;
    const int vlo = vtr_lane_off(lane) + 4 * hi * 64;
    ATT_DMA(0, 0);
    WAITV0_BAR();
    for (int t = 0; t < NT; ++t) {
        const int buf = t & 1;
        if (t + 1 < NT) ATT_DMA(t + 1, buf ^ 1);
        if (64 * t <= q0 + 32 * qb + 31) {
            const LAS unsigned char* kb = lds + buf * BUFB + mp * 8192 + hi * 1024 + r32 * 16;
            f32x16 p0 = (f32x16){}, p1 = (f32x16){};
#pragma unroll
            for (int d0 = 0; d0 < 4; ++d0) {
                const bf16x8 k0 = *(const LAS bf16x8*)(kb + d0 * 2048), k1 = *(const LAS bf16x8*)(kb + d0 * 2048 + 512);
                p0 = __builtin_amdgcn_mfma_f32_32x32x16_bf16(k0, qr[d0], p0, 0, 0, 0);
                p1 = __builtin_amdgcn_mfma_f32_32x32x16_bf16(k1, qr[d0], p1, 0, 0, 0);
            }
            if (64 * t + 63 > q0 + 32 * qb) {
#pragma unroll
                for (int r = 0; r < 16; ++r) { const int kv = 64 * t + crow(r, hi); if (kv > qg) p0[r] = -1e30f; if (kv + 32 > qg) p1[r] = -1e30f; }
            }
            float mt = fmaxf(p0[0], p1[0]);
#pragma unroll
            for (int r = 1; r < 16; ++r) mt = fmaxf(mt, fmaxf(p0[r], p1[r]));
            mt = swap_max(mt);
            const float mnew = fmaxf(mrun, mt);
            if (__any(mnew > mrun)) {
                const float al = ex2(mrun - mnew); lsum *= al;
#pragma unroll
                for (int i = 0; i < 4; ++i)
#pragma unroll
                    for (int r = 0; r < 16; ++r) o[i][r] *= al;
            }
            mrun = mnew;
            float ps = 0.f;
#pragma unroll
            for (int r = 0; r < 16; ++r) { p0[r] = ex2(p0[r] - mnew); p1[r] = ex2(p1[r] - mnew); ps += p0[r] + p1[r]; }
            lsum += ps;
            bf16x8 pw[4]; pw[0] = accfrag(p0, 0); pw[1] = accfrag(p0, 1); pw[2] = accfrag(p1, 0); pw[3] = accfrag(p1, 1);
            const LAS unsigned char* vb = lds + buf * BUFB + KIMG + vlo;
#pragma unroll
            for (int s = 0; s < 4; ++s)
#pragma unroll
                for (int db = 0; db < 4; ++db) {
                    const bf16x8 vf = cat8(vtr(vb + ((2 * s) * 4 + db) * 512), vtr(vb + ((2 * s + 1) * 4 + db) * 512));
                    o[db] = __builtin_amdgcn_mfma_f32_32x32x16_bf16(vf, pw[s], o[db], 0, 0, 0);
                }
        }
        WAITV0_BAR();
    }
#undef ATT_DMA
    const float inv = 1.0f / swap_sum(lsum);
    LAS float* X = (LAS float*)(lds + XOFF);
    if (mp == 1) { const float sc = lam * inv;
#pragma unroll
        for (int db = 0; db < 4; ++db)
#pragma unroll
            for (int r = 0; r < 16; ++r) X[(qb * 64 + db * 16 + r) * 64 + lane] = o[db][r] * sc; }
    LGKM_BAR();
    if (mp == 0) {
        float ss = 0.f;
#pragma unroll
        for (int db = 0; db < 4; ++db)
#pragma unroll
            for (int r = 0; r < 16; ++r) { const float a = o[db][r] * inv - X[(qb * 64 + db * 16 + r) * 64 + lane]; o[db][r] = a; ss += a * a; }
        ss = swap_sum(ss);
        const float rs = (1.0f - LAM_INIT) / sqrtf(ss * (1.0f / 128.0f) + EPS);
        bf16* orow = MIX + (rowbase + qg) * D + h * 128;
#pragma unroll
        for (int db = 0; db < 4; ++db)
#pragma unroll
            for (int g = 0; g < 4; ++g) { const int d = 32 * db + 8 * g + 4 * hi; const f32x4 gg = *(const f32x4*)(gsub + d);
                u32x2v w; w.x = cvtpk(o[db][4 * g] * rs * gg[0], o[db][4 * g + 1] * rs * gg[1]); w.y = cvtpk(o[db][4 * g + 2] * rs * gg[2], o[db][4 * g + 3] * rs * gg[3]);
                *(u32x2v*)(orow + d) = w; }
    }
}
}

namespace hg {
constexpr int QE_OFF = 0, QE_P = 136  , KE_OFF = 17408, KLT_OFF = 34816, KLT_P = 72, V_OFF = 53248, G_OFF = 86016, QT_OFF = 86528, LDS_END = 88576;
__device__ __forceinline__ void unit(int bh, const bf16* RQ, const bf16* RK, const bf16* RV, const float* LOGF, bf16* OREC, float* sout, ldsp_t lds) {
    int tid = threadIdx.x; asm volatile("" : "+v"(tid));
    const int lane = tid & 63, wid = __builtin_amdgcn_readfirstlane(tid >> 6), r32 = lane & 31, hi = lane >> 5, th = wid >> 2, eb = wid & 3;
    const int b = bh >> 2, h = bh & 3;
    const size_t rowbase = (size_t)b * SEQ; const int col0 = h * 128;
    const int d = tid & 127, tq = tid >> 7;
    LAS bf16* QE = (LAS bf16*)(lds + QE_OFF); LAS bf16* KE = (LAS bf16*)(lds + KE_OFF); LAS bf16* KLT = (LAS bf16*)(lds + KLT_OFF);
    LAS float* G = (LAS float*)(lds + G_OFF); LAS float* QT = (LAS float*)(lds + QT_OFF);
    float lf[16]; unsigned short rq[16], rk[16];
    f32x16 S[4];
#pragma unroll
    for (int i = 0; i < 4; ++i) S[i] = (f32x16){};
    const int vlo = vtr_lane_off(lane);
#define HG_LOAD(n) do { const size_t g0_ = (rowbase + 64 * (n) + 16 * tq) * RW + col0 + d; _Pragma("unroll") for (int i = 0; i < 16; ++i) { lf[i] = LOGF[g0_ + (size_t)i * RW]; rq[i] = RQ[g0_ + (size_t)i * RW]; rk[i] = RK[g0_ + (size_t)i * RW]; } \
        dma_vimg(RV + (rowbase + 64 * (n)) * RW + col0, RW, lds + V_OFF + ((n) & 1) * 16384, wid, lane); } while (0)
#define HG_PREP() do { float cs_[16]; float c_ = 0.f; _Pragma("unroll") for (int i = 0; i < 16; ++i) { c_ += lf[i]; cs_[i] = c_; } \
        QT[tq * 128 + d] = c_; LGKM_BAR(); \
        float off_ = 0.f, tot_ = 0.f; _Pragma("unroll") for (int q = 0; q < 4; ++q) { const float v_ = QT[q * 128 + d]; tot_ += v_; if (q < tq) off_ += v_; } \
        if (tq == 0) G[d] = fexpn(tot_); \
        unsigned klw_[8]; \
        _Pragma("unroll") for (int i = 0; i < 16; i += 2) { \
            const float b0_ = cs_[i] + off_, b1_ = cs_[i + 1] + off_; const float q0_ = bf2f(rq[i]), q1_ = bf2f(rq[i + 1]), k0_ = bf2f(rk[i]), k1_ = bf2f(rk[i + 1]); \
            const unsigned qe_ = cvtpk(q0_ * fexpn(b0_), q1_ * fexpn(b1_)), ke_ = cvtpk(k0_ * fexpn(-b0_), k1_ * fexpn(-b1_)); \
            klw_[i >> 1] = cvtpk(k0_ * fexpn(tot_ - b0_), k1_ * fexpn(tot_ - b1_)); \
            QE[(16 * tq + i) * QE_P + d] = (bf16)(qe_ & 0xffffu); QE[(16 * tq + i + 1) * QE_P + d] = (bf16)(qe_ >> 16); \
            KE[(16 * tq + i) * QE_P + d] = (bf16)(ke_ & 0xffffu); KE[(16 * tq + i + 1) * QE_P + d] = (bf16)(ke_ >> 16); } \
        *(LAS v4u*)(KLT + d * KLT_P + 16 * tq) = (v4u){klw_[0], klw_[1], klw_[2], klw_[3]}; *(LAS v4u*)(KLT + d * KLT_P + 16 * tq + 8) = (v4u){klw_[4], klw_[5], klw_[6], klw_[7]}; } while (0)
    HG_LOAD(0);
    HG_PREP();
    WAITV0_BAR();
    for (int n = 0; n < 32; ++n) {
        if (n + 1 < 32) HG_LOAD(n + 1);
        const LAS unsigned char* vimg = lds + V_OFF + (n & 1) * 16384;
        f32x16 o = (f32x16){};
        bf16x8 xw[2][2];
#pragma unroll
        for (int sb = 0; sb < 2; ++sb) if (sb <= th) {
            f32x16 x = (f32x16){};
#pragma unroll
            for (int sg = 0; sg < 8; ++sg) {
                const bf16x8 ka = *(const LAS bf16x8*)(KE + (32 * sb + r32) * QE_P + 16 * sg + 8 * hi), qbv = *(const LAS bf16x8*)(QE + (32 * th + r32) * QE_P + 16 * sg + 8 * hi);
                x = __builtin_amdgcn_mfma_f32_32x32x16_bf16(ka, qbv, x, 0, 0, 0);
            }
            if (sb == th) {
#pragma unroll
                for (int r = 0; r < 16; ++r) if (crow(r, hi) > r32) x[r] = 0.f;
            }
            xw[sb][0] = accfrag(x, 0); xw[sb][1] = accfrag(x, 1);
        }
#pragma unroll
        for (int db = 0; db < 4; ++db)
#pragma unroll
            for (int sg = 0; sg < 2; ++sg) {
                const LAS bf16* qp = QE + (32 * th + r32) * QE_P + 32 * db + 16 * sg + 4 * hi;
                const u32x2v a0 = *(const LAS u32x2v*)qp, a1 = *(const LAS u32x2v*)(qp + 8);
                const v4u aw = (v4u){a0.x, a0.y, a1.x, a1.y};
                o = __builtin_amdgcn_mfma_f32_32x32x16_bf16(__builtin_bit_cast(bf16x8, aw), accfrag(S[db], sg), o, 0, 0, 0);
            }
#pragma unroll
        for (int sb = 0; sb < 2; ++sb) if (sb <= th) {
#pragma unroll
            for (int sg = 0; sg < 2; ++sg) {
                const LAS unsigned char* vb = vimg + vlo + 4 * hi * 64 + ((4 * sb + 2 * sg) * 4 + eb) * 512;
                const bf16x8 vf = cat8(vtr(vb), vtr(vb + 4 * 512));
                o = __builtin_amdgcn_mfma_f32_32x32x16_bf16(xw[sb][sg], vf, o, 0, 0, 0);
            }
        }
        { bf16* op = OREC + (rowbase + 64 * n + 32 * th) * RW + col0 + 32 * eb + r32;
#pragma unroll
          for (int r = 0; r < 16; r += 2) { const unsigned w = cvtpk(o[r], o[r + 1]); op[(size_t)crow(r, hi) * RW] = (bf16)(w & 0xffffu); op[(size_t)crow(r + 1, hi) * RW] = (bf16)(w >> 16); } }
#pragma unroll
        for (int db = 0; db < 4; ++db) {
#pragma unroll
            for (int g = 0; g < 4; ++g) { const f32x4 gg = *(const LAS f32x4*)(G + 32 * db + 8 * g + 4 * hi);
                S[db][4 * g] *= gg[0]; S[db][4 * g + 1] *= gg[1]; S[db][4 * g + 2] *= gg[2]; S[db][4 * g + 3] *= gg[3]; }
        }
#pragma unroll
        for (int sg = 0; sg < 4; ++sg) {
            const LAS unsigned char* vb = vimg + vlo + ((2 * sg + hi) * 4 + eb) * 512;
            const bf16x8 vf = cat8(vtr(vb), vtr(vb + 4 * 64));
#pragma unroll
            for (int db = 0; db < 4; ++db) {
                const bf16x8 ka = *(const LAS bf16x8*)(KLT + (32 * db + r32) * KLT_P + 16 * sg + 8 * hi);
                S[db] = __builtin_amdgcn_mfma_f32_32x32x16_bf16(ka, vf, S[db], 0, 0, 0);
            }
        }
        LGKM_BAR();
        if (n + 1 < 32) HG_PREP();
        WAITV0_BAR();
    }
#undef HG_LOAD
#undef HG_PREP
    if (th == 0) { float* sp = sout + (size_t)bh * 16384 + 32 * eb + r32;
#pragma unroll
        for (int db = 0; db < 4; ++db)
#pragma unroll
            for (int r = 0; r < 16; ++r) sp[(size_t)(32 * db + crow(r, hi)) * 128] = S[db][r]; }
}
}

namespace dec {
constexpr int PART = 264;
__device__ __forceinline__ void unit(int bs, int h, const bf16* Q, const bf16* K, const bf16* V, const float* ck, const float* cv, const int* ptab, bf16* MIX, float lam, const float* gsub, ldsp_t lds) {
    int tid = threadIdx.x; asm volatile("" : "+v"(tid));
    const int lane = tid & 63, wid = __builtin_amdgcn_readfirstlane(tid >> 6);
    const size_t row = (size_t)MP + bs;
    LAS float* P = (LAS float*)lds;
    const int c4 = 4 * (lane & 31), half = lane >> 5, mymap = (lane >> 4) & 1;
    f32x4 q4; { const u32x2v qw = *(const u32x2v*)(Q + row * AW + h * 128 + c4); q4 = (f32x4){bflo(qw.x), bfhi(qw.x), bflo(qw.y), bfhi(qw.y)}; }
    float mrun = -1e30f, lrun = 0.f; f32x4 o0 = (f32x4){0.f, 0.f, 0.f, 0.f}, o1 = o0;
    const int pid0 = ptab[bs * NPAGES + 2 * wid], pid1 = ptab[bs * NPAGES + 2 * wid + 1];
    const size_t lo_ = (size_t)half * 512 + h * 128 + c4;
    const float* kp0 = ck + (size_t)pid0 * PAGE * 512 + lo_; const float* vp0 = cv + (size_t)pid0 * PAGE * 512 + lo_;
    const float* kp1 = ck + (size_t)pid1 * PAGE * 512 + lo_; const float* vp1 = cv + (size_t)pid1 * PAGE * 512 + lo_;
#define DEC_LOAD(KK, VV, st) do { const size_t so_ = (size_t)(16 * ((st) & 7)) * 512; const float* kq_ = ((st) < 8 ? kp0 : kp1) + so_; const float* vq_ = ((st) < 8 ? vp0 : vp1) + so_; \
        _Pragma("unroll") for (int i = 0; i < 8; ++i) KK[i] = __builtin_nontemporal_load((const f32x4*)(kq_ + (size_t)(2 * i) * 512)); \
        _Pragma("unroll") for (int i = 0; i < 8; ++i) VV[i] = __builtin_nontemporal_load((const f32x4*)(vq_ + (size_t)(2 * i) * 512)); } while (0)
#define DEC_COMPUTE(KK, VV) do { float pr[8]; \
        _Pragma("unroll") for (int i = 0; i < 8; ++i) pr[i] = (KK[i][0] * q4[0] + KK[i][1] * q4[1]) + (KK[i][2] * q4[2] + KK[i][3] * q4[3]); \
        float a4[4], a2[2], s; \
        { const bool up = (lane & 8) != 0; _Pragma("unroll") for (int i = 0; i < 4; ++i) { const float keep = up ? pr[i + 4] : pr[i], send = up ? pr[i] : pr[i + 4]; a4[i] = keep + __shfl_xor(send, 8); } } \
        { const bool up = (lane & 4) != 0; _Pragma("unroll") for (int i = 0; i < 2; ++i) { const float keep = up ? a4[i + 2] : a4[i], send = up ? a4[i] : a4[i + 2]; a2[i] = keep + __shfl_xor(send, 4); } } \
        { const bool up = (lane & 2) != 0; const float keep = up ? a2[1] : a2[0], send = up ? a2[0] : a2[1]; s = keep + __shfl_xor(send, 2); } \
        s += __shfl_xor(s, 1); \
        float mt = s; mt = fmaxf(mt, __shfl_xor(mt, 2)); mt = fmaxf(mt, __shfl_xor(mt, 4)); mt = fmaxf(mt, __shfl_xor(mt, 8)); mt = fmaxf(mt, __shfl_xor(mt, 32)); \
        const float mnew = fmaxf(mrun, mt), al = ex2(mrun - mnew), p = ex2(s - mnew); \
        float psum = p; psum += __shfl_xor(psum, 2); psum += __shfl_xor(psum, 4); psum += __shfl_xor(psum, 8); psum += __shfl_xor(psum, 32); \
        lrun = lrun * al + psum; mrun = mnew; \
        const float al0 = __shfl(al, 0), al1 = __shfl(al, 16); \
        o0 = o0 * al0; o1 = o1 * al1; \
        _Pragma("unroll") for (int i = 0; i < 8; ++i) { const float p0 = __shfl(p, (lane & 32) + 2 * i), p1 = __shfl(p, (lane & 32) + 16 + 2 * i); o0 = o0 + VV[i] * p0; o1 = o1 + VV[i] * p1; } } while (0)
    {
        f32x4 kA[8], vA[8], kB[8], vB[8];
        DEC_LOAD(kA, vA, 0);
        for (int st = 0; st < 16; st += 2) {
            DEC_LOAD(kB, vB, st + 1);
            DEC_COMPUTE(kA, vA);
            if (st + 2 < 16) DEC_LOAD(kA, vA, st + 2);
            DEC_COMPUTE(kB, vB);
        }
    }
#undef DEC_LOAD
#undef DEC_COMPUTE
#pragma unroll
    for (int j = 0; j < 4; ++j) { o0[j] += __shfl_xor(o0[j], 32); o1[j] += __shfl_xor(o1[j], 32); }
    { const float m0 = __shfl(mrun, 0), l0 = __shfl(lrun, 0), m1 = __shfl(mrun, 16), l1 = __shfl(lrun, 16);
      LAS float* pw = P + wid * PART;
      if (lane < 32) { *(LAS f32x4*)(pw + c4) = o0; *(LAS f32x4*)(pw + 128 + c4) = o1; }
      if (lane == 0) { pw[256] = m0; pw[257] = l0; pw[258] = m1; pw[259] = l1; } }
    if (wid == 0) {
        const u32x2v kw = *(const u32x2v*)(K + row * AW + h * 128 + c4);
        float s = (bflo(kw.x) * q4[0] + bfhi(kw.x) * q4[1]) + (bflo(kw.y) * q4[2] + bfhi(kw.y) * q4[3]);
        s += __shfl_xor(s, 1); s += __shfl_xor(s, 2); s += __shfl_xor(s, 4); s += __shfl_xor(s, 8);
        if (lane == 0) P[8 * PART] = s; if (lane == 16) P[8 * PART + 1] = s;
    }
    LGKM_BAR();
    if (wid == 0) {
        float M0 = P[8 * PART], M1 = P[8 * PART + 1]; const float sn0 = M0, sn1 = M1;
#pragma unroll
        for (int w = 0; w < 8; ++w) { M0 = fmaxf(M0, P[w * PART + 256]); M1 = fmaxf(M1, P[w * PART + 258]); }
        const float wn0 = ex2(sn0 - M0), wn1 = ex2(sn1 - M1);
        float L0 = wn0, L1 = wn1; float a[2], bq[2];
        { const bf16* vr = V + row * AW + h * 128; a[0] = wn0 * bf2f(vr[lane]); a[1] = wn0 * bf2f(vr[lane + 64]); bq[0] = wn1 * bf2f(vr[lane]); bq[1] = wn1 * bf2f(vr[lane + 64]); }
#pragma unroll
        for (int w = 0; w < 8; ++w) { const float f0 = ex2(P[w * PART + 256] - M0), f1 = ex2(P[w * PART + 258] - M1);
            L0 += f0 * P[w * PART + 257]; L1 += f1 * P[w * PART + 259];
            a[0] += f0 * P[w * PART + lane]; a[1] += f0 * P[w * PART + lane + 64]; bq[0] += f1 * P[w * PART + 128 + lane]; bq[1] += f1 * P[w * PART + 128 + lane + 64]; }
        const float i0 = 1.0f / L0, i1 = lam / L1;
        const float y0 = a[0] * i0 - bq[0] * i1, y1 = a[1] * i0 - bq[1] * i1;
        float ss = y0 * y0 + y1 * y1;
#pragma unroll
        for (int o = 1; o < 64; o <<= 1) ss += __shfl_xor(ss, o);
        const float rs = (1.0f - LAM_INIT) / sqrtf(ss * (1.0f / 128.0f) + EPS);
        bf16* orow = MIX + row * D + h * 128;
        orow[lane] = (bf16)f2bf(y0 * rs * gsub[lane]); orow[lane + 64] = (bf16)f2bf(y1 * rs * gsub[lane + 64]);
    }
    LGKM_BAR();
}
}

__device__ __forceinline__ void hgrn_step(int bs, int h, const bf16* RQ, const bf16* RK, const bf16* RV, const float* LOGF, const float* S0, float* Sout, bf16* OREC, ldsp_t lds) {
    int tid = threadIdx.x; asm volatile("" : "+v"(tid)); const size_t row = (size_t)MP + bs; const size_t g0 = row * RW + h * 128;
    LAS float* qs = (LAS float*)lds; LAS float* ks = qs + 128; LAS float* fs = qs + 256; LAS float* po = qs + 384;
    if (tid < 128) { qs[tid] = bf2f(RQ[g0 + tid]); ks[tid] = bf2f(RK[g0 + tid]); fs[tid] = fexpn(LOGF[g0 + tid]); }
    const int e = tid & 127, dq = tid >> 7;
    const float v = bf2f(RV[g0 + e]);
    LGKM_BAR();
    const size_t sb = ((size_t)(bs * 4 + h) * 128 + 32 * dq) * 128 + e;
    float acc = 0.f;
    float s0v[32];
#pragma unroll
    for (int i = 0; i < 32; ++i) s0v[i] = __builtin_nontemporal_load(S0 + sb + (size_t)i * 128);
#pragma unroll
    for (int i = 0; i < 32; ++i) { const int dd = 32 * dq + i; const float sn = fs[dd] * s0v[i] + ks[dd] * v; Sout[sb + (size_t)i * 128] = sn; acc += qs[dd] * sn; }
    po[dq * 128 + e] = acc;
    LGKM_BAR();
    if (tid < 128) OREC[g0 + tid] = (bf16)f2bf((po[tid] + po[128 + tid]) + (po[256 + tid] + po[384 + tid]));
    LGKM_BAR();
}


template <int MODE, int N, int K, int KC>
__device__ __forceinline__ void samp_item(int item, const bf16* Abf, const float* xs, const float* C4, const float* C5, const float* C6, float* SS1, const bf16* Bt, float* C) {
    int tid = threadIdx.x; asm volatile("" : "+v"(tid));
    const int lane = tid & 63, wid = __builtin_amdgcn_readfirstlane(tid >> 6), r32 = lane & 31, hi = lane >> 5, rb = wid >> 1, cbk = wid & 1;
    constexpr int NCH = N / 64;
    const int nc = item % NCH, kc = item / NCH, n0 = nc * 64 + 32 * cbk, k0 = kc * KC, row = 32 * rb + r32;
    f32x16 acc = (f32x16){};
    float ssp = 0.f, r2 = 0.f;
    if (MODE == 7) r2 = 1.0f / (SS1[row] * (1.0f / D) + EPS);
    const bf16* bp = Bt + (size_t)(n0 + r32) * K + k0 + 8 * hi;
#pragma unroll 4
    for (int s = 0; s < KC / 16; ++s) {
        const int k8 = k0 + 16 * s + 8 * hi;
        bf16x8 a;
        if (MODE == 4) a = *(const bf16x8*)(Abf + (size_t)row * D + k8);
        else {
            f32x4 v0, v1;
            if (MODE == 6) { const float* p = C5 + (size_t)row * FF + k8; v0 = *(const f32x4*)p; v1 = *(const f32x4*)(p + 4);
#pragma unroll
                for (int j = 0; j < 4; ++j) { const float a0 = fmaxf(v0[j], 0.f), a1 = fmaxf(v1[j], 0.f); v0[j] = a0 * a0; v1[j] = a1 * a1; } }
            else { const size_t o = (size_t)row * D + k8; v0 = *(const f32x4*)(xs + o) + *(const f32x4*)(C4 + o); v1 = *(const f32x4*)(xs + o + 4) + *(const f32x4*)(C4 + o + 4);
                if (MODE == 5) ssp += (v0[0] * v0[0] + v0[1] * v0[1]) + (v0[2] * v0[2] + v0[3] * v0[3]) + (v1[0] * v1[0] + v1[1] * v1[1]) + (v1[2] * v1[2] + v1[3] * v1[3]);
                if (MODE == 7) { v0 = v0 + *(const f32x4*)(C6 + o) * r2; v1 = v1 + *(const f32x4*)(C6 + o + 4) * r2; } }
            v4u w; w.x = cvtpk(v0[0], v0[1]); w.y = cvtpk(v0[2], v0[3]); w.z = cvtpk(v1[0], v1[1]); w.w = cvtpk(v1[2], v1[3]); a = __builtin_bit_cast(bf16x8, w);
        }
        const bf16x8 b = *(const bf16x8*)(bp + 16 * s);
        acc = __builtin_amdgcn_mfma_f32_32x32x16_bf16(a, b, acc, 0, 0, 0);
    }
    float* cp = C + (size_t)(32 * rb) * N + n0 + r32;
#pragma unroll
    for (int r = 0; r < 16; ++r) unsafeAtomicAdd(cp + (size_t)crow(r, hi) * N, acc[r]);
    if (MODE == 5 && nc == 0 && cbk == 0) { ssp = swap_sum(ssp); if (hi == 0) unsafeAtomicAdd(SS1 + row, ssp); }
}

constexpr size_t MiB = 1u << 20;
constexpr size_t WS_CTL = 0, CTL_ZERO_BYTES = 1 * MiB;
constexpr size_t WS_WIN = 2 * MiB, WS_WOUT = 9 * MiB, WS_WUP = 11 * MiB, WS_WDN = 19 * MiB, WS_WG = 27 * MiB, WS_WP = 29 * MiB;
constexpr size_t WS_XN = 32 * MiB, WS_PB = 66 * MiB, WS_Q = 76 * MiB, WS_K = 93 * MiB, WS_V = 110 * MiB, WS_RQ = 127 * MiB, WS_RK = 144 * MiB, WS_RV = 161 * MiB, WS_RG = 178 * MiB;
constexpr size_t WS_LOGF = 195 * MiB, WS_OREC = 228 * MiB, WS_MIX = 245 * MiB, WS_X1 = 278 * MiB, WS_A2 = 343 * MiB, WS_A3 = 376 * MiB, WS_PJ = 409 * MiB, WS_H = 442 * MiB;
constexpr size_t WS_SSP1 = 572 * MiB, WS_SSP3 = 574 * MiB;
constexpr size_t WS_X2 = 582 * MiB;
constexpr size_t WS_SC4 = 576 * MiB, WS_SC5 = 577 * MiB, WS_SC6 = 579 * MiB, WS_SC7 = 580 * MiB, WS_SS1S = 581 * MiB, WS_SC_END = WS_SS1S + 4096, WS_END = 648 * MiB;
static_assert(WS_K - WS_Q == 17 * MiB && WS_V - WS_K == 17 * MiB && WS_RQ - WS_V == 17 * MiB && WS_RK - WS_RQ == 17 * MiB && WS_RV - WS_RK == 17 * MiB && WS_RG - WS_RV == 17 * MiB, "EpiIn buffer stride");
static_assert(WS_XN + (size_t)MT * D * 2 <= WS_PB && WS_PB + (size_t)MT * PLE * 2 <= WS_Q && WS_Q + (size_t)MT * AW * 2 <= WS_K && WS_LOGF + (size_t)MT * RW * 4 <= WS_OREC &&
              WS_MIX + (size_t)MT * D * 2 <= WS_X1 && WS_X1 + (size_t)MT * D * 4 <= WS_A2 && WS_PJ + (size_t)MT * D * 2 <= WS_H && WS_H + (size_t)MT * FF * 2 <= WS_SSP1 && WS_SSP1 + (size_t)MT * 64 <= WS_SSP3, "d_ws map");
constexpr int CW_QA = 64, CW_QD = 128;
constexpr int CW_BAR = 4096;
static_assert((CW_BAR + XCD_BAR_WORDS) * 4 <= (int)CTL_ZERO_BYTES, "CTL words inside the memset region");

constexpr int RING_OFF = 0, RING_BYTES = 131072;
constexpr int LDSCTL_OFF = RING_BYTES, MISC_OFF = LDSCTL_OFF + 320;
constexpr int LDS_BYTES = 147456;
constexpr int NWAVES = 8;
constexpr int N_PHASES = 9;
#ifndef DEC_FIRST_FROM
#define DEC_FIRST_FROM 128
#endif

struct Frame {
    LAS unsigned char* lds; volatile LAS unsigned* MISC; gu32* ctl;
    int tid, lane, wave, vcu, G;
};

__device__ __forceinline__ float wave_sum(float v) {
#pragma unroll
    for (int o = 1; o < 64; o <<= 1) v += __shfl_xor(v, o);
    return v;
}
__device__ __forceinline__ void p0_transpose_item(const float* W, int K, int N, bf16* WT, const float* kscale, LAS float* scr, int item, int lane) {
    const int nblk = N / 32, kb = item / nblk, nb = item % nblk, k0 = 64 * kb, n0 = 32 * nb;
    float wv[32];
#pragma unroll
    for (int i = 0; i < 32; ++i) wv[i] = __builtin_nontemporal_load(W + (size_t)(k0 + 2 * i + (lane >> 5)) * N + n0 + (lane & 31));
    if (kscale) {
#pragma unroll
        for (int i = 0; i < 32; ++i) wv[i] *= kscale[k0 + 2 * i + (lane >> 5)]; }
#pragma unroll
    for (int i = 0; i < 32; ++i) scr[(2 * i + (lane >> 5)) * 33 + (lane & 31)] = wv[i];
    LDS_WAIT(); asm volatile("" ::: "memory");
    const int c = lane & 7;
#pragma unroll
    for (int j = 0; j < 4; ++j) { const int n = (lane >> 3) + 8 * j; const LAS float* s = scr + (8 * c) * 33 + n;
        v4u o; o.x = pk2(s[0 * 33], s[1 * 33]); o.y = pk2(s[2 * 33], s[3 * 33]); o.z = pk2(s[4 * 33], s[5 * 33]); o.w = pk2(s[6 * 33], s[7 * 33]);
        *(GAS v4u*)(WT + (size_t)(n0 + n) * K + k0 + 8 * c) = o; }
    LDS_WAIT(); asm volatile("" ::: "memory");
}
__device__ __forceinline__ void rms_row_to_bf16(const float* xrow, const float* g, bf16* orow, int lane) {
    const f32x4* xr = (const f32x4*)xrow + lane; const f32x4* gr = (const f32x4*)g + lane;
    f32x4 v[4]; float s = 0.f;
#pragma unroll
    for (int j = 0; j < 4; ++j) { v[j] = xr[64 * j]; s += (v[j].x * v[j].x + v[j].y * v[j].y) + (v[j].z * v[j].z + v[j].w * v[j].w); }
    const float r = 1.0f / sqrtf(wave_sum(s) * (1.f / D) + EPS);
    unsigned long long* o8 = (unsigned long long*)orow + lane;
#pragma unroll
    for (int j = 0; j < 4; ++j) { const f32x4 gg = gr[64 * j]; o8[64 * j] = (unsigned long long)pk2(v[j].x * r * gg.x, v[j].y * r * gg.y) | ((unsigned long long)pk2(v[j].z * r * gg.z, v[j].w * r * gg.w) << 32); }
}


struct Args { const float* in[24]; float* out; unsigned char* ws; int ph_lo, ph_hi, li, pad; };

#define x_prompt (args.in[0])
#define x_sample (args.in[1])
#define cache_k (args.in[2])
#define cache_v (args.in[3])
#define state0 (args.in[4])
#define ptab ((const int*)args.in[5])
#define p_prompt (args.in[6])
#define p_sample (args.in[7])
#define w_in (args.in[8])
#define g_subln (args.in[13])
#define hgrn_lb (args.in[14])
#define g_rec (args.in[15])
#define w_out (args.in[16])
#define g_mix (args.in[17])
#define g_ffn (args.in[18])
#define w_up (args.in[19])
#define w_down (args.in[20])
#define w_gate (args.in[21])
#define w_proj (args.in[22])
#define g_final (args.in[23])
#define OUTP (args.out)
#define WSP(T, off) ((T*)(args.ws + (off)))
#define WinT WSP(bf16, WS_WIN)
#define WoutT WSP(bf16, WS_WOUT)
#define WupT WSP(bf16, WS_WUP)
#define WdnT WSP(bf16, WS_WDN)
#define WgT WSP(bf16, WS_WG)
#define WpT WSP(bf16, WS_WP)
#define XN WSP(bf16, WS_XN)
#define PB WSP(bf16, WS_PB)
#define Qb WSP(bf16, WS_Q)
#define Kb WSP(bf16, WS_K)
#define Vb WSP(bf16, WS_V)
#define RQ WSP(bf16, WS_RQ)
#define RK WSP(bf16, WS_RK)
#define RV WSP(bf16, WS_RV)
#define RG WSP(bf16, WS_RG)
#define LOGF WSP(float, WS_LOGF)
#define OREC WSP(bf16, WS_OREC)
#define MIX WSP(bf16, WS_MIX)
#define X1 WSP(float, WS_X1)
#define A2 WSP(bf16, WS_A2)
#define A3 WSP(bf16, WS_A3)
#define PJ WSP(bf16, WS_PJ)
#define HB WSP(bf16, WS_H)
#define SSP1 WSP(float, WS_SSP1)
#define SSP3 WSP(float, WS_SSP3)
#define SC4 WSP(float, WS_SC4)
#define X2 WSP(float, WS_X2)
#define SC5 WSP(float, WS_SC5)
#define SC6 WSP(float, WS_SC6)
#define SC7 WSP(float, WS_SC7)
#define SS1S WSP(float, WS_SS1S)

__global__ void __launch_bounds__(NWAVES * 64, 2) mk_fwd(Args args) {
    extern __shared__ __attribute__((aligned(16))) unsigned char lds_raw[];
    Frame F;
    F.lds = (LAS unsigned char*)lds_raw;
    F.MISC = (volatile LAS unsigned*)(F.lds + MISC_OFF);
    F.tid = threadIdx.x; F.lane = F.tid & 63; F.wave = __builtin_amdgcn_readfirstlane(F.tid >> 6);
    F.G = gridDim.x; { const int bx = blockIdx.x; F.vcu = (F.G % 8 == 0) ? (bx % 8) * (F.G / 8) + bx / 8 : bx; }
    F.ctl = (gu32*)(args.ws + WS_CTL);
    for (int u = F.tid; u < (LDS_BYTES - LDSCTL_OFF) / 4; u += NWAVES * 64) ((LAS unsigned*)(F.lds + LDSCTL_OFF))[u] = 0u;
    __syncthreads();
    if (F.wave == 0) {
        const float a = args.in[9][F.lane] * args.in[10][F.lane], b = args.in[11][F.lane] * args.in[12][F.lane];
        const float lam = fexpn(wave_sum(a)) - fexpn(wave_sum(b)) + LAM_INIT;
        if (F.lane == 0) F.MISC[4] = __float_as_uint(lam);
    }
    XcdBarrier bar; bar.bar = (unsigned*)(F.ctl + CW_BAR); bar.x = 0; bar.st = nullptr;
    if (MK_N_LAUNCHES == 1) bar = xcd_barrier_post((unsigned*)(F.ctl + CW_BAR), F.MISC + 8);
    __syncthreads();
#define GRID_BAR() do { if (MK_N_LAUNCHES == 1) xcd_barrier(bar); } while (0)
    const int lo = args.ph_lo, hi = args.ph_hi;
#ifndef PH_MASK
#define PH_MASK 0x1ff
#endif
#ifndef PROBE_REP
#define PROBE_REP -1
#endif
#ifndef PROBE_MASK
#define PROBE_MASK 0
#endif
#define REPN(k) (((PROBE_REP) == (k) || (((PROBE_MASK) >> ((k) >= 20 ? (k) - 8 : (k))) & 1)) ? 2 : 1)
#define IN(k) ((((PH_MASK) >> (k)) & 1) && lo <= (k) && (k) < hi)
#define BOTH(k) (IN(k) && IN((k) + 1))
    const int gw = F.vcu * NWAVES + F.wave, NGW = F.G * NWAVES;

    if (IN(0)) {
        int tl_ = threadIdx.x; asm volatile("" : "+v"(tl_)); const int lane = tl_ & 63;
        LAS float* scr = (LAS float*)(F.lds + RING_OFF + F.wave * 16384);
        constexpr int I_IN = (D / 64) * (NIN / 32), I_O = (D / 64) * (D / 32), I_UP = (D / 64) * (FF / 32), I_DN = (FF / 64) * (D / 32), I_G = I_O, I_P = (PLE / 64) * (D / 32);
        constexpr int NITEMS = I_IN + I_O + I_UP + I_DN + I_G + I_P;
        _Pragma("unroll") for (int rep_ = 0; rep_ < REPN(0); ++rep_) {
        for (int it = gw; it < NITEMS; it += NGW) {
            int r = it;
            if (r < I_IN) { p0_transpose_item(w_in, D, NIN, WinT, nullptr, scr, r, lane); continue; } r -= I_IN;
            if (r < I_O) { p0_transpose_item(w_out, D, D, WoutT, nullptr, scr, r, lane); continue; } r -= I_O;
            if (r < I_UP) { p0_transpose_item(w_up, D, FF, WupT, g_ffn, scr, r, lane); continue; } r -= I_UP;
            if (r < I_DN) { p0_transpose_item(w_down, FF, D, WdnT, nullptr, scr, r, lane); continue; } r -= I_DN;
            if (r < I_G) { p0_transpose_item(w_gate, D, D, WgT, nullptr, scr, r, lane); continue; } r -= I_G;
            p0_transpose_item(w_proj, PLE, D, WpT, nullptr, scr, r, lane);
        }
        for (int m0 = 2 * gw; m0 < MT; m0 += 2 * NGW) {
            if (m0 + 1 < MP + MS) {
                const float* xr0 = m0 < MP ? x_prompt + (size_t)m0 * D : x_sample + (size_t)(m0 - MP) * D; const float* xr1 = xr0 + D;
                const float* pr0 = m0 < MP ? p_prompt + (size_t)m0 * PLE : p_sample + (size_t)(m0 - MP) * PLE;
                const f32x4* xa = (const f32x4*)xr0 + lane; const f32x4* xb = (const f32x4*)xr1 + lane; const f32x4* gr = (const f32x4*)g_mix + lane;
                f32x4 va[4], vb[4];
#pragma unroll
                for (int j = 0; j < 4; ++j) { va[j] = __builtin_nontemporal_load(xa + 64 * j); vb[j] = __builtin_nontemporal_load(xb + 64 * j); }
                const f32x4 pa = __builtin_nontemporal_load((const f32x4*)pr0 + lane), pb = __builtin_nontemporal_load((const f32x4*)(pr0 + PLE) + lane);
                float sa = 0.f, sb = 0.f;
#pragma unroll
                for (int j = 0; j < 4; ++j) { sa += (va[j].x * va[j].x + va[j].y * va[j].y) + (va[j].z * va[j].z + va[j].w * va[j].w); sb += (vb[j].x * vb[j].x + vb[j].y * vb[j].y) + (vb[j].z * vb[j].z + vb[j].w * vb[j].w); }
                const float ra = 1.0f / sqrtf(wave_sum(sa) * (1.f / D) + EPS), rb = 1.0f / sqrtf(wave_sum(sb) * (1.f / D) + EPS);
                unsigned long long* oa = (unsigned long long*)(XN + (size_t)m0 * D) + lane; unsigned long long* ob = oa + D / 4;
#pragma unroll
                for (int j = 0; j < 4; ++j) { const f32x4 gg = gr[64 * j];
                    oa[64 * j] = (unsigned long long)pk2(va[j].x * ra * gg.x, va[j].y * ra * gg.y) | ((unsigned long long)pk2(va[j].z * ra * gg.z, va[j].w * ra * gg.w) << 32);
                    ob[64 * j] = (unsigned long long)pk2(vb[j].x * rb * gg.x, vb[j].y * rb * gg.y) | ((unsigned long long)pk2(vb[j].z * rb * gg.z, vb[j].w * rb * gg.w) << 32); }
                unsigned long long* po = (unsigned long long*)(PB + (size_t)m0 * PLE) + lane;
                po[0] = (unsigned long long)pk2(pa.x, pa.y) | ((unsigned long long)pk2(pa.z, pa.w) << 32); po[PLE / 4] = (unsigned long long)pk2(pb.x, pb.y) | ((unsigned long long)pk2(pb.z, pb.w) << 32);
            } else {
#pragma unroll
                for (int q = 0; q < 2; ++q) { unsigned long long* o8 = (unsigned long long*)(XN + (size_t)(m0 + q) * D) + lane;
#pragma unroll
                    for (int j = 0; j < 4; ++j) o8[64 * j] = 0ull;
                    ((unsigned long long*)(PB + (size_t)(m0 + q) * PLE))[lane] = 0ull; }
            }
        }
        }
        { v4u* z = (v4u*)(args.ws + WS_SC4); const size_t nz = (WS_SC_END - WS_SC4) / 16;
          for (size_t i = (size_t)blockIdx.x * (NWAVES * 64) + tl_; i < nz; i += (size_t)F.G * (NWAVES * 64)) z[i] = (v4u){0u, 0u, 0u, 0u}; }
        if (BOTH(0)) GRID_BAR();
    }

    if (IN(1)) {
        { pg8::Gemm g{XN, WinT, MT, NIN, D}; pg8::StaticOrder S; S.init(MT, NIN, F.G, (int)blockIdx.x);
          pg8::EpiIn E{Qb, LOGF, OUTP, hgrn_lb};
          _Pragma("unroll") for (int rep_ = 0; rep_ < REPN(10); ++rep_) pg8::gemm_phase<pg8::EpiIn, pg8::StaticOrder, true, true>(F.lds + RING_OFF, g, S, E); }
        { pg8::Gemm g{PB, WpT, MT, D, PLE}; pg8::StaticOrder S; S.init(MT, D, F.G, (int)(F.G - 1 - blockIdx.x));
          pg8::EpiBf E{PJ, D};
          _Pragma("unroll") for (int rep_ = 0; rep_ < REPN(11); ++rep_) pg8::gemm_phase<pg8::EpiBf, pg8::StaticOrder, true, true>(F.lds + RING_OFF, g, S, E); }
        if (BOTH(1)) GRID_BAR();
    }

    if (IN(2)) {
        const float lam = __uint_as_float(F.MISC[4]);
#ifndef SKIP_DEC
        if ((int)blockIdx.x >= DEC_FIRST_FROM) for (;;) {
            if (F.tid == 0) F.MISC[1] = __hip_atomic_fetch_add(F.ctl + CW_QD, 1u, RLX_AGENT);
            LGKM_BAR();
            const int idx = (int)F.MISC[1];
            if (idx >= 512) break;
            dec::unit(idx >> 2, idx & 3, Qb, Kb, Vb, cache_k, cache_v, ptab, MIX, lam, g_subln, F.lds + RING_OFF);
        }
#endif
#ifndef SKIP_HG
        _Pragma("unroll") for (int rep_ = 0; rep_ < REPN(20); ++rep_) if (blockIdx.x < 32) hg::unit((int)blockIdx.x, RQ, RK, RV, LOGF, OREC, OUTP + OUT_SP, F.lds + RING_OFF);
#endif
#ifndef SKIP_ATT
        _Pragma("unroll") for (int rep_ = 0; rep_ < REPN(21); ++rep_) for (;;) {
            if (F.tid == 0) F.MISC[0] = __hip_atomic_fetch_add(F.ctl + CW_QA + 256 * rep_, 1u, RLX_AGENT);
            LGKM_BAR();
            const int idx = (int)F.MISC[0];
            if (idx >= 512) break;
            const int qblk = 15 - (idx >> 5), bh = idx & 31;
            att::unit(bh >> 2, bh & 3, qblk, Qb, Kb, Vb, MIX, lam, g_subln, F.lds + RING_OFF);
        }
#endif
#ifndef SKIP_DEC
        _Pragma("unroll") for (int rep_ = 0; rep_ < REPN(22); ++rep_) for (;;) {
            if (F.tid == 0) F.MISC[1] = __hip_atomic_fetch_add(F.ctl + CW_QD + 256 * rep_, 1u, RLX_AGENT);
            LGKM_BAR();
            const int idx = (int)F.MISC[1];
            if (idx >= 512) break;
            dec::unit(idx >> 2, idx & 3, Qb, Kb, Vb, cache_k, cache_v, ptab, MIX, lam, g_subln, F.lds + RING_OFF);
        }
#endif
        _Pragma("unroll") for (int rep_ = 0; rep_ < REPN(23); ++rep_) for (int it = F.vcu; it < 512; it += F.G) hgrn_step(it >> 2, it & 3, RQ, RK, RV, LOGF, state0, OUTP + OUT_SS, OREC, F.lds + RING_OFF);
        if (BOTH(2)) GRID_BAR();
    }

    if (IN(3)) {
        int tl_ = threadIdx.x; asm volatile("" : "+v"(tl_)); const int lane = tl_ & 63;
        _Pragma("unroll") for (int rep_ = 0; rep_ < REPN(3); ++rep_) for (int m0 = 4 * gw; m0 < MP + MS; m0 += 4 * NGW) {
            v4u ow[4], gq[4];
#pragma unroll
            for (int q = 0; q < 4; ++q) { ow[q] = ((const v4u*)(OREC + (size_t)(m0 + q) * RW))[lane]; gq[q] = ((const v4u*)(RG + (size_t)(m0 + q) * RW))[lane]; }
            const f32x4 g0 = ((const f32x4*)g_rec)[2 * lane], g1 = ((const f32x4*)g_rec)[2 * lane + 1];
#pragma unroll
            for (int q = 0; q < 4; ++q) {
                float o[8] = {bflo(ow[q].x), bfhi(ow[q].x), bflo(ow[q].y), bfhi(ow[q].y), bflo(ow[q].z), bfhi(ow[q].z), bflo(ow[q].w), bfhi(ow[q].w)};
                const float gt[8] = {bflo(gq[q].x), bfhi(gq[q].x), bflo(gq[q].y), bfhi(gq[q].y), bflo(gq[q].z), bfhi(gq[q].z), bflo(gq[q].w), bfhi(gq[q].w)};
                float s = 0.f;
#pragma unroll
                for (int j = 0; j < 8; ++j) s += o[j] * o[j];
                const float r = 1.0f / sqrtf(wave_sum(s) * (1.f / RW) + EPS);
                v4u w; w.x = pk2(o[0] * r * g0.x * gt[0], o[1] * r * g0.y * gt[1]); w.y = pk2(o[2] * r * g0.z * gt[2], o[3] * r * g0.w * gt[3]);
                w.z = pk2(o[4] * r * g1.x * gt[4], o[5] * r * g1.y * gt[5]); w.w = pk2(o[6] * r * g1.z * gt[6], o[7] * r * g1.w * gt[7]);
                ((v4u*)(MIX + (size_t)(m0 + q) * D + AW))[lane] = w;
            }
        }
        if (BOTH(3)) GRID_BAR();
#ifdef PROBE_XBAR
        _Pragma("unroll") for (int xb_ = 0; xb_ < PROBE_XBAR; ++xb_) GRID_BAR();
#endif
    }

    if (IN(4)) {
        pg8::Gemm g{MIX, WoutT, MP, D, D}; pg8::StaticOrder S; S.init(MP, D, F.G, (int)blockIdx.x);
        pg8::EpiOut E{x_prompt, x_sample, X1, A2, SSP1};
        _Pragma("unroll") for (int rep_ = 0; rep_ < REPN(4); ++rep_) pg8::gemm_phase<pg8::EpiOut, pg8::StaticOrder, true, true>(F.lds + RING_OFF, g, S, E);
        for (int it = blockIdx.x; it < 256; it += F.G) samp_item<4, D, D, 64>(it, MIX + (size_t)MP * D, nullptr, nullptr, nullptr, nullptr, nullptr, WoutT, SC4);
        if (BOTH(4)) GRID_BAR();
    }
    if (IN(5)) {
        pg8::Gemm g{A2, WupT, MP, FF, D}; pg8::StaticOrder S; S.init(MP, FF, F.G, (int)blockIdx.x);
        pg8::EpiUp E{HB, FF};
        _Pragma("unroll") for (int rep_ = 0; rep_ < REPN(5); ++rep_) pg8::gemm_phase<pg8::EpiUp, pg8::StaticOrder, true, true>(F.lds + RING_OFF, g, S, E);
        for (int it = blockIdx.x; it < 256; it += F.G) samp_item<5, FF, D, 256>(it, nullptr, x_sample, SC4, nullptr, nullptr, SS1S, WupT, SC5);
        if (BOTH(5)) GRID_BAR();
    }
    if (IN(6)) {
        pg8::Gemm g{HB, WdnT, MP, D, FF}; pg8::StaticOrder S; S.init(MP, D, F.G, (int)blockIdx.x);
        pg8::EpiDown E{X1, X2, A3, SSP1};
        _Pragma("unroll") for (int rep_ = 0; rep_ < REPN(6); ++rep_) pg8::gemm_phase<pg8::EpiDown, pg8::StaticOrder, true, true>(F.lds + RING_OFF, g, S, E);
        for (int it = blockIdx.x; it < 256; it += F.G) samp_item<6, D, FF, 256>(it, nullptr, nullptr, nullptr, SC5, nullptr, nullptr, WdnT, SC6);
        if (BOTH(6)) GRID_BAR();
    }
    if (IN(7)) {
        pg8::Gemm g{A3, WgT, MP, D, D}; pg8::StaticOrder S; S.init(MP, D, F.G, (int)blockIdx.x);
        pg8::EpiGate E{X2, PJ, X1, SSP3};
        _Pragma("unroll") for (int rep_ = 0; rep_ < REPN(7); ++rep_) pg8::gemm_phase<pg8::EpiGate, pg8::StaticOrder, true, true>(F.lds + RING_OFF, g, S, E);
        for (int it = blockIdx.x; it < 256; it += F.G) samp_item<7, D, D, 64>(it, nullptr, x_sample, SC4, nullptr, SC6, SS1S, WgT, SC7);
        if (BOTH(7)) GRID_BAR();
    }
    if (IN(8)) {
        int tl_ = threadIdx.x; asm volatile("" : "+v"(tl_)); const int lane = tl_ & 63;
        _Pragma("unroll") for (int rep_ = 0; rep_ < REPN(8); ++rep_) for (int m = gw; m < MP; m += NGW) {
            float* yr = OUTP + OUT_YP + (size_t)m * D; const f32x4* x4 = (const f32x4*)(X1 + (size_t)m * D) + lane;
            const f32x4* sp = (const f32x4*)(SSP3 + (size_t)m * 16);
            const f32x4 ps = (sp[0] + sp[1]) + (sp[2] + sp[3]);
            const float r = 1.0f / sqrtf(((ps.x + ps.y) + (ps.z + ps.w)) * (1.f / D) + EPS);
            f32x4* y4 = (f32x4*)yr + lane; const f32x4* g4 = (const f32x4*)g_final + lane;
#pragma unroll
            for (int j = 0; j < 4; ++j) { const f32x4 v = x4[64 * j], gg = g4[64 * j]; y4[64 * j] = v * r * gg; }
        }
        for (int sr = NGW - 1 - gw; sr < MS; sr += NGW) {
            const float r2 = 1.0f / (SS1S[sr] * (1.0f / D) + EPS);
            const f32x4* xs4 = (const f32x4*)(x_sample + (size_t)sr * D) + lane; const f32x4* c4 = (const f32x4*)(SC4 + (size_t)sr * D) + lane;
            const f32x4* c6 = (const f32x4*)(SC6 + (size_t)sr * D) + lane; const f32x4* c7 = (const f32x4*)(SC7 + (size_t)sr * D) + lane;
            const u32x2v* pj = (const u32x2v*)(PJ + (size_t)(MP + sr) * D) + lane;
            f32x4 v[4]; float s = 0.f;
#pragma unroll
            for (int j = 0; j < 4; ++j) { const f32x4 x2 = xs4[64 * j] + c4[64 * j] + c6[64 * j] * r2, gt = c7[64 * j]; const u32x2v pw = pj[64 * j];
                v[j].x = x2.x + pg8::sigmoidf_(gt.x) * bflo(pw.x); v[j].y = x2.y + pg8::sigmoidf_(gt.y) * bfhi(pw.x); v[j].z = x2.z + pg8::sigmoidf_(gt.z) * bflo(pw.y); v[j].w = x2.w + pg8::sigmoidf_(gt.w) * bfhi(pw.y);
                s += (v[j].x * v[j].x + v[j].y * v[j].y) + (v[j].z * v[j].z + v[j].w * v[j].w); }
            const float r = 1.0f / sqrtf(wave_sum(s) * (1.f / D) + EPS);
            f32x4* y4 = (f32x4*)(OUTP + OUT_YS + (size_t)sr * D) + lane; const f32x4* g4 = (const f32x4*)g_final + lane;
#pragma unroll
            for (int j = 0; j < 4; ++j) y4[64 * j] = v[j] * r * g4[64 * j];
        }
    }
#undef IN
#undef BOTH
#undef GRID_BAR
}

#undef x_prompt
#undef x_sample
#undef cache_k
#undef cache_v
#undef state0
#undef ptab
#undef p_prompt
#undef p_sample
#undef w_in
#undef g_subln
#undef hgrn_lb
#undef g_rec
#undef w_out
#undef g_mix
#undef g_ffn
#undef w_up
#undef w_down
#undef w_gate
#undef w_proj
#undef g_final
#undef OUTP
#undef WSP
#undef WinT
#undef WoutT
#undef WupT
#undef WdnT
#undef WgT
#undef WpT
#undef XN
#undef PB
#undef Qb
#undef Kb
#undef Vb
#undef RQ
#undef RK
#undef RV
#undef RG
#undef LOGF
#undef OREC
#undef MIX
#undef X1
#undef A2
#undef A3
#undef PJ
#undef HB
#undef SSP1
#undef SSP3
#undef SC4
#undef X2
#undef SC5
#undef SC6
#undef SC7
#undef SS1S
extern "C" void kernel_launch(void* const* d_in, const int* in_sizes, int n_in, void* d_out, int out_size, void* d_ws, size_t ws_size, hipStream_t stream) {
    static int grid = 0;
    if (grid == 0) {
        if (n_in != 24 || in_sizes[0] != MP * D || (size_t)out_size != OUT_END || ws_size < WS_END) {
            fprintf(stderr, "kernel_launch: unexpected shapes: n_in %d, in0 %d, out %d, ws %zu; nothing launched\n", n_in, n_in > 0 ? in_sizes[0] : -1, out_size, ws_size); grid = -1; return; }
        int dev = 0, cus = 0, per_cu = 0;
        if (hipGetDevice(&dev) != hipSuccess || hipDeviceGetAttribute(&cus, hipDeviceAttributeMultiprocessorCount, dev) != hipSuccess) { grid = -1; return; }
        if (hipFuncSetAttribute((const void*)mk_fwd, hipFuncAttributeMaxDynamicSharedMemorySize, LDS_BYTES) != hipSuccess) { fprintf(stderr, "kernel_launch: hipFuncSetAttribute failed\n"); grid = -1; return; }
        if (hipOccupancyMaxActiveBlocksPerMultiprocessor(&per_cu, (const void*)mk_fwd, NWAVES * 64, LDS_BYTES) != hipSuccess || per_cu < 1) {
            fprintf(stderr, "kernel_launch: occupancy query reports %d workgroups per CU; nothing launched\n", per_cu); (void)hipGetLastError(); grid = -1; return; }
        (void)hipGetLastError();
        grid = cus;
    }
    if (grid < 0) return;
    if (hipMemsetAsync((char*)d_ws + WS_CTL, 0, CTL_ZERO_BYTES, stream) != hipSuccess) return;
    Args a{};
    for (int i = 0; i < 24; ++i) a.in[i] = (const float*)d_in[i];
    a.out = (float*)d_out; a.ws = (unsigned char*)d_ws;
    if (MK_N_LAUNCHES == 1) {
        a.ph_lo = 0; a.ph_hi = N_PHASES; a.li = 0;
        hipLaunchKernelGGL(mk_fwd, dim3(grid), dim3(NWAVES * 64), LDS_BYTES, stream, a);
    } else {
        for (int li = 0; li < N_PHASES; ++li) { a.ph_lo = li; a.ph_hi = li + 1; a.li = li; hipLaunchKernelGGL(mk_fwd, dim3(grid), dim3(NWAVES * 64), LDS_BYTES, stream, a); }
    }
}
```
